# Optimizing an MI355X kernel written in HIP

```python
import math
import jax
import jax.numpy as jnp
from jax import lax
import numpy as np

D_MODEL = 1024
BATCH = 8
SEQ = 4096
DEPTH = 4

GRID_W = 64
CTX_LEN = 256
EPS = 1e-6

BRANCH_W = 512
N_BRANCH = 3

ATT_HEADS = 4
ATT_QK_DIM = 64
ATT_V_DIM = 2 * ATT_QK_DIM
ATT_WIDTH = ATT_HEADS * ATT_V_DIM
ROPE_BASE = 10000.0
Q_BLOCK = 128

LRU_WIDTH = BRANCH_W
LRU_BLOCKS = 8
LRU_BLOCK = LRU_WIDTH // LRU_BLOCKS
LRU_C = 8.0
CONV_W = 4
CONV_PAD = (2, 1)

S5_WIDTH = BRANCH_W
S5_GROUP = 16
S5_GROUPS = S5_WIDTH // S5_GROUP
S5_STATE = 64

SPLITS = (ATT_HEADS * 2 * ATT_QK_DIM, ATT_HEADS * 2 * ATT_QK_DIM, ATT_WIDTH, ATT_WIDTH,
          LRU_WIDTH, LRU_WIDTH, S5_WIDTH, S5_WIDTH, N_BRANCH * D_MODEL)
IN_DIM = sum(SPLITS)

kernel_name = 'hybrid_diffattn_rglru_s5_prefix_block'


def _split_points(sizes):
    pts, acc = [], 0
    for s in sizes[:-1]:
        acc += s
        pts.append(acc)
    return pts


def rmsnorm(x, g):
    xf = x.astype(jnp.float32)
    y = xf * lax.rsqrt(jnp.mean(jnp.square(xf), axis=-1, keepdims=True) + EPS)
    return (y * g.astype(jnp.float32)).astype(x.dtype)


def ada_mod(cond, w_mod, b_mod):
    m = jax.nn.silu(cond) @ w_mod + b_mod
    return jnp.split(m, 3, axis=-1)


def axial_rope(n_tokens):
    rows = n_tokens // GRID_W
    r = jnp.repeat(jnp.arange(rows, dtype=jnp.float32), GRID_W)
    col = jnp.tile(jnp.arange(GRID_W, dtype=jnp.float32), rows)
    n_freq = ATT_QK_DIM // 4
    inv = ROPE_BASE ** (-jnp.arange(n_freq, dtype=jnp.float32) / n_freq)
    ang = jnp.concatenate([r[:, None] * inv, col[:, None] * inv], axis=-1)
    return jnp.cos(ang), jnp.sin(ang)


def apply_rope(x, cos, sin):
    cos = cos[:, None, None, :]
    sin = sin[:, None, None, :]
    x1 = x[..., 0::2].astype(jnp.float32)
    x2 = x[..., 1::2].astype(jnp.float32)
    out = jnp.stack([x1 * cos - x2 * sin, x1 * sin + x2 * cos], axis=-1).reshape(x.shape)
    return out.astype(x.dtype)


def diff_attend(q, k, v, lam):
    s = jnp.einsum('bqhcd,bkhcd->bhcqk', q, k, preferred_element_type=jnp.float32) * (ATT_QK_DIM ** -0.5)
    p = jax.nn.softmax(s, axis=-1)
    w = p[:, :, 0] - lam * p[:, :, 1]
    return jnp.einsum('bhqk,bkhd->bqhd', w.astype(v.dtype), v)


def diff_attention_branch(q_l, k_l, v_l, q_c, k_c, v_c, lam_qk, subln_g, lam_init, need_ctx):
    b, t = q_l.shape[:2]
    lq = lam_qk.astype(jnp.float32)
    lam = jnp.exp(jnp.sum(lq[0] * lq[1])) - jnp.exp(jnp.sum(lq[2] * lq[3])) + lam_init
    cos, sin = axial_rope(t)
    q_l = apply_rope(q_l, cos, sin)
    k_l = apply_rope(k_l, cos, sin)
    k_all = jnp.concatenate([k_l, k_c], axis=1)
    v_all = jnp.concatenate([v_l, v_c], axis=1)
    n_blk = t // Q_BLOCK
    q_blocks = jnp.moveaxis(q_l.reshape(b, n_blk, Q_BLOCK, *q_l.shape[2:]), 1, 0)
    o = lax.map(lambda qb: diff_attend(qb, k_all, v_all, lam), q_blocks)
    o_l = jnp.moveaxis(o, 0, 1).reshape(b, t, ATT_HEADS, ATT_V_DIM)

    def post(o_):
        return (rmsnorm(o_, subln_g) * (1.0 - lam_init)).reshape(*o_.shape[:2], ATT_WIDTH)

    y_c = post(diff_attend(q_c, k_c, v_c, lam)) if need_ctx else None
    return post(o_l), y_c


def depthwise_conv(x, w, b):
    y = lax.conv_general_dilated(x, w[:, None, :].astype(x.dtype), (1,), [CONV_PAD],
                                 dimension_numbers=('NWC', 'WIO', 'NWC'),
                                 feature_group_count=x.shape[-1])
    return y + b


def block_diag(x, w, b):
    xb = x.reshape(*x.shape[:-1], LRU_BLOCKS, LRU_BLOCK)
    return jnp.einsum('btnc,ncd->btnd', xb, w).reshape(x.shape) + b


def rglru_coeffs(x, w_a, b_a, w_x, b_x, lam):
    r = jax.nn.sigmoid(block_diag(x, w_a, b_a).astype(jnp.float32))
    i = jax.nn.sigmoid(block_diag(x, w_x, b_x).astype(jnp.float32))
    log_a = -LRU_C * r * jax.nn.softplus(-lam.astype(jnp.float32))
    a = jnp.exp(log_a)
    bterm = jnp.sqrt(-jnp.expm1(2.0 * log_a)) * (i * x.astype(jnp.float32))
    return a, bterm


def _lin_combine(e1, e2):
    a1, b1 = e1
    a2, b2 = e2
    return a1 * a2, a2 * b1 + b2


def linear_scan(a, b, h0, reverse):
    if h0 is not None:
        first = -1 if reverse else 0
        b = b.at[:, first].add(a[:, first] * h0)
    return lax.associative_scan(_lin_combine, (a, b), axis=1, reverse=reverse)[1]


def rglru_branch(x_l, x_c, conv_w, conv_b, w_a, b_a, w_x, b_x, lam):
    u_l = depthwise_conv(x_l, conv_w, conv_b)
    u_c = depthwise_conv(x_c, conv_w, conv_b)
    hs_l, hs_c = [], []
    for d, rev in enumerate((False, True)):
        a_c, b_c = rglru_coeffs(u_c, w_a[d], b_a[d], w_x[d], b_x[d], lam[d])
        h_c = linear_scan(a_c, b_c, None, rev)
        h0 = h_c[:, 0] if rev else h_c[:, -1]
        a_l, b_l = rglru_coeffs(u_l, w_a[d], b_a[d], w_x[d], b_x[d], lam[d])
        hs_l.append(linear_scan(a_l, b_l, h0, rev))
        hs_c.append(h_c)
    return (hs_l[0] + hs_l[1]).astype(x_l.dtype), (hs_c[0] + hs_c[1]).astype(x_c.dtype)


def s5_discretise(lam_re, lam_im, log_dt, b_re, b_im):
    dt = jnp.exp(log_dt.astype(jnp.float32))[:, None]
    lr = lam_re.astype(jnp.float32)
    li = lam_im.astype(jnp.float32)
    mag = jnp.exp(lr * dt)
    ar = mag * jnp.cos(li * dt)
    ai = mag * jnp.sin(li * dt)
    den = lr * lr + li * li
    nr = ar - 1.0
    cr = (nr * lr + ai * li) / den
    ci = (ai * lr - nr * li) / den
    br = cr[..., None] * b_re - ci[..., None] * b_im
    bi = cr[..., None] * b_im + ci[..., None] * b_re
    return ar, ai, br, bi


def _cplx_combine(e1, e2):
    ar1, ai1, br1, bi1 = e1
    ar2, ai2, br2, bi2 = e2
    return (ar1 * ar2 - ai1 * ai2, ar1 * ai2 + ai1 * ar2,
            ar2 * br1 - ai2 * bi1 + br2, ar2 * bi1 + ai2 * br1 + bi2)


def complex_scan(ar, ai, br, bi, h0, reverse):
    if h0 is not None:
        h0r, h0i = h0
        first = -1 if reverse else 0
        br = br.at[:, first].add(ar * h0r - ai * h0i)
        bi = bi.at[:, first].add(ar * h0i + ai * h0r)
    a_r = jnp.broadcast_to(ar, br.shape)
    a_i = jnp.broadcast_to(ai, br.shape)
    _, _, hr, hi = lax.associative_scan(_cplx_combine, (a_r, a_i, br, bi), axis=1, reverse=reverse)
    return hr, hi


def s5_branch(u_l, u_c, lam_re, lam_im, log_dt, b_re, b_im, c_re, c_im, d_skip, w_glu, b_glu, need_ctx):
    def drive(u, bbr, bbi):
        ug = u.reshape(*u.shape[:2], S5_GROUPS, S5_GROUP).astype(jnp.float32)
        return jnp.einsum('btgh,gph->btgp', ug, bbr), jnp.einsum('btgh,gph->btgp', ug, bbi)

    def readout(u, hr, hi):
        y = jnp.einsum('btgp,ghp->btgh', hr, c_re) - jnp.einsum('btgp,ghp->btgh', hi, c_im)
        y = y.reshape(u.shape).astype(u.dtype) + d_skip * u
        g = jax.nn.gelu(y)
        return g * jax.nn.sigmoid(g @ w_glu + b_glu)

    hl_r, hl_i, hc_r, hc_i = [], [], [], []
    for d, rev in enumerate((False, True)):
        ar, ai, bbr, bbi = s5_discretise(lam_re[d], lam_im[d], log_dt[d], b_re[d], b_im[d])
        cr_, ci_ = complex_scan(ar, ai, *drive(u_c, bbr, bbi), None, rev)
        idx = 0 if rev else -1
        lr_, li_ = complex_scan(ar, ai, *drive(u_l, bbr, bbi), (cr_[:, idx], ci_[:, idx]), rev)
        hl_r.append(lr_)
        hl_i.append(li_)
        hc_r.append(cr_)
        hc_i.append(ci_)
    y_l = readout(u_l, hl_r[0] + hl_r[1], hl_i[0] + hl_i[1])
    y_c = readout(u_c, hc_r[0] + hc_r[1], hc_i[0] + hc_i[1]) if need_ctx else None
    return y_l, y_c


def gated_merge(ya, yr, ys, za, zr, zs, gl, w_branch, w_out):
    y = jnp.stack([ya * jax.nn.silu(za), yr * jax.nn.silu(zr), ys * jax.nn.silu(zs)], axis=2)
    yb = jnp.einsum('btnw,nwd->btnd', y, w_branch)
    g = jax.nn.sigmoid(gl.reshape(*gl.shape[:2], N_BRANCH, D_MODEL))
    return jnp.sum(g * yb, axis=2) @ w_out


def _qk_heads(t):
    return t.reshape(*t.shape[:2], ATT_HEADS, 2, ATT_QK_DIM)


def _v_heads(t):
    return t.reshape(*t.shape[:2], ATT_HEADS, ATT_V_DIM)


def hybrid_layer(x, ctx, c, c_ctx, p, layer_idx, need_ctx):
    lam_init = 0.8 - 0.6 * math.exp(-0.3 * layer_idx)
    sh_x, sc_x, gt_x = ada_mod(c, p['w_mod'], p['b_mod'])
    sh_c, sc_c, gt_c = ada_mod(c_ctx, p['w_mod'], p['b_mod'])
    h_l = rmsnorm(x, p['norm_g']) * (1.0 + sc_x[:, None]) + sh_x[:, None]
    h_c = rmsnorm(ctx, p['norm_g']) * (1.0 + sc_c) + sh_c
    pts = _split_points(SPLITS)
    q_l, k_l, v_l, za_l, xr_l, zr_l, us_l, zs_l, gl_l = jnp.split(h_l @ p['w_in'], pts, axis=-1)
    q_c, k_c, v_c, za_c, xr_c, zr_c, us_c, zs_c, gl_c = jnp.split(h_c @ p['w_in'], pts, axis=-1)

    ya_l, ya_c = diff_attention_branch(_qk_heads(q_l), _qk_heads(k_l), _v_heads(v_l),
                                       _qk_heads(q_c), _qk_heads(k_c), _v_heads(v_c),
                                       p['lam_qk'], p['subln_g'], lam_init, need_ctx)
    yr_l, yr_c = rglru_branch(xr_l, xr_c, p['conv_w'], p['conv_b'], p['lru_wa'], p['lru_ba'],
                              p['lru_wx'], p['lru_bx'], p['lru_lam'])
    ys_l, ys_c = s5_branch(us_l, us_c, p['s5_lam_re'], p['s5_lam_im'], p['s5_log_dt'], p['s5_b_re'],
                           p['s5_b_im'], p['s5_c_re'], p['s5_c_im'], p['s5_d'], p['s5_w_glu'],
                           p['s5_b_glu'], need_ctx)

    x = x + gt_x[:, None] * gated_merge(ya_l, yr_l, ys_l, za_l, zr_l, zs_l, gl_l, p['w_branch'], p['w_out'])
    if need_ctx:
        ctx = ctx + gt_c * gated_merge(ya_c, yr_c, ys_c, za_c, zr_c, zs_c, gl_c, p['w_branch'], p['w_out'])
    return x, ctx


def setup_inputs(seed: int = 0) -> dict:
    key = jax.random.key(seed)
    ks = jax.random.split(key, 32)
    f32 = jnp.float32
    L = DEPTH

    def nrm(k, shape, s):
        return jax.random.normal(k, shape, f32) * s

    a_c = jax.random.uniform(ks[16], (L, 2, LRU_WIDTH), f32, minval=0.9, maxval=0.999)
    a_base = a_c ** (1.0 / LRU_C)
    return {
        'x': nrm(ks[0], (BATCH, SEQ, D_MODEL), 1.0),
        'c': nrm(ks[1], (BATCH, D_MODEL), 1.0),
        'ctx': nrm(ks[2], (BATCH, CTX_LEN, D_MODEL), 1.0),
        'c_ctx': nrm(ks[3], (D_MODEL,), 1.0),
        'w_mod': nrm(ks[4], (L, D_MODEL, 3 * D_MODEL), 0.5 * D_MODEL ** -0.5),
        'b_mod': nrm(ks[5], (L, 3 * D_MODEL), 0.01),
        'norm_g': 1.0 + nrm(ks[6], (L, D_MODEL), 0.01),
        'w_in': nrm(ks[7], (L, D_MODEL, IN_DIM), D_MODEL ** -0.5),
        'lam_qk': nrm(ks[8], (L, 4, ATT_QK_DIM), 0.1),
        'subln_g': 1.0 + nrm(ks[9], (L, ATT_V_DIM), 0.01),
        'conv_w': nrm(ks[10], (L, CONV_W, LRU_WIDTH), CONV_W ** -0.5),
        'conv_b': nrm(ks[11], (L, LRU_WIDTH), 0.01),
        'lru_wa': nrm(ks[12], (L, 2, LRU_BLOCKS, LRU_BLOCK, LRU_BLOCK), LRU_BLOCK ** -0.5),
        'lru_ba': nrm(ks[13], (L, 2, LRU_WIDTH), 0.01),
        'lru_wx': nrm(ks[14], (L, 2, LRU_BLOCKS, LRU_BLOCK, LRU_BLOCK), LRU_BLOCK ** -0.5),
        'lru_bx': nrm(ks[15], (L, 2, LRU_WIDTH), 0.01),
        'lru_lam': jnp.log(a_base) - jnp.log1p(-a_base),
        's5_lam_re': -0.5 + nrm(ks[17], (L, 2, S5_GROUPS, S5_STATE), 0.01),
        's5_lam_im': jnp.pi * jnp.arange(S5_STATE, dtype=f32) + nrm(ks[18], (L, 2, S5_GROUPS, S5_STATE), 0.01),
        's5_log_dt': jax.random.uniform(ks[19], (L, 2, S5_GROUPS), f32,
                                        minval=math.log(1e-3), maxval=math.log(1e-1)),
        's5_b_re': nrm(ks[20], (L, 2, S5_GROUPS, S5_STATE, S5_GROUP), (2 * S5_GROUP) ** -0.5),
        's5_b_im': nrm(ks[21], (L, 2, S5_GROUPS, S5_STATE, S5_GROUP), (2 * S5_GROUP) ** -0.5),
        's5_c_re': nrm(ks[22], (L, S5_GROUPS, S5_GROUP, S5_STATE), (2 * S5_STATE) ** -0.5),
        's5_c_im': nrm(ks[23], (L, S5_GROUPS, S5_GROUP, S5_STATE), (2 * S5_STATE) ** -0.5),
        's5_d': nrm(ks[24], (L, S5_WIDTH), 1.0),
        's5_w_glu': nrm(ks[25], (L, S5_WIDTH, S5_WIDTH), S5_WIDTH ** -0.5),
        's5_b_glu': nrm(ks[26], (L, S5_WIDTH), 0.01),
        'w_branch': nrm(ks[27], (L, N_BRANCH, BRANCH_W, D_MODEL), BRANCH_W ** -0.5),
        'w_out': nrm(ks[28], (L, D_MODEL, D_MODEL), D_MODEL ** -0.5),
        'final_g': 1.0 + nrm(ks[29], (D_MODEL,), 0.01),
    }


def reference(x, c, ctx, c_ctx, w_mod, b_mod, norm_g, w_in, lam_qk, subln_g, conv_w, conv_b,
              lru_wa, lru_ba, lru_wx, lru_bx, lru_lam, s5_lam_re, s5_lam_im, s5_log_dt,
              s5_b_re, s5_b_im, s5_c_re, s5_c_im, s5_d, s5_w_glu, s5_b_glu, w_branch, w_out, final_g):
    for l in range(DEPTH):
        p = dict(w_mod=w_mod[l], b_mod=b_mod[l], norm_g=norm_g[l], w_in=w_in[l], lam_qk=lam_qk[l],
                 subln_g=subln_g[l], conv_w=conv_w[l], conv_b=conv_b[l], lru_wa=lru_wa[l],
                 lru_ba=lru_ba[l], lru_wx=lru_wx[l], lru_bx=lru_bx[l], lru_lam=lru_lam[l],
                 s5_lam_re=s5_lam_re[l], s5_lam_im=s5_lam_im[l], s5_log_dt=s5_log_dt[l],
                 s5_b_re=s5_b_re[l], s5_b_im=s5_b_im[l], s5_c_re=s5_c_re[l], s5_c_im=s5_c_im[l],
                 s5_d=s5_d[l], s5_w_glu=s5_w_glu[l], s5_b_glu=s5_b_glu[l], w_branch=w_branch[l],
                 w_out=w_out[l])
        x, ctx = hybrid_layer(x, ctx, c, c_ctx, p, l, l < DEPTH - 1)
    return rmsnorm(x, final_g)
```

```cpp
#include <hip/hip_runtime.h>
#include <hip/hip_bf16.h>
#include <hip/hip_cooperative_groups.h>
#include <cstdio>
#include <cstdint>
namespace cg = cooperative_groups;

#ifndef MULTI_LAUNCH
#define MULTI_LAUNCH 0
#endif

#define DEV __device__ __forceinline__
typedef unsigned short bf16_t;
using bf16x8 = __attribute__((ext_vector_type(8))) short;
using f32x4 = __attribute__((ext_vector_type(4))) float;
using u32x4 = __attribute__((ext_vector_type(4))) unsigned;
using u32x2 = __attribute__((ext_vector_type(2))) unsigned;

constexpr int NR = 34816;
constexpr int NLAT = 32768;
constexpr int PW = 4096;
constexpr int CQ = 0, CK = 512, CZA = 1536, CXR = 2048, CZR = 2560, CUS = 3072, CZS = 3584, CM = 512;
constexpr int NCH = 544;
constexpr int NPHASE = 34;
constexpr int SMEM_HALF = 73728;
constexpr int SMEM_BYTES = 2 * SMEM_HALF;

struct Params {
  const float *x, *c, *ctx, *c_ctx, *w_mod, *b_mod, *norm_g, *w_in, *lam_qk, *subln_g, *conv_w, *conv_b,
      *lru_wa, *lru_ba, *lru_wx, *lru_bx, *lru_lam, *s5_lam_re, *s5_lam_im, *s5_log_dt, *s5_b_re, *s5_b_im,
      *s5_c_re, *s5_c_im, *s5_d, *s5_w_glu, *s5_b_glu, *w_branch, *w_out, *final_g;
  float* out;
  bf16_t *proj, *hbuf, *WinT, *WbT, *WoT, *WgT, *WlT, *Vt;
  float *ctxres, *mods, *lamv, *lruP, *lruS;
  float2 *rope, *s5A, *s5A64, *s5E;
  u32x4 *s5drvB, *s5C;
  unsigned* bar;
};

DEV int tidx() { int t = threadIdx.x & 255; asm volatile("" : "+v"(t)); return t; }
DEV int tid512() { int t = threadIdx.x; asm volatile("" : "+v"(t)); return t; }
DEV int vhalf() { return __builtin_amdgcn_readfirstlane((int)(threadIdx.x >> 8)); }
DEV int vb() { return (int)blockIdx.x * 2 + vhalf(); }
DEV int vg() { return (int)gridDim.x * 2; }
DEV u32x4 u32x4_mk(unsigned a, unsigned b, unsigned c, unsigned d) { return u32x4{a, b, c, d}; }
DEV u32x2 u32x2_mk(unsigned a, unsigned b) { return u32x2{a, b}; }
typedef float f32x2_t __attribute__((ext_vector_type(2)));
typedef __bf16 bf16x2_t __attribute__((ext_vector_type(2)));
DEV bf16_t f2bf(float f) { return __builtin_bit_cast(unsigned short, (__bf16)f); }
DEV float bf2f(bf16_t h) { return __uint_as_float(((unsigned)h) << 16); }
DEV unsigned pack2(float a, float b) {
  f32x2_t v = {a, b};
  return __builtin_bit_cast(unsigned, __builtin_convertvector(v, bf16x2_t));
}
DEV float fexp2(float x) { return __builtin_amdgcn_exp2f(x); }
DEV float frcp(float x) { return __builtin_amdgcn_rcpf(x); }
DEV float sigmoidf_(float x) { return frcp(1.f + __expf(-x)); }
DEV float siluf_(float x) { return x * frcp(1.f + __expf(-x)); }
DEV float gelu_tanh(float x) {
  float u = 0.7978845608028654f * (x + 0.044715f * x * x * x);
  return x * frcp(1.f + __expf(-2.f * u));
}
DEV float shx(float v, int mask, int lane) { return __int_as_float(__builtin_amdgcn_ds_bpermute((lane ^ mask) << 2, __float_as_int(v))); }
DEV float shi(float v, int src) { return __int_as_float(__builtin_amdgcn_ds_bpermute(src << 2, __float_as_int(v))); }
DEV f32x4 mfma16(bf16x8 a, bf16x8 b, f32x4 c) { return __builtin_amdgcn_mfma_f32_16x16x32_bf16(a, b, c, 0, 0, 0); }
DEV bf16x8 as_bf16x8(u32x4 v) {
  return __builtin_bit_cast(bf16x8, v);
}

template <int NTW>
DEV void g_load(u32x4 (&ra)[4], u32x4 (&rw)[NTW], const bf16_t* __restrict__ A, int lda, const bf16_t* __restrict__ W,
                int ldw, int k0, int lrow, int loff) {
#pragma unroll
  for (int i = 0; i < 4; ++i) ra[i] = *(const u32x4*)(A + (size_t)(lrow + 32 * i) * lda + k0 + loff);
#pragma unroll
  for (int i = 0; i < NTW; ++i) rw[i] = *(const u32x4*)(W + (size_t)(lrow + 32 * i) * ldw + k0 + loff);
}
template <int NTW>
DEV void s_store(const u32x4 (&ra)[4], const u32x4 (&rw)[NTW], bf16_t* As, bf16_t* Ws, int lrow, int loff) {
#pragma unroll
  for (int i = 0; i < 4; ++i) *(u32x4*)(As + (lrow + 32 * i) * 72 + loff) = ra[i];
#pragma unroll
  for (int i = 0; i < NTW; ++i) *(u32x4*)(Ws + (lrow + 32 * i) * 72 + loff) = rw[i];
}
template <int BN>
DEV void g_compute(f32x4 (&acc)[4][BN / 32], const bf16_t* As, const bf16_t* Ws, int wm, int wn, int r16, int g) {
  constexpr int NTW = BN / 32;
#pragma unroll
  for (int kb = 0; kb < 2; ++kb) {
    bf16x8 af[4], wf[NTW];
#pragma unroll
    for (int mt = 0; mt < 4; ++mt) af[mt] = *(const bf16x8*)(As + (wm * 64 + mt * 16 + r16) * 72 + kb * 32 + g * 8);
#pragma unroll
    for (int nt = 0; nt < NTW; ++nt)
      wf[nt] = *(const bf16x8*)(Ws + (wn * (BN / 2) + nt * 16 + r16) * 72 + kb * 32 + g * 8);
#pragma unroll
    for (int mt = 0; mt < 4; ++mt)
#pragma unroll
      for (int nt = 0; nt < NTW; ++nt) acc[mt][nt] = mfma16(wf[nt], af[mt], acc[mt][nt]);
  }
}
template <int BN>
DEV void gemm_main(f32x4 (&acc)[4][BN / 32], const bf16_t* __restrict__ A, int lda, const bf16_t* __restrict__ W,
                   int ldw, int K, char* smem) {
  constexpr int NTW = BN / 32;
  constexpr int BUF = (128 + BN) * 72;
  bf16_t* As0 = (bf16_t*)smem;
  bf16_t* Ws0 = As0 + 128 * 72;
  bf16_t* As1 = As0 + BUF;
  bf16_t* Ws1 = As1 + 128 * 72;
  const int tid = tidx(), lane = tid & 63, w = tid >> 6;
  const int wm = w & 1, wn = w >> 1;
  const int r16 = lane & 15, g = lane >> 4;
  const int lrow = tid >> 3, loff = (tid & 7) * 8;
  u32x4 ra0[4], rw0[NTW], ra1[4], rw1[NTW];
  const int nk = K >> 6;
  g_load<NTW>(ra0, rw0, A, lda, W, ldw, 0, lrow, loff);
  g_load<NTW>(ra1, rw1, A, lda, W, ldw, 64, lrow, loff);
  __syncthreads();
  s_store<NTW>(ra0, rw0, As0, Ws0, lrow, loff);
  g_load<NTW>(ra0, rw0, A, lda, W, ldw, 128, lrow, loff);
  __syncthreads();
  for (int kt = 0; kt < nk; kt += 2) {
    s_store<NTW>(ra1, rw1, As1, Ws1, lrow, loff);
    g_load<NTW>(ra1, rw1, A, lda, W, ldw, min(kt + 3, nk - 1) << 6, lrow, loff);
    g_compute<BN>(acc, As0, Ws0, wm, wn, r16, g);
    __syncthreads();
    s_store<NTW>(ra0, rw0, As0, Ws0, lrow, loff);
    g_load<NTW>(ra0, rw0, A, lda, W, ldw, min(kt + 4, nk - 1) << 6, lrow, loff);
    g_compute<BN>(acc, As1, Ws1, wm, wn, r16, g);
    __syncthreads();
  }
}

template <int NT>
DEV void zero_acc(f32x4 (&acc)[4][NT]) {
#pragma unroll
  for (int i = 0; i < 4; ++i)
#pragma unroll
    for (int j = 0; j < NT; ++j) acc[i][j] = f32x4{0.f, 0.f, 0.f, 0.f};
}

DEV int mod_row(int m) { return m < NLAT ? (m >> 12) : 8; }

DEV void transpose_tile(const float* __restrict__ src, int N, bf16_t* __restrict__ dst, int K, int k0, int n0, char* smem) {
  float* tile = (float*)smem;
  const int tid = tidx();
  __syncthreads();
  {
    const int n = tid & 63, kk = tid >> 6;
#pragma unroll
    for (int i = 0; i < 16; ++i) {
      int k = kk + 4 * i;
      tile[k * 65 + n] = src[(size_t)(k0 + k) * N + n0 + n];
    }
  }
  __syncthreads();
  {
    const int k = tid & 63, nn = tid >> 6;
#pragma unroll
    for (int i = 0; i < 16; ++i) {
      int n = nn + 4 * i;
      dst[(size_t)(n0 + n) * K + k0 + k] = f2bf(tile[k * 65 + n]);
    }
  }
}

DEV void transpose_tile2(const float* __restrict__ src, int N, bf16_t* __restrict__ dst, int K, int k0, int n0, char* smem) {
  float* tile = (float*)smem;
  const int tid = tidx();
  __syncthreads();
  {
    const int n = tid & 63, kk = tid >> 6;
#pragma unroll
    for (int i = 0; i < 32; ++i) {
      int k = kk + 4 * i;
      tile[k * 65 + n] = src[(size_t)(k0 + k) * N + n0 + n];
    }
  }
  __syncthreads();
  {
    const int kp = tid & 63, nn = tid >> 6;
#pragma unroll
    for (int i = 0; i < 16; ++i) {
      int n = nn + 4 * i;
      unsigned v = pack2(tile[(2 * kp) * 65 + n], tile[(2 * kp + 1) * 65 + n]);
      *(unsigned*)(dst + (size_t)(n0 + n) * K + k0 + 2 * kp) = v;
    }
  }
}

struct TrJob { const float* src; bf16_t* dst; int N, K, k0, n0, rows; };
DEV TrJob prep_job(const Params& P, int l, int job) {
  TrJob t;
  int j = job;
  if (j < 896) {
    t.src = P.w_in + (size_t)l * 1024 * 7168; t.dst = P.WinT + (size_t)l * 7168 * 1024; t.N = 7168; t.K = 1024;
    t.k0 = (j / 112) * 128; t.n0 = (j % 112) * 64; t.rows = 128; return t;
  }
  j -= 896;
  if (j < 192) {
    const int mat = l * 3 + j / 64, q = j % 64;
    t.src = P.w_branch + (size_t)mat * 512 * 1024; t.dst = P.WbT + (size_t)mat * 1024 * 512; t.N = 1024; t.K = 512;
    t.k0 = (q / 16) * 128; t.n0 = (q % 16) * 64; t.rows = 128; return t;
  }
  j -= 192;
  if (j < 128) {
    t.src = P.w_out + (size_t)l * 1024 * 1024; t.dst = P.WoT + (size_t)l * 1024 * 1024; t.N = 1024; t.K = 1024;
    t.k0 = (j / 16) * 128; t.n0 = (j % 16) * 64; t.rows = 128; return t;
  }
  j -= 128;
  if (j < 32) {
    t.src = P.s5_w_glu + (size_t)l * 512 * 512; t.dst = P.WgT + (size_t)l * 512 * 512; t.N = 512; t.K = 512;
    t.k0 = (j / 8) * 128; t.n0 = (j % 8) * 64; t.rows = 128; return t;
  }
  j -= 32;
  {
    const int jj = l * 32 + j;
    const int blk = jj & 7, which = (jj >> 3) & 1, ld = jj >> 4;
    t.src = (which ? P.lru_wx : P.lru_wa) + (size_t)(ld * 8 + blk) * 4096; t.dst = P.WlT + (size_t)jj * 4096; t.N = 64; t.K = 64;
    t.k0 = 0; t.n0 = 0; t.rows = 64; return t;
  }
}
DEV void prep_load(const TrJob& t, float (&v)[32], int tid) {
  const int n = tid & 63, kk = tid >> 6;
#pragma unroll
  for (int i = 0; i < 32; ++i) {
    const int k = kk + 4 * i;
    v[i] = (k < t.rows) ? t.src[(size_t)(t.k0 + k) * t.N + t.n0 + n] : 0.f;
  }
}
DEV void prep_layer_weights(const Params& P, int l, int first, int stride, char* smem) {
  float* tile = (float*)smem;
  const int tid = tidx();
  if (first >= 1280) return;
  TrJob cur = prep_job(P, l, first);
  float v[32];
  prep_load(cur, v, tid);
  for (int job = first; job < 1280; job += stride) {
    __syncthreads();
    {
      const int n = tid & 63, kk = tid >> 6;
#pragma unroll
      for (int i = 0; i < 32; ++i) tile[(kk + 4 * i) * 65 + n] = v[i];
    }
    const bool has_next = job + stride < 1280;
    TrJob nxt = cur;
    if (has_next) { nxt = prep_job(P, l, job + stride); prep_load(nxt, v, tid); }
    __syncthreads();
    {
      const int kp = tid & 63, nn = tid >> 6;
      if (2 * kp < cur.rows) {
#pragma unroll
        for (int i = 0; i < 16; ++i) {
          const int n = nn + 4 * i;
          const unsigned pk = pack2(tile[(2 * kp) * 65 + n], tile[(2 * kp + 1) * 65 + n]);
          *(unsigned*)(cur.dst + (size_t)(cur.n0 + n) * cur.K + cur.k0 + 2 * kp) = pk;
        }
      }
    }
    cur = nxt;
  }
}

DEV void phase0(const Params& P, char* smem) {
  const int tid = tidx();
  prep_layer_weights(P, 0, vb(), vg(), smem);
  constexpr int J_MOD = 768, J_ROPE = 512, J_S5 = 256;
  constexpr int JT = J_MOD + J_ROPE + J_S5 + 1;
  for (int job = vb(); job < JT; job += vg()) {
    int j = job;
    if (j < J_MOD) {
      int l = j / 192, jt = j % 192;
      float* sc = (float*)smem;
      float* red = sc + 9216;
      __syncthreads();
      for (int idx = tid; idx < 9216; idx += 256) {
        int r = idx >> 10, k = idx & 1023;
        float v = r < 8 ? P.c[r * 1024 + k] : P.c_ctx[k];
        sc[idx] = siluf_(v);
      }
      __syncthreads();
      const int jj = tid & 15, kq = tid >> 4, col = jt * 16 + jj;
      float a[9];
#pragma unroll
      for (int r = 0; r < 9; ++r) a[r] = 0.f;
      const float* wp = P.w_mod + (size_t)l * 1024 * 3072 + col;
#pragma unroll 16
      for (int k = kq * 64; k < kq * 64 + 64; ++k) {
        float wv = wp[(size_t)k * 3072];
#pragma unroll
        for (int r = 0; r < 9; ++r) a[r] += sc[r * 1024 + k] * wv;
      }
#pragma unroll
      for (int r = 0; r < 9; ++r) red[(kq * 9 + r) * 16 + jj] = a[r];
      __syncthreads();
      if (tid < 144) {
        int r = tid >> 4, j2 = tid & 15;
        float s_ = 0.f;
#pragma unroll
        for (int q = 0; q < 16; ++q) s_ += red[(q * 9 + r) * 16 + j2];
        int cc = jt * 16 + j2;
        P.mods[(size_t)(l * 9 + r) * 3072 + cc] = s_ + P.b_mod[l * 3072 + cc];
      }
      continue;
    }
    j -= J_MOD;
    if (j < J_ROPE) {
      int e = j * 256 + tid;
      int t = e >> 5, i = e & 31, f = i & 15;
      float inv = powf(10000.f, -(float)f / 16.f);
      float pos = (float)(i < 16 ? (t >> 6) : (t & 63));
      float ang = pos * inv;
      P.rope[e] = make_float2(cosf(ang), sinf(ang));
      continue;
    }
    j -= J_ROPE;
    if (j < J_S5) {
      const int g = j & 31, ld = j >> 5, l = ld >> 1, d = ld & 1;
      float* crs = (float*)smem;
      __syncthreads();
      if (tid < 64) {
        int p = tid;
        float lr = P.s5_lam_re[(size_t)j * 64 + p], li = P.s5_lam_im[(size_t)j * 64 + p];
        float dt = expf(P.s5_log_dt[j]);
        float mag = expf(lr * dt);
        float ar = mag * cosf(li * dt), ai = mag * sinf(li * dt);
        float den = lr * lr + li * li;
        float nr = ar - 1.f;
        crs[p] = (nr * lr + ai * li) / den;
        crs[64 + p] = (ai * lr - nr * li) / den;
        P.s5A[(size_t)j * 64 + p] = make_float2(ar, ai);
        float pr = ar, pi = ai;
#pragma unroll
        for (int s = 0; s < 6; ++s) {
          float nr2 = pr * pr - pi * pi, ni2 = 2.f * pr * pi;
          pr = nr2; pi = ni2;
        }
        P.s5A64[(size_t)j * 64 + p] = make_float2(pr, pi);
      }
      __syncthreads();
      for (int e = tid; e < 512; e += 256) {
        int nt = e >> 6, ln = e & 63;
        int ri = nt >> 2, p = (nt & 3) * 16 + (ln & 15), kg = ln >> 4;
        float cr = crs[p], ci = crs[64 + p];
        unsigned v[4] = {0u, 0u, 0u, 0u};
        if (kg < 2) {
          const float* bre = P.s5_b_re + ((size_t)j * 64 + p) * 16 + kg * 8;
          const float* bim = P.s5_b_im + ((size_t)j * 64 + p) * 16 + kg * 8;
#pragma unroll
          for (int q = 0; q < 4; ++q) {
            float r0 = bre[2 * q], i0 = bim[2 * q], r1 = bre[2 * q + 1], i1 = bim[2 * q + 1];
            float v0 = ri == 0 ? cr * r0 - ci * i0 : cr * i0 + ci * r0;
            float v1 = ri == 0 ? cr * r1 - ci * i1 : cr * i1 + ci * r1;
            v[q] = pack2(v0, v1);
          }
        }
        P.s5drvB[((size_t)j * 8 + nt) * 64 + ln] = u32x4_mk(v[0], v[1], v[2], v[3]);
      }
      if (d == 0) {
        int kk = tid >> 6, ln = tid & 63;
        int h = ln & 15;
        unsigned v[4];
#pragma unroll
        for (int q = 0; q < 4; ++q) {
          float vv[2];
#pragma unroll
          for (int s = 0; s < 2; ++s) {
            int k = kk * 32 + (ln >> 4) * 8 + 2 * q + s;
            size_t base = ((size_t)(l * 32 + g) * 16 + h) * 64;
            vv[s] = (k & 1) == 0 ? P.s5_c_re[base + (k >> 1)] : -P.s5_c_im[base + (k >> 1)];
          }
          v[q] = pack2(vv[0], vv[1]);
        }
        P.s5C[((size_t)(l * 32 + g) * 4 + kk) * 64 + ln] = u32x4_mk(v[0], v[1], v[2], v[3]);
      }
      continue;
    }
    j -= J_S5;
    {
      int l = tid >> 6, lane = tid & 63;
      const float* lq = P.lam_qk + l * 256;
      float s1 = lq[lane] * lq[64 + lane], s2 = lq[128 + lane] * lq[192 + lane];
#pragma unroll
      for (int o = 32; o > 0; o >>= 1) {
        s1 += shx(s1, o, lane);
        s2 += shx(s2, o, lane);
      }
      float lam_init = 0.8f - 0.6f * expf(-0.3f * (float)l);
      if (lane == 0) P.lamv[l] = expf(s1) - expf(s2) + lam_init;
    }
  }
}

DEV void phase_norm(const Params& P, int l) {
  const int tid_ = tidx(); const int lane = tid_ & 63, w = tid_ >> 6;
  const float* ng = P.norm_g + l * 1024;
  auto rowptr = [&](int r) -> const float* {
    if (r < NLAT) return (l == 0 ? P.x : P.out) + (size_t)r * 1024;
    return (l == 0 ? P.ctx : P.ctxres) + (size_t)(r - NLAT) * 1024;
  };
  const int stride = vg() * 4;
  int r = vb() * 4 + w;
  float4 v[4], vn[4];
  if (r < NR) {
    const float* src = rowptr(r);
#pragma unroll
    for (int i = 0; i < 4; ++i) v[i] = *(const float4*)(src + i * 256 + lane * 4);
  }
  for (; r < NR; r += stride) {
    const int rn = r + stride;
    if (rn < NR) {
      const float* srcn = rowptr(rn);
#pragma unroll
      for (int i = 0; i < 4; ++i) vn[i] = *(const float4*)(srcn + i * 256 + lane * 4);
    }
    const float* md = P.mods + (size_t)(l * 9 + mod_row(r)) * 3072;
    float ss = 0.f;
#pragma unroll
    for (int i = 0; i < 4; ++i) ss += v[i].x * v[i].x + v[i].y * v[i].y + v[i].z * v[i].z + v[i].w * v[i].w;
#pragma unroll
    for (int o = 32; o > 0; o >>= 1) ss += __shfl_xor(ss, o);
    float rstd = rsqrtf(ss * (1.f / 1024.f) + 1e-6f);
#pragma unroll
    for (int i = 0; i < 4; ++i) {
      int k = i * 256 + lane * 4;
      float4 g4 = *(const float4*)(ng + k);
      float4 sh = *(const float4*)(md + k);
      float4 sc = *(const float4*)(md + 1024 + k);
      float o0 = v[i].x * rstd * g4.x * (1.f + sc.x) + sh.x;
      float o1 = v[i].y * rstd * g4.y * (1.f + sc.y) + sh.y;
      float o2 = v[i].z * rstd * g4.z * (1.f + sc.z) + sh.z;
      float o3 = v[i].w * rstd * g4.w * (1.f + sc.w) + sh.w;
      u32x2 pk = u32x2_mk(pack2(o0, o1), pack2(o2, o3));
      *(u32x2*)(P.hbuf + (size_t)r * 1024 + k) = pk;
    }
#pragma unroll
    for (int i = 0; i < 4; ++i) v[i] = vn[i];
  }
}

DEV void phase_proj(const Params& P, int l, char* smem) {
  const int tid_ = tidx(); const int lane = tid_ & 63, w = tid_ >> 6;
  const int wm = w & 1, wn = w >> 1, r16 = lane & 15, g = lane >> 4;
  const bf16_t* Wl = P.WinT + (size_t)l * 7168 * 1024;
  const float QS = 0.125f * 1.4426950408889634f;
  for (int tile = vb(); tile < 272 * 32; tile += vg()) {
    const int mtile = tile >> 5, ntile = tile & 31;
    const int m0 = mtile * 128, n0 = ntile * 128;
    f32x4 acc[4][4];
    zero_acc<4>(acc);
    gemm_main<128>(acc, P.hbuf + (size_t)m0 * 1024, 1024, Wl + (size_t)n0 * 1024, 1024, 1024, smem);
    const int region = n0 >> 9;
#pragma unroll
    for (int mt = 0; mt < 4; ++mt) {
      const int m = m0 + wm * 64 + mt * 16 + r16;
#pragma unroll
      for (int nt = 0; nt < 4; ++nt) {
        const int n = n0 + wn * 64 + nt * 16 + g * 4;
        f32x4 v = acc[mt][nt];
        if (region <= 1) {
          if (m < NLAT) {
            int t = m & 4095;
            int i0 = (n & 63) >> 1;
            float4 cs = *(const float4*)(P.rope + (size_t)t * 32 + i0);
            float a0 = v[0] * cs.x - v[1] * cs.y, a1 = v[0] * cs.y + v[1] * cs.x;
            float a2 = v[2] * cs.z - v[3] * cs.w, a3 = v[2] * cs.w + v[3] * cs.z;
            v = f32x4{a0, a1, a2, a3};
          }
          if (region == 0) v = v * QS;
          *(u32x2*)(P.proj + (size_t)m * PW + n) = u32x2_mk(pack2(v[0], v[1]), pack2(v[2], v[3]));
        } else if (region == 2) {
          int b, key;
          if (m < NLAT) { b = m >> 12; key = m & 4095; }
          else { b = (m - NLAT) >> 8; key = 4096 + ((m - NLAT) & 255); }
          int nn = n - 1024;
          bf16_t* vp = P.Vt + ((size_t)b * 512 + nn) * 4352 + key;
#pragma unroll
          for (int j = 0; j < 4; ++j) vp[(size_t)j * 4352] = f2bf(v[j]);
        } else {
          if (region == 3 || region == 5 || region == 7) {
#pragma unroll
            for (int j = 0; j < 4; ++j) v[j] = siluf_(v[j]);
          }
          *(u32x2*)(P.proj + (size_t)m * PW + n) = u32x2_mk(pack2(v[0], v[1]), pack2(v[2], v[3]));
        }
      }
    }
  }
}

struct ChunkGeo { int row0, seqrow0, seqlen, tloc0; };
DEV ChunkGeo chunk_geo(int cid) {
  ChunkGeo c;
  if (cid < 512) {
    int b = cid >> 6, lc = cid & 63;
    c.row0 = b * 4096 + lc * 64; c.seqrow0 = b * 4096; c.seqlen = 4096; c.tloc0 = lc * 64;
  } else {
    int cc = cid - 512, b = cc >> 2;
    c.row0 = NLAT + cc * 64; c.seqrow0 = NLAT + b * 256; c.seqlen = 256; c.tloc0 = (cc & 3) * 64;
  }
  return c;
}
DEV int chunk_at(int b, int d, int pos) {
  if (d == 0) return pos < 4 ? 512 + b * 4 + pos : b * 64 + (pos - 4);
  return pos < 4 ? 512 + b * 4 + (3 - pos) : b * 64 + (63 - (pos - 4));
}

DEV void lru_item(const Params& P, int l, int item, bool step3, char* smem) {
  const int tid = tidx(), lane = tid & 63, w = tid >> 6, r16 = lane & 15, g = lane >> 4;
  const int cid = item >> 3, cb = item & 7;
  const ChunkGeo cg_ = chunk_geo(cid);
  bf16_t* Us = (bf16_t*)smem;
  const int c8 = tid & 7, tr = tid >> 3;
  const int ch0 = cb * 64 + c8 * 8;
  u32x4 xin[2][4];
#pragma unroll
  for (int pass = 0; pass < 2; ++pass)
#pragma unroll
    for (int jt = 0; jt < 4; ++jt) {
      const int tt = cg_.tloc0 + tr + 32 * pass + jt - 2;
      u32x4 xv = u32x4_mk(0u, 0u, 0u, 0u);
      if (tt >= 0 && tt < cg_.seqlen) xv = *(const u32x4*)(P.proj + (size_t)(cg_.seqrow0 + tt) * PW + CXR + ch0);
      xin[pass][jt] = xv;
    }
  float wt[4][8], cbv[8];
#pragma unroll
  for (int e = 0; e < 8; ++e) cbv[e] = P.conv_b[l * 512 + ch0 + e];
#pragma unroll
  for (int jt = 0; jt < 4; ++jt)
#pragma unroll
    for (int e = 0; e < 8; ++e) wt[jt][e] = P.conv_w[(l * 4 + jt) * 512 + ch0 + e];
  const int ch = cb * 64 + w * 16 + r16;
  bf16_t zep[4][4];
  float cin[2] = {0.f, 0.f};
  if (step3) {
    cin[0] = P.lruS[(size_t)(0 * NCH + cid) * 512 + ch];
    cin[1] = P.lruS[(size_t)(1 * NCH + cid) * 512 + ch];
#pragma unroll
    for (int tt = 0; tt < 4; ++tt)
#pragma unroll
      for (int j = 0; j < 4; ++j) zep[tt][j] = P.proj[(size_t)(cg_.row0 + tt * 16 + g * 4 + j) * PW + CZR + ch];
  }
  bf16x8 wfr[2][2][2];
  float bav[2], bxv[2], lmv[2];
#pragma unroll
  for (int d = 0; d < 2; ++d) {
#pragma unroll
    for (int wh = 0; wh < 2; ++wh)
#pragma unroll
      for (int kb = 0; kb < 2; ++kb)
        wfr[d][wh][kb] = *(const bf16x8*)(P.WlT + (size_t)(((l * 2 + d) * 2 + wh) * 8 + cb) * 4096 + (w * 16 + r16) * 64 + kb * 32 + g * 8);
    bav[d] = P.lru_ba[(l * 2 + d) * 512 + ch];
    bxv[d] = P.lru_bx[(l * 2 + d) * 512 + ch];
    lmv[d] = P.lru_lam[(l * 2 + d) * 512 + ch];
  }
  __syncthreads();
#pragma unroll
  for (int pass = 0; pass < 2; ++pass) {
    const int t = tr + 32 * pass;
    float a[8];
#pragma unroll
    for (int e = 0; e < 8; ++e) a[e] = cbv[e];
#pragma unroll
    for (int jt = 0; jt < 4; ++jt) {
      const u32x4 xv = xin[pass][jt];
      const unsigned xs[4] = {xv.x, xv.y, xv.z, xv.w};
#pragma unroll
      for (int q = 0; q < 4; ++q) {
        a[2 * q] += wt[jt][2 * q] * bf2f((bf16_t)(xs[q] & 0xffffu));
        a[2 * q + 1] += wt[jt][2 * q + 1] * bf2f((bf16_t)(xs[q] >> 16));
      }
    }
    *(u32x4*)(Us + t * 72 + c8 * 8) = u32x4_mk(pack2(a[0], a[1]), pack2(a[2], a[3]), pack2(a[4], a[5]), pack2(a[6], a[7]));
  }
  __syncthreads();
  bf16x8 uf[4][2];
#pragma unroll
  for (int tt = 0; tt < 4; ++tt)
#pragma unroll
    for (int kb = 0; kb < 2; ++kb) uf[tt][kb] = *(const bf16x8*)(Us + (tt * 16 + r16) * 72 + kb * 32 + g * 8);
  float uval[4][4];
#pragma unroll
  for (int tt = 0; tt < 4; ++tt)
#pragma unroll
    for (int j = 0; j < 4; ++j) uval[tt][j] = bf2f(Us[(tt * 16 + g * 4 + j) * 72 + w * 16 + r16]);
  float outv[4][4];
#pragma unroll
  for (int tt = 0; tt < 4; ++tt)
#pragma unroll
    for (int j = 0; j < 4; ++j) outv[tt][j] = 0.f;

#pragma unroll
  for (int d = 0; d < 2; ++d) {
    f32x4 ga[4], gx[4];
#pragma unroll
    for (int tt = 0; tt < 4; ++tt) { ga[tt] = f32x4{0.f, 0.f, 0.f, 0.f}; gx[tt] = f32x4{0.f, 0.f, 0.f, 0.f}; }
#pragma unroll
    for (int kb = 0; kb < 2; ++kb) {
#pragma unroll
      for (int tt = 0; tt < 4; ++tt) {
        ga[tt] = mfma16(uf[tt][kb], wfr[d][0][kb], ga[tt]);
        gx[tt] = mfma16(uf[tt][kb], wfr[d][1][kb], gx[tt]);
      }
    }
    const float ba = bav[d], bx = bxv[d];
    const float sp = log1pf(expf(-lmv[d]));
    float av[4][4], bv[4][4];
#pragma unroll
    for (int tt = 0; tt < 4; ++tt)
#pragma unroll
      for (int j = 0; j < 4; ++j) {
        float r = sigmoidf_(ga[tt][j] + ba), ii = sigmoidf_(gx[tt][j] + bx);
        float log_a = -8.f * r * sp;
        float a_ = __expf(log_a);
        float x2 = 2.f * log_a;
        float ser = -x2 * (1.f + x2 * (0.5f + x2 * (0.16666667f + x2 * (0.041666668f + x2 * (0.0083333338f + x2 * 0.0013888889f)))));
        float om = x2 > -0.25f ? ser : 1.f - a_ * a_;
        av[tt][j] = a_;
        bv[tt][j] = __builtin_amdgcn_sqrtf(om) * (ii * uval[tt][j]);
      }
    float Ps[4], Ss[4];
#pragma unroll
    for (int tt = 0; tt < 4; ++tt) {
      float p_ = 1.f, s_ = 0.f;
      if (d == 0) {
#pragma unroll
        for (int j = 0; j < 4; ++j) { p_ *= av[tt][j]; s_ = s_ * av[tt][j] + bv[tt][j]; }
      } else {
#pragma unroll
        for (int j = 3; j >= 0; --j) { p_ *= av[tt][j]; s_ = s_ * av[tt][j] + bv[tt][j]; }
      }
      Ps[tt] = p_; Ss[tt] = s_;
    }
    const size_t cidx = (size_t)(d * NCH + cid) * 512 + ch;
    if (!step3) {
      float Pc = 1.f, Sc = 0.f;
#pragma unroll
      for (int q = 0; q < 4; ++q) {
        const int tt = d == 0 ? q : 3 - q;
#pragma unroll
        for (int q2 = 0; q2 < 4; ++q2) {
          const int gg = d == 0 ? q2 : 3 - q2;
          float Pg = shi(Ps[tt], gg * 16 + r16), Sg = shi(Ss[tt], gg * 16 + r16);
          Sc = Sc * Pg + Sg;
          Pc = Pc * Pg;
        }
      }
      if (g == 0) { P.lruP[cidx] = Pc; P.lruS[cidx] = Sc; }
    } else {
      float carry = cin[d];
#pragma unroll
      for (int q = 0; q < 4; ++q) {
        const int tt = d == 0 ? q : 3 - q;
        float run = carry, hstart = 0.f;
#pragma unroll
        for (int q2 = 0; q2 < 4; ++q2) {
          const int gg = d == 0 ? q2 : 3 - q2;
          float Pg = shi(Ps[tt], gg * 16 + r16), Sg = shi(Ss[tt], gg * 16 + r16);
          if (gg == g) hstart = run;
          run = run * Pg + Sg;
        }
        carry = run;
        float h = hstart;
        if (d == 0) {
#pragma unroll
          for (int j = 0; j < 4; ++j) { h = av[tt][j] * h + bv[tt][j]; outv[tt][j] += h; }
        } else {
#pragma unroll
          for (int j = 3; j >= 0; --j) { h = av[tt][j] * h + bv[tt][j]; outv[tt][j] += h; }
        }
      }
    }
  }
  if (step3) {
#pragma unroll
    for (int tt = 0; tt < 4; ++tt)
#pragma unroll
      for (int j = 0; j < 4; ++j) {
        bf16_t* zp = P.proj + (size_t)(cg_.row0 + tt * 16 + g * 4 + j) * PW + CZR + ch;
        *zp = f2bf(outv[tt][j] * bf2f(zep[tt][j]));
      }
  }
}

DEV void s5_item(const Params& P, int l, int item, bool step3, char* smem) {
  const int tid = tidx(), lane = tid & 63, w = tid >> 6, r16 = lane & 15, g = lane >> 4;
  const int cid = item >> 3, gq = item & 7;
  const int grp = gq * 4 + w;
  const ChunkGeo cg_ = chunk_geo(cid);
  bf16_t* BUh = (bf16_t*)(smem + w * 16896);
  bf16_t* Hs = (bf16_t*)(smem + w * 16896 + 8192);
  f32x4 Y[4];
#pragma unroll
  for (int s_ = 0; s_ < 4; ++s_) Y[s_] = f32x4{0.f, 0.f, 0.f, 0.f};
  bf16x8 ufr[4];
#pragma unroll
  for (int sub = 0; sub < 4; ++sub) {
    u32x4 uv = u32x4_mk(0u, 0u, 0u, 0u);
    if (g < 2) uv = *(const u32x4*)(P.proj + (size_t)(cg_.row0 + sub * 16 + r16) * PW + CUS + grp * 16 + g * 8);
    ufr[sub] = as_bf16x8(uv);
  }
  bf16x8 cf[4];
  bf16_t uep[4][4];
  if (step3) {
#pragma unroll
    for (int kk = 0; kk < 4; ++kk) cf[kk] = as_bf16x8(P.s5C[((size_t)(l * 32 + grp) * 4 + kk) * 64 + lane]);
#pragma unroll
    for (int sub = 0; sub < 4; ++sub)
#pragma unroll
      for (int j = 0; j < 4; ++j) uep[sub][j] = P.proj[(size_t)(cg_.row0 + sub * 16 + g * 4 + j) * PW + CUS + grp * 16 + r16];
  }
  const int jd0 = (l * 2 + 0) * 32 + grp, jd1 = (l * 2 + 1) * 32 + grp;
  bf16x8 bfrA[8], bfrB[8];
#pragma unroll
  for (int nt = 0; nt < 8; ++nt) {
    bfrA[nt] = as_bf16x8(P.s5drvB[((size_t)jd0 * 8 + nt) * 64 + lane]);
    bfrB[nt] = as_bf16x8(P.s5drvB[((size_t)jd1 * 8 + nt) * 64 + lane]);
  }
  const float2 A0 = P.s5A[(size_t)jd0 * 64 + lane], A1 = P.s5A[(size_t)jd1 * 64 + lane];
  const size_t eidx0 = ((size_t)(0 * NCH + cid) * 32 + grp) * 64 + lane, eidx1 = ((size_t)(1 * NCH + cid) * 32 + grp) * 64 + lane;
  float h0r = 0.f, h0i = 0.f, h1r = 0.f, h1i = 0.f;
  if (step3) { float2 a_ = P.s5E[eidx0], b_ = P.s5E[eidx1]; h0r = a_.x; h0i = a_.y; h1r = b_.x; h1i = b_.y; }
#pragma unroll
  for (int si = 0; si < 4; ++si) {
    const int sub0 = si, sub1 = 3 - si;
    __syncthreads();
#pragma unroll
    for (int nt = 0; nt < 8; ++nt) {
      f32x4 b0 = mfma16(ufr[sub0], bfrA[nt], f32x4{0.f, 0.f, 0.f, 0.f});
      f32x4 b1 = mfma16(ufr[sub1], bfrB[nt], f32x4{0.f, 0.f, 0.f, 0.f});
      *(u32x2*)(BUh + (nt * 16 + r16) * 16 + g * 4) = u32x2_mk(pack2(b0[0], b0[1]), pack2(b0[2], b0[3]));
      *(u32x2*)(BUh + 2048 + (nt * 16 + r16) * 16 + g * 4) = u32x2_mk(pack2(b1[0], b1[1]), pack2(b1[2], b1[3]));
    }
    __syncthreads();
    u32x4 r0a = *(const u32x4*)(BUh + lane * 16), r0b = *(const u32x4*)(BUh + lane * 16 + 8);
    u32x4 i0a = *(const u32x4*)(BUh + (64 + lane) * 16), i0b = *(const u32x4*)(BUh + (64 + lane) * 16 + 8);
    u32x4 r1a = *(const u32x4*)(BUh + 2048 + lane * 16), r1b = *(const u32x4*)(BUh + 2048 + lane * 16 + 8);
    u32x4 i1a = *(const u32x4*)(BUh + 2048 + (64 + lane) * 16), i1b = *(const u32x4*)(BUh + 2048 + (64 + lane) * 16 + 8);
    const unsigned re0[8] = {r0a.x, r0a.y, r0a.z, r0a.w, r0b.x, r0b.y, r0b.z, r0b.w};
    const unsigned im0[8] = {i0a.x, i0a.y, i0a.z, i0a.w, i0b.x, i0b.y, i0b.z, i0b.w};
    const unsigned re1[8] = {r1a.x, r1a.y, r1a.z, r1a.w, r1b.x, r1b.y, r1b.z, r1b.w};
    const unsigned im1[8] = {i1a.x, i1a.y, i1a.z, i1a.w, i1b.x, i1b.y, i1b.z, i1b.w};
#pragma unroll
    for (int ti = 0; ti < 16; ++ti) {
      {
        const int t = ti;
        const unsigned rw_ = re0[t >> 1], iw_ = im0[t >> 1];
        const float re = (t & 1) ? __uint_as_float(rw_ & 0xffff0000u) : __uint_as_float(rw_ << 16);
        const float im = (t & 1) ? __uint_as_float(iw_ & 0xffff0000u) : __uint_as_float(iw_ << 16);
        const float nr = A0.x * h0r - A0.y * h0i + re, ni = A0.x * h0i + A0.y * h0r + im;
        h0r = nr; h0i = ni;
        if (step3) *(unsigned*)(Hs + t * 136 + 2 * lane) = pack2(h0r, h0i);
      }
      {
        const int t = 15 - ti;
        const unsigned rw_ = re1[t >> 1], iw_ = im1[t >> 1];
        const float re = (t & 1) ? __uint_as_float(rw_ & 0xffff0000u) : __uint_as_float(rw_ << 16);
        const float im = (t & 1) ? __uint_as_float(iw_ & 0xffff0000u) : __uint_as_float(iw_ << 16);
        const float nr = A1.x * h1r - A1.y * h1i + re, ni = A1.x * h1i + A1.y * h1r + im;
        h1r = nr; h1i = ni;
        if (step3) *(unsigned*)(Hs + 2176 + t * 136 + 2 * lane) = pack2(h1r, h1i);
      }
    }
    if (step3) {
      __syncthreads();
#pragma unroll
      for (int kk = 0; kk < 4; ++kk) {
        bf16x8 hf0 = *(const bf16x8*)(Hs + r16 * 136 + kk * 32 + g * 8);
        bf16x8 hf1 = *(const bf16x8*)(Hs + 2176 + r16 * 136 + kk * 32 + g * 8);
        Y[sub0] = mfma16(hf0, cf[kk], Y[sub0]);
        Y[sub1] = mfma16(hf1, cf[kk], Y[sub1]);
      }
    }
  }
  if (!step3) { P.s5E[eidx0] = make_float2(h0r, h0i); P.s5E[eidx1] = make_float2(h1r, h1i); }
  if (step3) {
    const float dsk = P.s5_d[l * 512 + grp * 16 + r16];
#pragma unroll
    for (int sub = 0; sub < 4; ++sub)
#pragma unroll
      for (int j = 0; j < 4; ++j) {
        bf16_t* up = P.proj + (size_t)(cg_.row0 + sub * 16 + g * 4 + j) * PW + CUS + grp * 16 + r16;
        float y = Y[sub][j] + dsk * bf2f(uep[sub][j]);
        *up = f2bf(gelu_tanh(y));
      }
  }
}

DEV void phase_scan(const Params& P, int l, bool step3, char* smem) {
  const int ncid = (step3 && l == 3) ? 512 : NCH;
  const int nitems = ncid * 8;
  for (int it = vb(); it < 2 * nitems; it += vg()) {
    if (it < nitems) s5_item(P, l, it, step3, smem);
    else lru_item(P, l, it - nitems, step3, smem);
  }
}

DEV void carry_job(const Params& P, int l, int job) {
  const int tid = tidx();
  if (job < 32) {
    int id = job * 256 + tid;
    int ch = id & 511, d = (id >> 9) & 1, b = id >> 10;
    float carry = 0.f;
#pragma unroll 4
    for (int pos = 0; pos < 68; ++pos) {
      size_t idx = (size_t)(d * NCH + chunk_at(b, d, pos)) * 512 + ch;
      float Pv = P.lruP[idx], Sv = P.lruS[idx];
      P.lruS[idx] = carry;
      carry = Pv * carry + Sv;
    }
  } else {
    int id = (job - 32) * 256 + tid;
    int p = id & 63, g = (id >> 6) & 31, d = (id >> 11) & 1, b = id >> 12;
    float2 A = P.s5A64[((size_t)(l * 2 + d) * 32 + g) * 64 + p];
    float cr = 0.f, ci = 0.f;
#pragma unroll 4
    for (int pos = 0; pos < 68; ++pos) {
      size_t idx = ((size_t)(d * NCH + chunk_at(b, d, pos)) * 32 + g) * 64 + p;
      float2 e = P.s5E[idx];
      P.s5E[idx] = make_float2(cr, ci);
      float nr = A.x * cr - A.y * ci + e.x;
      float ni = A.x * ci + A.y * cr + e.y;
      cr = nr; ci = ni;
    }
  }
}

DEV void attn_item(const Params& P, int l, int item, char* smem, int dowrite = 1) {
  const int tid = tidx(), lane = tid & 63, w = tid >> 6, r16 = lane & 15, g = lane >> 4;
  bf16_t* Ks = (bf16_t*)smem;
  bf16_t* Vs = Ks + 64 * 136;
  int b, h, qrow0, kt0, nkt;
  if (item < 2048) {
    b = item >> 8; h = (item >> 6) & 3;
    qrow0 = b * 4096 + (item & 63) * 64; kt0 = 0; nkt = 68;
  } else {
    int i2 = item - 2048;
    b = i2 >> 4; h = (i2 >> 2) & 3;
    qrow0 = NLAT + b * 256 + (i2 & 3) * 64; kt0 = 64; nkt = 4;
  }
  const int qrow = qrow0 + w * 16 + r16;
  bf16x8 qf[2][2];
#pragma unroll
  for (int c = 0; c < 2; ++c)
#pragma unroll
    for (int kb = 0; kb < 2; ++kb)
      qf[c][kb] = *(const bf16x8*)(P.proj + (size_t)qrow * PW + CQ + h * 128 + c * 64 + kb * 32 + g * 8);
  f32x4 o[2][8];
#pragma unroll
  for (int c = 0; c < 2; ++c)
#pragma unroll
    for (int dv = 0; dv < 8; ++dv) o[c][dv] = f32x4{0.f, 0.f, 0.f, 0.f};
  float mrun[2] = {-1e30f, -1e30f}, lsum[2] = {0.f, 0.f};
  const bf16_t* Vbase = P.Vt + (size_t)(b * 4 + h) * 128 * 4352;
  u32x4 rk[4], rv[4];
  auto gl = [&](int kt) {
    int krow0, vkey0;
    if (kt < 64) { krow0 = b * 4096 + kt * 64; vkey0 = kt * 64; }
    else { krow0 = NLAT + b * 256 + (kt - 64) * 64; vkey0 = 4096 + (kt - 64) * 64; }
#pragma unroll
    for (int i = 0; i < 4; ++i) {
      int cidx = tid + 256 * i;
      rk[i] = *(const u32x4*)(P.proj + (size_t)(krow0 + (cidx >> 4)) * PW + CK + h * 128 + (cidx & 15) * 8);
      rv[i] = *(const u32x4*)(Vbase + (size_t)(cidx >> 3) * 4352 + vkey0 + (cidx & 7) * 8);
    }
  };
  auto st = [&](int buf) {
    bf16_t* Kd = Ks + buf * (64 * 136 + 128 * 72);
    bf16_t* Vd = Vs + buf * (64 * 136 + 128 * 72);
#pragma unroll
    for (int i = 0; i < 4; ++i) {
      int cidx = tid + 256 * i;
      *(u32x4*)(Kd + (cidx >> 4) * 136 + (cidx & 15) * 8) = rk[i];
      *(u32x4*)(Vd + (cidx >> 3) * 72 + (cidx & 7) * 8) = rv[i];
    }
  };
  gl(kt0);
  __syncthreads();
  st(0);
  gl(kt0 + 1);
  __syncthreads();
  for (int it = 0; it < nkt; ++it) {
    const int cur = it & 1;
    if (it + 1 < nkt) st(cur ^ 1);
    if (it + 2 < nkt) gl(kt0 + it + 2);
    const bf16_t* Kc = Ks + cur * (64 * 136 + 128 * 72);
    const bf16_t* Vc = Vs + cur * (64 * 136 + 128 * 72);
#pragma unroll
    for (int c = 0; c < 2; ++c) {
      f32x4 s[4];
#pragma unroll
      for (int kt = 0; kt < 4; ++kt) {
        s[kt] = f32x4{0.f, 0.f, 0.f, 0.f};
#pragma unroll
        for (int kb = 0; kb < 2; ++kb) {
          bf16x8 kf = *(const bf16x8*)(Kc + (kt * 16 + r16) * 136 + c * 64 + kb * 32 + g * 8);
          s[kt] = mfma16(kf, qf[c][kb], s[kt]);
        }
      }
      float mx = fmaxf(fmaxf(s[0][0], s[0][1]), fmaxf(s[0][2], s[0][3]));
#pragma unroll
      for (int kt = 1; kt < 4; ++kt) mx = fmaxf(mx, fmaxf(fmaxf(s[kt][0], s[kt][1]), fmaxf(s[kt][2], s[kt][3])));
      mx = fmaxf(mx, shx(mx, 16, lane));
      mx = fmaxf(mx, shx(mx, 32, lane));
      const bool need = mx > mrun[c] + 8.f;
      if (__any(need)) {
        const float mnew = need ? mx : mrun[c];
        const float alpha = fexp2(mrun[c] - mnew);
        mrun[c] = mnew;
        lsum[c] *= alpha;
#pragma unroll
        for (int dv = 0; dv < 8; ++dv) o[c][dv] = o[c][dv] * alpha;
      }
      const float mref = mrun[c];
      float ps = 0.f;
#pragma unroll
      for (int kt = 0; kt < 4; ++kt) {
        s[kt] = s[kt] - mref;
#pragma unroll
        for (int j = 0; j < 4; ++j) { s[kt][j] = fexp2(s[kt][j]); ps += s[kt][j]; }
      }
      lsum[c] += ps;
      bf16x8 pf[2];
#pragma unroll
      for (int kb2 = 0; kb2 < 2; ++kb2) {
        u32x4 pk = u32x4_mk(pack2(s[2 * kb2][0], s[2 * kb2][1]), pack2(s[2 * kb2][2], s[2 * kb2][3]),
                            pack2(s[2 * kb2 + 1][0], s[2 * kb2 + 1][1]), pack2(s[2 * kb2 + 1][2], s[2 * kb2 + 1][3]));
        pf[kb2] = as_bf16x8(pk);
      }
#pragma unroll
      for (int dv = 0; dv < 8; ++dv) {
        if ((dv & 1) == 0) __builtin_amdgcn_sched_barrier(0);
#pragma unroll
        for (int kb2 = 0; kb2 < 2; ++kb2) {
          const bf16_t* vp = Vc + (dv * 16 + r16) * 72 + kb2 * 32 + g * 4;
          u32x2 v0 = *(const u32x2*)vp, v1 = *(const u32x2*)(vp + 16);
          bf16x8 vf = as_bf16x8(u32x4_mk(v0.x, v0.y, v1.x, v1.y));
          o[c][dv] = mfma16(vf, pf[kb2], o[c][dv]);
        }
      }
      __builtin_amdgcn_sched_barrier(0);
    }
    __syncthreads();
  }
  float l0 = lsum[0], l1 = lsum[1];
  l0 += shx(l0, 16, lane); l0 += shx(l0, 32, lane);
  l1 += shx(l1, 16, lane); l1 += shx(l1, 32, lane);
  const float lam = P.lamv[l];
  const float i0 = 1.f / l0, i1 = lam / l1;
  float ss = 0.f;
#pragma unroll
  for (int dv = 0; dv < 8; ++dv)
#pragma unroll
    for (int j = 0; j < 4; ++j) {
      float v = o[0][dv][j] * i0 - o[1][dv][j] * i1;
      o[0][dv][j] = v;
      ss += v * v;
    }
  ss += shx(ss, 16, lane); ss += shx(ss, 32, lane);
  const float lam_init = 0.8f - 0.6f * expf(-0.3f * (float)l);
  const float rs = rsqrtf(ss * (1.f / 128.f) + 1e-6f) * (1.f - lam_init);
#pragma unroll
  for (int dv = 0; dv < 8; ++dv) {
    const int dcol = dv * 16 + g * 4;
    float4 sg = *(const float4*)(P.subln_g + l * 128 + dcol);
    u32x2 zz = *(const u32x2*)(P.proj + (size_t)qrow * PW + CZA + h * 128 + dcol);
    float z0 = bf2f((bf16_t)(zz.x & 0xffffu)), z1 = bf2f((bf16_t)(zz.x >> 16));
    float z2 = bf2f((bf16_t)(zz.y & 0xffffu)), z3 = bf2f((bf16_t)(zz.y >> 16));
    float y0 = o[0][dv][0] * rs * sg.x * z0, y1 = o[0][dv][1] * rs * sg.y * z1;
    float y2 = o[0][dv][2] * rs * sg.z * z2, y3 = o[0][dv][3] * rs * sg.w * z3;
    if (dowrite) *(u32x2*)(P.proj + (size_t)qrow * PW + CQ + h * 128 + dcol) = u32x2_mk(pack2(y0, y1), pack2(y2, y3));
  }
}

DEV void phase_attn(const Params& P, int l, char* smem) {
  const int nattn = 2048 + (l < 3 ? 128 : 0);
  const int total = 160 + nattn;
  (void)total;
  for (int it = vb(); it < 160; it += vg()) carry_job(P, l, it);
#if PROBE_PH == 3
  { int flag = 0; asm volatile("" : "+s"(flag));
    for (int it = vg() - 1 - vb(); it < nattn; it += vg()) attn_item(P, l, it, smem, flag); }
#endif
  for (int it = vg() - 1 - vb(); it < nattn; it += vg()) attn_item(P, l, it, smem);
}


DEV void attn_item8(const Params& P, int l, int item, char* smem) {
  const int tid = tid512(), lane = tid & 63, wv = tid >> 6, r16 = lane & 15, g = lane >> 4;
  const int c = wv & 1, qg = wv >> 1;
  bf16_t* Ks = (bf16_t*)smem;
  bf16_t* Vs = Ks + 64 * 136;
  constexpr int BUFE = 64 * 136 + 128 * 72;
  float* X = (float*)(smem + SMEM_HALF);
  int b, h, qrow0, kt0, nkt;
  if (item < 1024) {
    b = item >> 7; h = (item >> 5) & 3;
    qrow0 = b * 4096 + (item & 31) * 128; kt0 = 0; nkt = 68;
  } else {
    int i2 = item - 1024;
    b = i2 >> 3; h = (i2 >> 1) & 3;
    qrow0 = NLAT + b * 256 + (i2 & 1) * 128; kt0 = 64; nkt = 4;
  }
  const int qrowb = qrow0 + qg * 32 + r16;
  bf16x8 qf[2][2];
#pragma unroll
  for (int qt = 0; qt < 2; ++qt)
#pragma unroll
    for (int kb = 0; kb < 2; ++kb)
      qf[qt][kb] = *(const bf16x8*)(P.proj + (size_t)(qrowb + qt * 16) * PW + CQ + h * 128 + c * 64 + kb * 32 + g * 8);
  f32x4 o[2][8];
#pragma unroll
  for (int qt = 0; qt < 2; ++qt)
#pragma unroll
    for (int dv = 0; dv < 8; ++dv) o[qt][dv] = f32x4{0.f, 0.f, 0.f, 0.f};
  float mrun[2] = {0.f, 0.f}, lsum[2] = {0.f, 0.f};
  const bf16_t* Vbase = P.Vt + (size_t)(b * 4 + h) * 128 * 4352;
  u32x4 rk[2], rv[2];
  auto gl = [&](int kt) {
    int krow0, vkey0;
    if (kt < 64) { krow0 = b * 4096 + kt * 64; vkey0 = kt * 64; }
    else { krow0 = NLAT + b * 256 + (kt - 64) * 64; vkey0 = 4096 + (kt - 64) * 64; }
#pragma unroll
    for (int i = 0; i < 2; ++i) {
      int cidx = tid + 512 * i;
      rk[i] = *(const u32x4*)(P.proj + (size_t)(krow0 + (cidx >> 4)) * PW + CK + h * 128 + (cidx & 15) * 8);
      rv[i] = *(const u32x4*)(Vbase + (size_t)(cidx >> 3) * 4352 + vkey0 + (cidx & 7) * 8);
    }
  };
  auto st = [&](int buf) {
    bf16_t* Kd = Ks + buf * BUFE;
    bf16_t* Vd = Vs + buf * BUFE;
#pragma unroll
    for (int i = 0; i < 2; ++i) {
      int cidx = tid + 512 * i;
      *(u32x4*)(Kd + (cidx >> 4) * 136 + (cidx & 15) * 8) = rk[i];
      *(u32x4*)(Vd + (cidx >> 3) * 72 + (cidx & 7) * 8) = rv[i];
    }
  };
  auto tile_compute = [&](const int CUR_, const bool FIRST_) {
    const bf16_t* Kc = Ks + CUR_ * BUFE;
    const bf16_t* Vc = Vs + CUR_ * BUFE;
    f32x4 s[2][4];
#pragma unroll
    for (int qt = 0; qt < 2; ++qt) {
      const float ninit = -mrun[qt];
#pragma unroll
      for (int kt = 0; kt < 4; ++kt) s[qt][kt] = f32x4{ninit, ninit, ninit, ninit};
    }
#pragma unroll
    for (int kt = 0; kt < 4; ++kt)
#pragma unroll
      for (int kb = 0; kb < 2; ++kb) {
        bf16x8 kf = *(const bf16x8*)(Kc + (kt * 16 + r16) * 136 + c * 64 + kb * 32 + g * 8);
        s[0][kt] = mfma16(kf, qf[0][kb], s[0][kt]);
        s[1][kt] = mfma16(kf, qf[1][kb], s[1][kt]);
      }
    bf16x8 pf[2][2];
#pragma unroll
    for (int qt = 0; qt < 2; ++qt) {
      float mx = fmaxf(fmaxf(s[qt][0][0], s[qt][0][1]), fmaxf(s[qt][0][2], s[qt][0][3]));
#pragma unroll
      for (int kt = 1; kt < 4; ++kt) mx = fmaxf(mx, fmaxf(fmaxf(s[qt][kt][0], s[qt][kt][1]), fmaxf(s[qt][kt][2], s[qt][kt][3])));
      const bool first = FIRST_;
      if (__any(first || mx > 8.f)) {
        mx = fmaxf(mx, shx(mx, 16, lane));
        mx = fmaxf(mx, shx(mx, 32, lane));
        const bool need = first || mx > 8.f;
        const float dm = need ? mx : 0.f;
        const float alpha = first ? 1.f : fexp2(-dm);
        mrun[qt] += dm;
        lsum[qt] *= alpha;
#pragma unroll
        for (int dv = 0; dv < 8; ++dv) o[qt][dv] = o[qt][dv] * alpha;
#pragma unroll
        for (int kt = 0; kt < 4; ++kt) s[qt][kt] = s[qt][kt] - dm;
      }
      float ps = 0.f;
#pragma unroll
      for (int kt = 0; kt < 4; ++kt)
#pragma unroll
        for (int j = 0; j < 4; ++j) { s[qt][kt][j] = fexp2(s[qt][kt][j]); ps += s[qt][kt][j]; }
      lsum[qt] += ps;
#pragma unroll
      for (int kb2 = 0; kb2 < 2; ++kb2) {
        u32x4 pk = u32x4_mk(pack2(s[qt][2 * kb2][0], s[qt][2 * kb2][1]), pack2(s[qt][2 * kb2][2], s[qt][2 * kb2][3]),
                            pack2(s[qt][2 * kb2 + 1][0], s[qt][2 * kb2 + 1][1]), pack2(s[qt][2 * kb2 + 1][2], s[qt][2 * kb2 + 1][3]));
        pf[qt][kb2] = as_bf16x8(pk);
      }
    }
    bf16x8 vfr[2][2][2];
    auto ldv = [&](int slot, int dvp) {
#pragma unroll
      for (int e = 0; e < 2; ++e)
#pragma unroll
        for (int kb2 = 0; kb2 < 2; ++kb2) {
          const bf16_t* vp = Vc + ((dvp * 2 + e) * 16 + r16) * 72 + kb2 * 32 + g * 4;
          u32x2 v0 = *(const u32x2*)vp, v1 = *(const u32x2*)(vp + 16);
          vfr[slot][e][kb2] = as_bf16x8(u32x4_mk(v0.x, v0.y, v1.x, v1.y));
        }
    };
    ldv(0, 0);
#pragma unroll
    for (int dvp = 0; dvp < 4; ++dvp) {
      if (dvp < 3) ldv((dvp + 1) & 1, dvp + 1);
      __builtin_amdgcn_sched_barrier(0);
#pragma unroll
      for (int e = 0; e < 2; ++e)
#pragma unroll
        for (int kb2 = 0; kb2 < 2; ++kb2) {
          o[0][dvp * 2 + e] = mfma16(vfr[dvp & 1][e][kb2], pf[0][kb2], o[0][dvp * 2 + e]);
          o[1][dvp * 2 + e] = mfma16(vfr[dvp & 1][e][kb2], pf[1][kb2], o[1][dvp * 2 + e]);
        }
      __builtin_amdgcn_sched_barrier(0);
    }
  };
  const int ktl = kt0 + nkt - 1;
  gl(kt0);
  __syncthreads();
  st(0);
  gl(kt0 + 1);
  st(1);
  gl(min(kt0 + 2, ktl));
  __syncthreads();
  for (int T = 0; 2 * T < nkt; ++T) {
    const int base = (T & 1) * 2, nbase = 2 - base;
    if (2 * T + 2 < nkt) st(nbase);
    gl(min(kt0 + 2 * T + 3, ktl));
    tile_compute(base, T == 0);
    if (2 * T + 3 < nkt) st(nbase + 1);
    gl(min(kt0 + 2 * T + 4, ktl));
    tile_compute(base + 1, false);
    __syncthreads();
  }
  const float lam = P.lamv[l];
#pragma unroll
  for (int qt = 0; qt < 2; ++qt) {
    float lq = lsum[qt];
    lq += shx(lq, 16, lane); lq += shx(lq, 32, lane);
    const float sc = (c == 0 ? 1.f : lam) / lq;
#pragma unroll
    for (int dv = 0; dv < 8; ++dv) o[qt][dv] = o[qt][dv] * sc;
  }
  if (c == 1) {
#pragma unroll
    for (int qt = 0; qt < 2; ++qt)
#pragma unroll
      for (int dv = 0; dv < 8; ++dv)
        *(f32x4*)(X + (size_t)((qg * 2 + qt) * 16 + r16) * 128 + dv * 16 + g * 4) = o[qt][dv];
  }
  __syncthreads();
  if (c == 0) {
    const float lam_init = 0.8f - 0.6f * expf(-0.3f * (float)l);
#pragma unroll
    for (int qt = 0; qt < 2; ++qt) {
      float ss = 0.f;
#pragma unroll
      for (int dv = 0; dv < 8; ++dv) {
        f32x4 o1 = *(const f32x4*)(X + (size_t)((qg * 2 + qt) * 16 + r16) * 128 + dv * 16 + g * 4);
        f32x4 v = o[qt][dv] - o1;
        o[qt][dv] = v;
        ss += v[0] * v[0] + v[1] * v[1] + v[2] * v[2] + v[3] * v[3];
      }
      ss += shx(ss, 16, lane); ss += shx(ss, 32, lane);
      const float rs = rsqrtf(ss * (1.f / 128.f) + 1e-6f) * (1.f - lam_init);
      const int qrow = qrowb + qt * 16;
#pragma unroll
      for (int dv = 0; dv < 8; ++dv) {
        const int dcol = dv * 16 + g * 4;
        float4 sg = *(const float4*)(P.subln_g + l * 128 + dcol);
        u32x2 zz = *(const u32x2*)(P.proj + (size_t)qrow * PW + CZA + h * 128 + dcol);
        float z0 = bf2f((bf16_t)(zz.x & 0xffffu)), z1 = bf2f((bf16_t)(zz.x >> 16));
        float z2 = bf2f((bf16_t)(zz.y & 0xffffu)), z3 = bf2f((bf16_t)(zz.y >> 16));
        float y0 = o[qt][dv][0] * rs * sg.x * z0, y1 = o[qt][dv][1] * rs * sg.y * z1;
        float y2 = o[qt][dv][2] * rs * sg.z * z2, y3 = o[qt][dv][3] * rs * sg.w * z3;
        *(u32x2*)(P.proj + (size_t)qrow * PW + CQ + h * 128 + dcol) = u32x2_mk(pack2(y0, y1), pack2(y2, y3));
      }
    }
  }
  __syncthreads();
}

DEV void phase_attn8(const Params& P, int l, char* smem_all) {
  const int nattn = 1024 + (l < 3 ? 64 : 0);
  for (int it = vb(); it < 160; it += vg()) carry_job(P, l, it);
  if (gridDim.x == 256) {
    const int xcd = (int)blockIdx.x & 7, slot = (int)blockIdx.x >> 3;
#pragma unroll 1
    for (int k = 0; k < 4; ++k) attn_item8(P, l, (k * 8 + xcd) * 32 + slot, smem_all);
    if (nattn > 1024 && (int)blockIdx.x >= 192) attn_item8(P, l, 1024 + 255 - (int)blockIdx.x, smem_all);
  } else {
    for (int it = (int)gridDim.x - 1 - (int)blockIdx.x; it < nattn; it += (int)gridDim.x) attn_item8(P, l, it, smem_all);
  }
}

DEV void phase_glu(const Params& P, int l, char* smem) {
  const int tid_ = tidx(); const int lane = tid_ & 63, w = tid_ >> 6;
  const int wm = w & 1, wn = w >> 1, r16 = lane & 15, g = lane >> 4;
  const bf16_t* Wl = P.WgT + (size_t)l * 512 * 512;
  for (int tile = vb(); tile < 16 * 16; tile += vg()) {
    const int m0 = (256 + (tile >> 4)) * 128, n0 = (tile & 15) * 32;
    f32x4 acc[4][1];
    zero_acc<1>(acc);
    gemm_main<32>(acc, P.proj + (size_t)m0 * PW + CUS, PW, Wl + (size_t)n0 * 512, 512, 512, smem);
#pragma unroll
    for (int mt = 0; mt < 4; ++mt) {
      const int m = m0 + wm * 64 + mt * 16 + r16;
#pragma unroll
      for (int nt = 0; nt < 1; ++nt) {
        const int n = n0 + wn * 16 + nt * 16 + g * 4;
        float4 bg = *(const float4*)(P.s5_b_glu + l * 512 + n);
        u32x2 gg = *(const u32x2*)(P.proj + (size_t)m * PW + CUS + n);
        u32x2 zz = *(const u32x2*)(P.proj + (size_t)m * PW + CZS + n);
        float y0 = bf2f((bf16_t)(gg.x & 0xffffu)) * sigmoidf_(acc[mt][nt][0] + bg.x) * bf2f((bf16_t)(zz.x & 0xffffu));
        float y1 = bf2f((bf16_t)(gg.x >> 16)) * sigmoidf_(acc[mt][nt][1] + bg.y) * bf2f((bf16_t)(zz.x >> 16));
        float y2 = bf2f((bf16_t)(gg.y & 0xffffu)) * sigmoidf_(acc[mt][nt][2] + bg.z) * bf2f((bf16_t)(zz.y & 0xffffu));
        float y3 = bf2f((bf16_t)(gg.y >> 16)) * sigmoidf_(acc[mt][nt][3] + bg.w) * bf2f((bf16_t)(zz.y >> 16));
        *(u32x2*)(P.proj + (size_t)m * PW + CZS + n) = u32x2_mk(pack2(y0, y1), pack2(y2, y3));
      }
    }
  }
}

DEV void phase_merge(const Params& P, int l, char* smem) {
  const int tid_ = tidx(); const int lane = tid_ & 63, w = tid_ >> 6;
  const int wm = w & 1, wn = w >> 1, r16 = lane & 15, g = lane >> 4;
  const bf16_t* Wl = P.WinT + (size_t)l * 7168 * 1024;
  for (int tile = vb(); tile < 16 * 32; tile += vg()) {
    const int m0 = (256 + (tile >> 5)) * 128, n0 = (tile & 31) * 32;
    f32x4 accM[4][1];
    zero_acc<1>(accM);
#pragma unroll 1
    for (int nb = 0; nb < 3; ++nb) {
      f32x4 accG[4][1], accY[4][1];
      zero_acc<1>(accG);
      zero_acc<1>(accY);
      gemm_main<32>(accG, P.hbuf + (size_t)m0 * 1024, 1024, Wl + (size_t)(4096 + nb * 1024 + n0) * 1024, 1024, 1024, smem);
      const int cofs = nb == 0 ? CQ : (nb == 1 ? CZR : CZS);
      gemm_main<32>(accY, P.proj + (size_t)m0 * PW + cofs, PW, P.WbT + ((size_t)(l * 3 + nb) * 1024 + n0) * 512, 512, 512, smem);
#pragma unroll
      for (int mt = 0; mt < 4; ++mt)
#pragma unroll
        for (int nt = 0; nt < 1; ++nt)
#pragma unroll
          for (int j = 0; j < 4; ++j) accM[mt][nt][j] += sigmoidf_(accG[mt][nt][j]) * accY[mt][nt][j];
    }
#pragma unroll
    for (int mt = 0; mt < 4; ++mt) {
      const int m = m0 + wm * 64 + mt * 16 + r16;
#pragma unroll
      for (int nt = 0; nt < 1; ++nt) {
        const int n = n0 + wn * 16 + nt * 16 + g * 4;
        f32x4 v = accM[mt][nt];
        *(u32x2*)(P.proj + (size_t)m * PW + CM + n) = u32x2_mk(pack2(v[0], v[1]), pack2(v[2], v[3]));
      }
    }
  }
}

DEV void phase_out(const Params& P, int l, char* smem) {
  const int tid_ = tidx(); const int lane = tid_ & 63, w = tid_ >> 6;
  const int wm = w & 1, wn = w >> 1, r16 = lane & 15, g = lane >> 4;
  const bf16_t* Wl = P.WoT + (size_t)l * 1024 * 1024;
  for (int tile = vb(); tile < 16 * 32; tile += vg()) {
    const int m0 = (256 + (tile >> 5)) * 128, n0 = (tile & 31) * 32;
    f32x4 acc[4][1];
    zero_acc<1>(acc);
    gemm_main<32>(acc, P.proj + (size_t)m0 * PW + CM, PW, Wl + (size_t)n0 * 1024, 1024, 1024, smem);
#pragma unroll
    for (int mt = 0; mt < 4; ++mt) {
      const int m = m0 + wm * 64 + mt * 16 + r16;
      const float* src;
      float* dst;
      if (m < NLAT) { src = (l == 0 ? P.x : P.out) + (size_t)m * 1024; dst = P.out + (size_t)m * 1024; }
      else { src = (l == 0 ? P.ctx : P.ctxres) + (size_t)(m - NLAT) * 1024; dst = P.ctxres + (size_t)(m - NLAT) * 1024; }
      const float* gt = P.mods + (size_t)(l * 9 + mod_row(m)) * 3072 + 2048;
#pragma unroll
      for (int nt = 0; nt < 1; ++nt) {
        const int n = n0 + wn * 16 + nt * 16 + g * 4;
        float4 xo = *(const float4*)(src + n);
        float4 gg = *(const float4*)(gt + n);
        float4 r;
        r.x = xo.x + gg.x * acc[mt][nt][0];
        r.y = xo.y + gg.y * acc[mt][nt][1];
        r.z = xo.z + gg.z * acc[mt][nt][2];
        r.w = xo.w + gg.w * acc[mt][nt][3];
        *(float4*)(dst + n) = r;
      }
    }
  }
}

DEV void phase_final(const Params& P) {
  const int tid_ = tidx(); const int lane = tid_ & 63, w = tid_ >> 6;
  const int stride = vg() * 4;
  int r = vb() * 4 + w;
  float4 v[4], vn[4];
  if (r < NLAT) {
#pragma unroll
    for (int i = 0; i < 4; ++i) v[i] = *(const float4*)(P.out + (size_t)r * 1024 + i * 256 + lane * 4);
  }
  for (; r < NLAT; r += stride) {
    const int rn = r + stride;
    if (rn < NLAT) {
#pragma unroll
      for (int i = 0; i < 4; ++i) vn[i] = *(const float4*)(P.out + (size_t)rn * 1024 + i * 256 + lane * 4);
    }
    float* src = P.out + (size_t)r * 1024;
    float ss = 0.f;
#pragma unroll
    for (int i = 0; i < 4; ++i) ss += v[i].x * v[i].x + v[i].y * v[i].y + v[i].z * v[i].z + v[i].w * v[i].w;
#pragma unroll
    for (int o = 32; o > 0; o >>= 1) ss += __shfl_xor(ss, o);
    float rstd = rsqrtf(ss * (1.f / 1024.f) + 1e-6f);
#pragma unroll
    for (int i = 0; i < 4; ++i) {
      int k = i * 256 + lane * 4;
      float4 g4 = *(const float4*)(P.final_g + k);
      float4 r4;
      r4.x = v[i].x * rstd * g4.x; r4.y = v[i].y * rstd * g4.y; r4.z = v[i].z * rstd * g4.z; r4.w = v[i].w * rstd * g4.w;
      *(float4*)(src + k) = r4;
    }
#pragma unroll
    for (int i = 0; i < 4; ++i) v[i] = vn[i];
  }
}

namespace pg8 {
#define PG8_LAS __attribute__((address_space(3)))
constexpr int BM = 256, BK = 64, HALF = 128, HTB = HALF * BK * 2, NXCD = 8, WGM = 8;
DEV int lds_byte(int r, int c) { const int st = (r >> 4) * 2 + (c >> 5), rr = r & 15, cc = c & 31, ob = rr * 64 + cc * 2; return st * 1024 + (ob ^ (((ob >> 9) & 1) << 5)); }
DEV void stage_rc(int b, int& R, int& C) { const int st = b / 1024, sb = b % 1024, swz = sb ^ (((sb >> 9) & 1) << 5); R = (st >> 1) * 16 + swz / 64; C = (st & 1) * 32 + (swz % 64) / 2; }
DEV int perm32(int rho) { const int n = rho >> 4, i = rho & 15; return 8 * (i >> 2) + 4 * n + (i & 3); }
struct Unit { int pm, pn; };
struct Gemm { const bf16_t* A; const bf16_t* Bt; int M, N, K, lda; };
struct StaticOrder {
  int nM, nN, nwg, G, c;
  DEV void init(int M, int N, int G_, int c_) { nM = M / BM; nN = N / BM; nwg = nM * nN; G = G_; c = c_; }
  DEV bool next(int i, Unit& u) const {
    const long L = (long)i * G + c; if (L >= nwg) return false;
    int wgid = (int)L; { const int q = nwg / NXCD, r = nwg % NXCD, xcd = wgid % NXCD, off = wgid / NXCD; wgid = (xcd < r ? xcd * (q + 1) : r * (q + 1) + (xcd - r) * q) + off; }
    const int nig = WGM * nN, gid = wgid / nig, fm = gid * WGM, gsz = (nM - fm) < WGM ? (nM - fm) : WGM;
    u.pm = fm + ((wgid % nig) % gsz); u.pn = (wgid % nig) / gsz; return true;
  }
};
template <class Epi>
DEV void gemm_phase(PG8_LAS unsigned char* lds, const Gemm g, const StaticOrder& S, const Epi& E) {
  const int tid = tid512(), wid = __builtin_amdgcn_readfirstlane(tid >> 6), lane = tid & 63, wr = wid >> 2, wc = wid & 3, fr = lane & 15, fq = lane >> 4;
  const int K = g.K, nt = K / BK, lda = g.lda;
  unsigned voffA[2], voffB[2];
#pragma unroll
  for (int i = 0; i < 2; ++i) { int R, C; stage_rc(tid * 16 + i * 8192, R, C);
    const int Rb = (R & ~31) + perm32(R & 31);
    voffA[i] = (unsigned)(R * lda + C) * 2u; voffB[i] = (unsigned)(Rb * K + C) * 2u; }
  const size_t kstep = (size_t)(BK * 2);
  const size_t hstepA = (size_t)HALF * lda * 2, hstepB = (size_t)HALF * K * 2;
  const size_t tstepA = 2 * hstepA, tstepB = 2 * hstepB;
  const unsigned ldsw = (unsigned)wid * 1024u;
  const int aoff = lds_byte(wr * 64 + fr, fq * 8), boff = lds_byte(wc * 32 + fr, fq * 8);
#define PG8_SA(b, h) (((b) * 2 + (h)) * HTB)
#define PG8_SB(b, h) ((4 + (b) * 2 + (h)) * HTB)
#define PG8_STAGE(bufoff, gbase, voff) do { _Pragma("unroll") for (int _i = 0; _i < 2; ++_i) \
    __builtin_amdgcn_global_load_lds((const unsigned*)((const char*)(gbase) + (voff)[_i]), (PG8_LAS unsigned*)(lds + (bufoff) + ldsw + _i * 8192), 16, 0, 0); } while (0)
#define PG8_LDA(dst, b, h) do { _Pragma("unroll") for (int m = 0; m < 4; ++m) _Pragma("unroll") for (int k = 0; k < 2; ++k) dst[m][k] = *(const PG8_LAS bf16x8*)(lds + PG8_SA(b, h) + aoff + m * 2048 + k * 1024); } while (0)
#define PG8_LDB(dst, b, h) do { _Pragma("unroll") for (int n = 0; n < 2; ++n) _Pragma("unroll") for (int k = 0; k < 2; ++k) dst[n][k] = *(const PG8_LAS bf16x8*)(lds + PG8_SB(b, h) + boff + n * 2048 + k * 1024); } while (0)
#define PG8_MMA(ai, bj, At, Bt) do { __builtin_amdgcn_s_setprio(1); _Pragma("unroll") for (int m = 0; m < 4; ++m) _Pragma("unroll") for (int n = 0; n < 2; ++n) _Pragma("unroll") for (int k = 0; k < 2; ++k) \
    acc[ai][bj][m][n] = __builtin_amdgcn_mfma_f32_16x16x32_bf16(Bt[n][k], At[m][k], acc[ai][bj][m][n], 0, 0, 0); __builtin_amdgcn_s_setprio(0); } while (0)
#define PG8_WAIT_V(n) asm volatile("s_waitcnt vmcnt(" #n ")" ::: "memory")
#define PG8_WAIT_L(n) asm volatile("s_waitcnt lgkmcnt(" #n ")" ::: "memory")
#define PG8_BAR __builtin_amdgcn_s_barrier()
#define PG8_SCHED __builtin_amdgcn_sched_barrier(0)
  Unit cur, nxt; int ui = 0;
  if (!S.next(0, cur)) return;
  f32x4 acc[2][2][4][2];
#pragma unroll
  for (int a = 0; a < 2; ++a)
#pragma unroll
    for (int b = 0; b < 2; ++b)
#pragma unroll
      for (int m = 0; m < 4; ++m)
#pragma unroll
        for (int n = 0; n < 2; ++n) acc[a][b][m][n] = f32x4{0.f, 0.f, 0.f, 0.f};
  bf16x8 At[4][2], B0[2][2], B1[2][2];
  const char* cA = (const char*)g.A + (size_t)cur.pm * tstepA; const char* cB = (const char*)g.Bt + (size_t)cur.pn * tstepB;
  PG8_STAGE(PG8_SB(0, 0), cB, voffB); PG8_STAGE(PG8_SA(0, 0), cA, voffA); PG8_STAGE(PG8_SB(0, 1), cB + hstepB, voffB); PG8_STAGE(PG8_SA(0, 1), cA + hstepA, voffA);
  if (wr == 1) PG8_BAR;
  PG8_WAIT_V(4); PG8_BAR;
  PG8_STAGE(PG8_SB(1, 0), cB + kstep, voffB); PG8_STAGE(PG8_SA(1, 0), cA + kstep, voffA); PG8_STAGE(PG8_SB(1, 1), cB + hstepB + kstep, voffB);
  PG8_WAIT_V(6); PG8_BAR;
  for (;;) {
    const bool has_next = S.next(ui + 1, nxt);
    const char* nA = has_next ? (const char*)g.A + (size_t)nxt.pm * tstepA : cA; const char* nB = has_next ? (const char*)g.Bt + (size_t)nxt.pn * tstepB : cB;
    for (int t = 0; t < nt; t += 2) {
      const bool last = (t == nt - 2);
      const char* a1 = cA + (size_t)(t + 1) * kstep;
      const char* a2 = last ? nA : cA + (size_t)(t + 2) * kstep; const char* b2 = last ? nB : cB + (size_t)(t + 2) * kstep;
      const char* a3 = a2 + kstep; const char* b3 = b2 + kstep;
      PG8_LDB(B0, 0, 0); PG8_SCHED; PG8_LDA(At, 0, 0); PG8_STAGE(PG8_SA(1, 1), a1 + hstepA, voffA);
      PG8_WAIT_L(8); PG8_BAR; PG8_WAIT_L(0); PG8_MMA(0, 0, At, B0); PG8_BAR; PG8_SCHED;
      PG8_LDB(B1, 0, 1); PG8_STAGE(PG8_SB(0, 0), b2, voffB);
      PG8_BAR; PG8_WAIT_L(0); PG8_MMA(0, 1, At, B1); PG8_BAR;
      PG8_LDA(At, 0, 1); PG8_STAGE(PG8_SA(0, 0), a2, voffA);
      PG8_BAR; PG8_WAIT_L(0); PG8_MMA(1, 0, At, B0); PG8_BAR; PG8_SCHED;
      PG8_STAGE(PG8_SB(0, 1), b2 + hstepB, voffB);
      PG8_WAIT_V(6); PG8_BAR; PG8_MMA(1, 1, At, B1); PG8_BAR;
      PG8_LDB(B0, 1, 0); PG8_SCHED; PG8_LDA(At, 1, 0); PG8_STAGE(PG8_SA(0, 1), a2 + hstepA, voffA);
      PG8_WAIT_L(8); PG8_BAR; PG8_WAIT_L(0); PG8_MMA(0, 0, At, B0); PG8_BAR; PG8_SCHED;
      PG8_LDB(B1, 1, 1); PG8_STAGE(PG8_SB(1, 0), b3, voffB);
      PG8_BAR; PG8_WAIT_L(0); PG8_MMA(0, 1, At, B1); PG8_BAR;
      PG8_LDA(At, 1, 1); PG8_STAGE(PG8_SA(1, 0), a3, voffA);
      PG8_BAR; PG8_WAIT_L(0); PG8_MMA(1, 0, At, B0); PG8_BAR; PG8_SCHED;
      PG8_STAGE(PG8_SB(1, 1), b3 + hstepB, voffB);
      PG8_WAIT_V(6); PG8_BAR; PG8_MMA(1, 1, At, B1); PG8_BAR;
    }
    E(acc, cur, wr, wc, fr, fq);
    if (!has_next) break;
#pragma unroll
    for (int a = 0; a < 2; ++a)
#pragma unroll
      for (int b = 0; b < 2; ++b)
#pragma unroll
        for (int m = 0; m < 4; ++m)
#pragma unroll
          for (int n = 0; n < 2; ++n) acc[a][b][m][n] = f32x4{0.f, 0.f, 0.f, 0.f};
    cur = nxt; cA = nA; cB = nB; ++ui;
  }
  PG8_WAIT_V(0);
  if (wr == 0) PG8_BAR;
  PG8_BAR;
#undef PG8_SA
#undef PG8_SB
#undef PG8_STAGE
#undef PG8_LDA
#undef PG8_LDB
#undef PG8_MMA
#undef PG8_WAIT_V
#undef PG8_WAIT_L
#undef PG8_BAR
#undef PG8_SCHED
}
}

DEV u32x4 pack8(const f32x4& v0, const f32x4& v1) { return u32x4_mk(pack2(v0[0], v0[1]), pack2(v0[2], v0[3]), pack2(v1[0], v1[1]), pack2(v1[2], v1[3])); }
DEV float bflo(unsigned w) { return __uint_as_float(w << 16); }
DEV float bfhi(unsigned w) { return __uint_as_float(w & 0xffff0000u); }
struct EpiProj {
  const Params* Pp; int l;
  DEV void operator()(const f32x4 (&acc)[2][2][4][2], const pg8::Unit& u, int wr, int wc, int fr, int fq) const {
    const Params& P = *Pp;
    const float QS = 0.125f * 1.4426950408889634f;
#pragma unroll
    for (int ai = 0; ai < 2; ++ai)
#pragma unroll
      for (int mm = 0; mm < 4; ++mm) {
        const int m = u.pm * 256 + ai * 128 + wr * 64 + mm * 16 + fr;
#pragma unroll
        for (int bj = 0; bj < 2; ++bj) {
          const int region = (u.pn * 256 + bj * 128) >> 9;
          const int n8 = u.pn * 256 + bj * 128 + wc * 32 + 8 * fq;
          f32x4 v0 = acc[ai][bj][mm][0], v1 = acc[ai][bj][mm][1];
          if (region <= 1) {
            if (m < NLAT) {
              const int t = m & 4095;
              const int i0 = (n8 & 63) >> 1;
              const float4 c0 = *(const float4*)(P.rope + (size_t)t * 32 + i0);
              const float4 c1 = *(const float4*)(P.rope + (size_t)t * 32 + i0 + 2);
              v0 = f32x4{v0[0] * c0.x - v0[1] * c0.y, v0[0] * c0.y + v0[1] * c0.x, v0[2] * c0.z - v0[3] * c0.w, v0[2] * c0.w + v0[3] * c0.z};
              v1 = f32x4{v1[0] * c1.x - v1[1] * c1.y, v1[0] * c1.y + v1[1] * c1.x, v1[2] * c1.z - v1[3] * c1.w, v1[2] * c1.w + v1[3] * c1.z};
            }
            if (region == 0) { v0 = v0 * QS; v1 = v1 * QS; }
            *(u32x4*)(P.proj + (size_t)m * PW + n8) = pack8(v0, v1);
          } else if (region == 2) {
            int b, key;
            if (m < NLAT) { b = m >> 12; key = m & 4095; }
            else { b = (m - NLAT) >> 8; key = 4096 + ((m - NLAT) & 255); }
            bf16_t* vp = P.Vt + ((size_t)b * 512 + (n8 - 1024)) * 4352 + key;
#pragma unroll
            for (int j = 0; j < 4; ++j) { vp[(size_t)j * 4352] = f2bf(v0[j]); vp[(size_t)(4 + j) * 4352] = f2bf(v1[j]); }
          } else {
            if (region == 3 || region == 5 || region == 7) {
#pragma unroll
              for (int j = 0; j < 4; ++j) { v0[j] = siluf_(v0[j]); v1[j] = siluf_(v1[j]); }
            }
            *(u32x4*)(P.proj + (size_t)m * PW + n8) = pack8(v0, v1);
          }
        }
      }
  }
};
struct EpiGlu {
  const Params* Pp; int l;
  DEV void operator()(const f32x4 (&acc)[2][2][4][2], const pg8::Unit& u, int wr, int wc, int fr, int fq) const {
    const Params& P = *Pp;
#pragma unroll
    for (int ai = 0; ai < 2; ++ai)
#pragma unroll
      for (int mm = 0; mm < 4; ++mm) {
        const int m = u.pm * 256 + ai * 128 + wr * 64 + mm * 16 + fr;
#pragma unroll
        for (int bj = 0; bj < 2; ++bj) {
          const int n8 = u.pn * 256 + bj * 128 + wc * 32 + 8 * fq;
          const f32x4 a0 = acc[ai][bj][mm][0], a1 = acc[ai][bj][mm][1];
          const float4 b0 = *(const float4*)(P.s5_b_glu + l * 512 + n8), b1 = *(const float4*)(P.s5_b_glu + l * 512 + n8 + 4);
          const u32x4 gg = *(const u32x4*)(P.proj + (size_t)m * PW + CUS + n8);
          const u32x4 zz = *(const u32x4*)(P.proj + (size_t)m * PW + CZS + n8);
          f32x4 y0, y1;
          y0[0] = bflo(gg.x) * sigmoidf_(a0[0] + b0.x) * bflo(zz.x); y0[1] = bfhi(gg.x) * sigmoidf_(a0[1] + b0.y) * bfhi(zz.x);
          y0[2] = bflo(gg.y) * sigmoidf_(a0[2] + b0.z) * bflo(zz.y); y0[3] = bfhi(gg.y) * sigmoidf_(a0[3] + b0.w) * bfhi(zz.y);
          y1[0] = bflo(gg.z) * sigmoidf_(a1[0] + b1.x) * bflo(zz.z); y1[1] = bfhi(gg.z) * sigmoidf_(a1[1] + b1.y) * bfhi(zz.z);
          y1[2] = bflo(gg.w) * sigmoidf_(a1[2] + b1.z) * bflo(zz.w); y1[3] = bfhi(gg.w) * sigmoidf_(a1[3] + b1.w) * bfhi(zz.w);
          *(u32x4*)(P.proj + (size_t)m * PW + CZS + n8) = pack8(y0, y1);
        }
      }
  }
};
struct EpiOut {
  const Params* Pp; int l;
  DEV void operator()(const f32x4 (&acc)[2][2][4][2], const pg8::Unit& u, int wr, int wc, int fr, int fq) const {
    const Params& P = *Pp;
#pragma unroll
    for (int ai = 0; ai < 2; ++ai)
#pragma unroll
      for (int mm = 0; mm < 4; ++mm) {
        const int m = u.pm * 256 + ai * 128 + wr * 64 + mm * 16 + fr;
        const float* src;
        float* dst;
        if (m < NLAT) { src = (l == 0 ? P.x : P.out) + (size_t)m * 1024; dst = P.out + (size_t)m * 1024; }
        else { src = (l == 0 ? P.ctx : P.ctxres) + (size_t)(m - NLAT) * 1024; dst = P.ctxres + (size_t)(m - NLAT) * 1024; }
        const float* gt = P.mods + (size_t)(l * 9 + mod_row(m)) * 3072 + 2048;
#pragma unroll
        for (int bj = 0; bj < 2; ++bj) {
          const int n8 = u.pn * 256 + bj * 128 + wc * 32 + 8 * fq;
#pragma unroll
          for (int nn = 0; nn < 2; ++nn) {
            const f32x4 a = acc[ai][bj][mm][nn];
            const int n = n8 + 4 * nn;
            float4 xo = *(const float4*)(src + n);
            float4 gg = *(const float4*)(gt + n);
            float4 r;
            r.x = xo.x + gg.x * a[0];
            r.y = xo.y + gg.y * a[1];
            r.z = xo.z + gg.z * a[2];
            r.w = xo.w + gg.w * a[3];
            *(float4*)(dst + n) = r;
          }
        }
      }
  }
};
struct EpiYB {
  const Params* Pp; int l;
  DEV void operator()(const f32x4 (&acc)[2][2][4][2], const pg8::Unit& u, int wr, int wc, int fr, int fq) const {
    const Params& P = *Pp;
#pragma unroll
    for (int ai = 0; ai < 2; ++ai)
#pragma unroll
      for (int mm = 0; mm < 4; ++mm) {
        const int m = u.pm * 256 + ai * 128 + wr * 64 + mm * 16 + fr;
#pragma unroll
        for (int bj = 0; bj < 2; ++bj) {
          const int n8 = u.pn * 256 + bj * 128 + wc * 32 + 8 * fq;
          *(u32x4*)(P.proj + (size_t)m * PW + CZA + n8) = pack8(acc[ai][bj][mm][0], acc[ai][bj][mm][1]);
        }
      }
  }
};
struct EpiGate {
  const Params* Pp; int nb;
  DEV void operator()(const f32x4 (&acc)[2][2][4][2], const pg8::Unit& u, int wr, int wc, int fr, int fq) const {
    const Params& P = *Pp;
#pragma unroll
    for (int ai = 0; ai < 2; ++ai)
#pragma unroll
      for (int mm = 0; mm < 4; ++mm) {
        const int m = u.pm * 256 + ai * 128 + wr * 64 + mm * 16 + fr;
#pragma unroll
        for (int bj = 0; bj < 2; ++bj) {
          const int n8 = u.pn * 256 + bj * 128 + wc * 32 + 8 * fq;
          const f32x4 a0 = acc[ai][bj][mm][0], a1 = acc[ai][bj][mm][1];
          const u32x4 yb = *(const u32x4*)(P.proj + (size_t)m * PW + CZA + n8);
          f32x4 v0, v1;
          v0[0] = sigmoidf_(a0[0]) * bflo(yb.x); v0[1] = sigmoidf_(a0[1]) * bfhi(yb.x);
          v0[2] = sigmoidf_(a0[2]) * bflo(yb.y); v0[3] = sigmoidf_(a0[3]) * bfhi(yb.y);
          v1[0] = sigmoidf_(a1[0]) * bflo(yb.z); v1[1] = sigmoidf_(a1[1]) * bfhi(yb.z);
          v1[2] = sigmoidf_(a1[2]) * bflo(yb.w); v1[3] = sigmoidf_(a1[3]) * bfhi(yb.w);
          if (nb > 0) {
            const u32x4 pv = *(const u32x4*)(P.proj + (size_t)m * PW + CM + n8);
            v0[0] += bflo(pv.x); v0[1] += bfhi(pv.x); v0[2] += bflo(pv.y); v0[3] += bfhi(pv.y);
            v1[0] += bflo(pv.z); v1[1] += bfhi(pv.z); v1[2] += bflo(pv.w); v1[3] += bfhi(pv.w);
          }
          *(u32x4*)(P.proj + (size_t)m * PW + CM + n8) = pack8(v0, v1);
        }
      }
  }
};
template <class Epi>
DEV void engine_gemm_e(const Epi& E, char* smem, const bf16_t* A, int lda, const bf16_t* Bt, int M, int N, int K) {
  pg8::Gemm g{A, Bt, M, N, K, lda};
  pg8::StaticOrder S;
  S.init(M, N, (int)gridDim.x, (int)blockIdx.x);
  pg8::gemm_phase<Epi>((PG8_LAS unsigned char*)smem, g, S, E);
}
template <class Epi>
DEV void engine_gemm(const Params& P, int l, char* smem, const bf16_t* A, int lda, const bf16_t* Bt, int M, int N, int K) {
  Epi E{&P, l};
  engine_gemm_e<Epi>(E, smem, A, lda, Bt, M, N, K);
}
DEV void engine_merge(const Params& P, int l, char* smem, int M) {
#pragma unroll 1
  for (int nb = 0; nb < 3; ++nb) {
    const int cofs = nb == 0 ? CQ : (nb == 1 ? CZR : CZS);
    EpiYB ey{&P, l};
    engine_gemm_e<EpiYB>(ey, smem, P.proj + cofs, PW, P.WbT + (size_t)(l * 3 + nb) * 1024 * 512, M, 1024, 512);
    EpiGate eg{&P, nb};
    engine_gemm_e<EpiGate>(eg, smem, P.hbuf, 1024, P.WinT + ((size_t)l * 7168 + 4096 + nb * 1024) * 1024, M, 1024, 1024);
  }
}

#define XB_TMO      128
#define XB_XCNT(j)  (256  + 64 * (j))
#define XB_XSUB(j)  (1280 + 64 * (j))
#define XB_XGEN(j)  (2304 + 64 * (j))
#define XB_TOP      3328
#define XB_TOPGEN   3392
#define XCD_BAR_WORDS 3456
#define XB_SPIN_CAP (1u << 18)
#define LAS __attribute__((address_space(3)))

__device__ __forceinline__ unsigned xb_ld(unsigned* p)              { return __hip_atomic_load(p, __ATOMIC_RELAXED, __HIP_MEMORY_SCOPE_AGENT); }
__device__ __forceinline__ unsigned xb_add(unsigned* p, unsigned v) { return __hip_atomic_fetch_add(p, v, __ATOMIC_RELAXED, __HIP_MEMORY_SCOPE_AGENT); }
__device__ __forceinline__ unsigned xb_xcc_id() { return (unsigned)__builtin_amdgcn_s_getreg((3 << 11) | 20) & 0xFu; }
#define XB_SPIN(cond, bar) do { unsigned _sp = 0; while (cond) { __builtin_amdgcn_s_sleep(1); \
    if ((++_sp & 255u) == 0u) { if (xb_ld(&(bar)[XB_TMO])) break; if (_sp > XB_SPIN_CAP) { atomicAdd(&(bar)[XB_TMO], 1u); break; } } } } while (0)

struct XcdBarrier {
    unsigned* bar; unsigned x;
    volatile LAS unsigned* st;
};

__device__ __forceinline__ XcdBarrier xcd_barrier_post(unsigned* bar, volatile LAS unsigned* st) {
    XcdBarrier b; b.bar = bar; b.x = xb_xcc_id(); b.st = st;
    if (threadIdx.x == 0) (void)xb_add(&bar[XB_XCNT(b.x)], 1u);
    return b;
}
__device__ __forceinline__ void xcd_barrier_complete(unsigned* bar, unsigned x, unsigned& nloc, unsigned& nx) {
    const unsigned G = gridDim.x * gridDim.y * gridDim.z;
    unsigned sum, cnt, mine, sp = 0u;
    for (;;) {
        sum = 0u; cnt = 0u; mine = 0u;
#pragma unroll
        for (unsigned j = 0; j < 16; ++j) { const unsigned c = xb_ld(&bar[XB_XCNT(j)]); sum += c; cnt += (c > 0u) ? 1u : 0u; mine = (j == x) ? c : mine; }
        if (sum == G) break;
        __builtin_amdgcn_s_sleep(1);
        if ((++sp & 255u) == 0u) { if (xb_ld(&bar[XB_TMO])) break; if (sp > XB_SPIN_CAP) { atomicAdd(&bar[XB_TMO], 1u); break; } }
    }
    nloc = mine > 0u ? mine : 1u; nx = cnt > 0u ? cnt : 1u;
}

__device__ __forceinline__ void xcd_barrier(const XcdBarrier& b) {
    asm volatile("s_waitcnt vmcnt(0)" ::: "memory");
    __syncthreads();
    if (threadIdx.x == 0) {
        unsigned* bar = b.bar;
        __builtin_amdgcn_s_waitcnt(0);
        unsigned nloc = b.st[0], nx = b.st[1];
        if (nloc == 0u) { xcd_barrier_complete(bar, b.x, nloc, nx); b.st[0] = nloc; b.st[1] = nx; }
        const unsigned old = xb_add(&bar[XB_XSUB(b.x)], 1u);
        const unsigned gen = old / nloc;
        if (old + 1u == (gen + 1u) * nloc) {
            __builtin_amdgcn_fence(__ATOMIC_RELEASE, "agent");
            asm volatile("s_waitcnt vmcnt(0)" ::: "memory");
            const unsigned og = xb_add(&bar[XB_TOP], 1u);
            const unsigned tg = og / nx;
            if (og + 1u == (tg + 1u) * nx) xb_add(&bar[XB_TOPGEN], 1u);
            else XB_SPIN(xb_ld(&bar[XB_TOPGEN]) == tg, bar);
            __builtin_amdgcn_fence(__ATOMIC_ACQUIRE, "agent");
            xb_add(&bar[XB_XGEN(b.x)], 1u);
            asm volatile("s_waitcnt vmcnt(0)" ::: "memory");
        } else {
            XB_SPIN(xb_ld(&bar[XB_XGEN(b.x)]) == gen, bar);
            __builtin_amdgcn_fence(__ATOMIC_ACQUIRE, "agent");
            asm volatile("s_waitcnt vmcnt(0)" ::: "memory");
        }
    }
    __syncthreads();
}


#ifndef PROBE_PH
#define PROBE_PH -1
#endif
#define REPEAT(id, body) { int nrep_ = (PROBE_PH == (id)) ? 2 : 1; asm volatile("" : "+s"(nrep_)); _Pragma("unroll 1") for (int rep_ = 0; rep_ < nrep_; ++rep_) { body } }
__global__ void __launch_bounds__(512, 2) mega_kernel(Params P) {
  __shared__ __attribute__((aligned(16))) char smem_all[SMEM_BYTES];
  cg::grid_group grid = cg::this_grid();
  char* smem = smem_all + vhalf() * SMEM_HALF;
  __shared__ __attribute__((aligned(16))) unsigned xb_st[4];
  if (threadIdx.x < 4) xb_st[threadIdx.x] = 0u;
  __syncthreads();
  const XcdBarrier xb = xcd_barrier_post(P.bar, (volatile LAS unsigned*)xb_st);
  REPEAT(0, phase0(P, smem); grid.sync();)
#pragma unroll 1
  for (int l = 0; l < 4; ++l) {
    REPEAT(5, phase_norm(P, l); xcd_barrier(xb);)
    engine_gemm<EpiProj>(P, l, smem_all, P.hbuf, 1024, P.WinT + (size_t)l * 7168 * 1024, NR, 4096, 1024);
    if (l < 3 && gridDim.x == 256 && blockIdx.x >= 128) prep_layer_weights(P, l + 1, ((int)blockIdx.x - 128) * 2 + vhalf(), 256, smem);
    if (l < 3 && gridDim.x != 256) prep_layer_weights(P, l + 1, vb(), vg(), smem);
    xcd_barrier(xb);
#if PROBE_PH == 1
    engine_gemm<EpiProj>(P, l, smem_all, P.hbuf, 1024, P.WinT + (size_t)l * 7168 * 1024, NR, 4096, 1024);
    xcd_barrier(xb);
#endif
    REPEAT(2, phase_scan(P, l, false, smem); xcd_barrier(xb);)
    phase_attn8(P, l, smem_all);
    xcd_barrier(xb);
    phase_scan(P, l, true, smem);
    xcd_barrier(xb);
    engine_gemm<EpiGlu>(P, l, smem_all, P.proj + CUS, PW, P.WgT + (size_t)l * 512 * 512, NLAT, 512, 512);
    if (l < 3) phase_glu(P, l, smem);
    xcd_barrier(xb);
    engine_merge(P, l, smem_all, NLAT);
    if (l < 3) phase_merge(P, l, smem);
    xcd_barrier(xb);
#if PROBE_PH == 4
    engine_merge(P, l, smem_all, Mrows);
    xcd_barrier(xb);
#endif
    engine_gemm<EpiOut>(P, l, smem_all, P.proj + CM, PW, P.WoT + (size_t)l * 1024 * 1024, NLAT, 1024, 1024);
    if (l < 3) phase_out(P, l, smem);
    xcd_barrier(xb);
  }
  phase_final(P);
}

extern "C" void kernel_launch(void* const* d_in, const int* in_sizes, int n_in, void* d_out, int out_size, void* d_ws,
                              size_t ws_size, hipStream_t stream) {
  Params p{};
  const float** fp = (const float**)&p;
  for (int i = 0; i < 30; ++i) fp[i] = (const float*)d_in[i];
  p.out = (float*)d_out;
  char* ws = (char*)d_ws;
  size_t off = 0;
  auto take = [&](size_t bytes) { char* r = ws + off; off += (bytes + 255) & ~(size_t)255; return r; };
  p.proj = (bf16_t*)take((size_t)NR * PW * 2);
  p.hbuf = (bf16_t*)take((size_t)NR * 1024 * 2);
  p.WinT = (bf16_t*)take((size_t)4 * 7168 * 1024 * 2);
  p.WbT = (bf16_t*)take((size_t)12 * 1024 * 512 * 2);
  p.WoT = (bf16_t*)take((size_t)4 * 1024 * 1024 * 2);
  p.WgT = (bf16_t*)take((size_t)4 * 512 * 512 * 2);
  p.WlT = (bf16_t*)take((size_t)128 * 4096 * 2);
  p.Vt = (bf16_t*)take((size_t)32 * 128 * 4352 * 2);
  p.ctxres = (float*)take((size_t)2048 * 1024 * 4);
  p.mods = (float*)take((size_t)4 * 9 * 3072 * 4);
  p.lamv = (float*)take(256);
  p.lruP = (float*)take((size_t)2 * NCH * 512 * 4);
  p.lruS = (float*)take((size_t)2 * NCH * 512 * 4);
  p.rope = (float2*)take((size_t)4096 * 32 * 8);
  p.s5A = (float2*)take((size_t)256 * 64 * 8);
  p.s5A64 = (float2*)take((size_t)256 * 64 * 8);
  p.s5E = (float2*)take((size_t)2 * NCH * 32 * 64 * 8);
  p.s5drvB = (u32x4*)take((size_t)256 * 8 * 64 * 16);
  p.s5C = (u32x4*)take((size_t)128 * 4 * 64 * 16);
  p.bar = (unsigned*)take((size_t)XCD_BAR_WORDS * 4);
  if (off > ws_size) { fprintf(stderr, "workspace too small: need %zu have %zu\n", off, ws_size); return; }

  static int grid_blocks = 0;
  if (!grid_blocks) {
    int dev = 0, cus = 0, per_cu = 0;
    (void)hipGetDevice(&dev);
    (void)hipDeviceGetAttribute(&cus, hipDeviceAttributeMultiprocessorCount, dev);
    (void)hipOccupancyMaxActiveBlocksPerMultiprocessor(&per_cu, mega_kernel, 512, 0);
    if (per_cu < 1) per_cu = 1;
    if (per_cu > 1) per_cu = 1;
    grid_blocks = cus * per_cu;
  }
  (void)hipMemsetAsync(p.bar, 0, (size_t)XCD_BAR_WORDS * 4, stream);
  void* args[] = {&p};
  hipError_t e = hipLaunchCooperativeKernel((void*)mega_kernel, dim3(grid_blocks), dim3(512), args, 0, stream);
  if (e != hipSuccess) fprintf(stderr, "cooperative launch failed: %s (grid %d)\n", hipGetErrorString(e), grid_blocks);
}
```

```cpp
#include <hip/hip_runtime.h>
#include <hip/hip_bf16.h>
#include <hip/hip_cooperative_groups.h>
#include <cstdio>
#include <cstdint>
namespace cg = cooperative_groups;

#ifndef MULTI_LAUNCH
#define MULTI_LAUNCH 0
#endif

#define DEV __device__ __forceinline__
typedef unsigned short bf16_t;
using bf16x8 = __attribute__((ext_vector_type(8))) short;
using f32x4 = __attribute__((ext_vector_type(4))) float;
using u32x4 = __attribute__((ext_vector_type(4))) unsigned;
using u32x2 = __attribute__((ext_vector_type(2))) unsigned;

constexpr int NR = 34816;
constexpr int NLAT = 32768;
constexpr int PW = 4096;
constexpr int CQ = 0, CK = 512, CZA = 1536, CXR = 2048, CZR = 2560, CUS = 3072, CZS = 3584, CM = 512;
constexpr int NCH = 544;
constexpr int NPHASE = 34;
constexpr int SMEM_HALF = 73728;
constexpr int SMEM_BYTES = 2 * SMEM_HALF;

struct Params {
  const float *x, *c, *ctx, *c_ctx, *w_mod, *b_mod, *norm_g, *w_in, *lam_qk, *subln_g, *conv_w, *conv_b,
      *lru_wa, *lru_ba, *lru_wx, *lru_bx, *lru_lam, *s5_lam_re, *s5_lam_im, *s5_log_dt, *s5_b_re, *s5_b_im,
      *s5_c_re, *s5_c_im, *s5_d, *s5_w_glu, *s5_b_glu, *w_branch, *w_out, *final_g;
  float* out;
  bf16_t *proj, *hbuf, *WinT, *WbT, *WoT, *WgT, *WlT, *Vt;
  float *ctxres, *mods, *lamv, *lruP, *lruS;
  float2 *rope, *s5A, *s5A64, *s5E;
  u32x4 *s5drvB, *s5C;
  unsigned* bar;
};

DEV int tidx() { int t = threadIdx.x & 255; asm volatile("" : "+v"(t)); return t; }
DEV int tid512() { int t = threadIdx.x; asm volatile("" : "+v"(t)); return t; }
DEV int vhalf() { return __builtin_amdgcn_readfirstlane((int)(threadIdx.x >> 8)); }
DEV int vb() { return (int)blockIdx.x * 2 + vhalf(); }
DEV int vg() { return (int)gridDim.x * 2; }
DEV u32x4 u32x4_mk(unsigned a, unsigned b, unsigned c, unsigned d) { return u32x4{a, b, c, d}; }
DEV u32x2 u32x2_mk(unsigned a, unsigned b) { return u32x2{a, b}; }
typedef float f32x2_t __attribute__((ext_vector_type(2)));
typedef __bf16 bf16x2_t __attribute__((ext_vector_type(2)));
DEV bf16_t f2bf(float f) { return __builtin_bit_cast(unsigned short, (__bf16)f); }
DEV float bf2f(bf16_t h) { return __uint_as_float(((unsigned)h) << 16); }
DEV unsigned pack2(float a, float b) {
  f32x2_t v = {a, b};
  return __builtin_bit_cast(unsigned, __builtin_convertvector(v, bf16x2_t));
}
DEV float fexp2(float x) { return __builtin_amdgcn_exp2f(x); }
DEV float frcp(float x) { return __builtin_amdgcn_rcpf(x); }
DEV float sigmoidf_(float x) { return frcp(1.f + __expf(-x)); }
DEV float siluf_(float x) { return x * frcp(1.f + __expf(-x)); }
DEV float gelu_tanh(float x) {
  float u = 0.7978845608028654f * (x + 0.044715f * x * x * x);
  return x * frcp(1.f + __expf(-2.f * u));
}
DEV float shx(float v, int mask, int lane) { return __int_as_float(__builtin_amdgcn_ds_bpermute((lane ^ mask) << 2, __float_as_int(v))); }
DEV float shi(float v, int src) { return __int_as_float(__builtin_amdgcn_ds_bpermute(src << 2, __float_as_int(v))); }
DEV f32x4 mfma16(bf16x8 a, bf16x8 b, f32x4 c) { return __builtin_amdgcn_mfma_f32_16x16x32_bf16(a, b, c, 0, 0, 0); }
DEV bf16x8 as_bf16x8(u32x4 v) {
  return __builtin_bit_cast(bf16x8, v);
}

template <int NTW>
DEV void g_load(u32x4 (&ra)[4], u32x4 (&rw)[NTW], const bf16_t* __restrict__ A, int lda, const bf16_t* __restrict__ W,
                int ldw, int k0, int lrow, int loff) {
#pragma unroll
  for (int i = 0; i < 4; ++i) ra[i] = *(const u32x4*)(A + (size_t)(lrow + 32 * i) * lda + k0 + loff);
#pragma unroll
  for (int i = 0; i < NTW; ++i) rw[i] = *(const u32x4*)(W + (size_t)(lrow + 32 * i) * ldw + k0 + loff);
}
template <int NTW>
DEV void s_store(const u32x4 (&ra)[4], const u32x4 (&rw)[NTW], bf16_t* As, bf16_t* Ws, int lrow, int loff) {
#pragma unroll
  for (int i = 0; i < 4; ++i) *(u32x4*)(As + (lrow + 32 * i) * 72 + loff) = ra[i];
#pragma unroll
  for (int i = 0; i < NTW; ++i) *(u32x4*)(Ws + (lrow + 32 * i) * 72 + loff) = rw[i];
}
template <int BN>
DEV void g_compute(f32x4 (&acc)[4][BN / 32], const bf16_t* As, const bf16_t* Ws, int wm, int wn, int r16, int g) {
  constexpr int NTW = BN / 32;
#pragma unroll
  for (int kb = 0; kb < 2; ++kb) {
    bf16x8 af[4], wf[NTW];
#pragma unroll
    for (int mt = 0; mt < 4; ++mt) af[mt] = *(const bf16x8*)(As + (wm * 64 + mt * 16 + r16) * 72 + kb * 32 + g * 8);
#pragma unroll
    for (int nt = 0; nt < NTW; ++nt)
      wf[nt] = *(const bf16x8*)(Ws + (wn * (BN / 2) + nt * 16 + r16) * 72 + kb * 32 + g * 8);
#pragma unroll
    for (int mt = 0; mt < 4; ++mt)
#pragma unroll
      for (int nt = 0; nt < NTW; ++nt) acc[mt][nt] = mfma16(wf[nt], af[mt], acc[mt][nt]);
  }
}
template <int BN>
DEV void gemm_main(f32x4 (&acc)[4][BN / 32], const bf16_t* __restrict__ A, int lda, const bf16_t* __restrict__ W,
                   int ldw, int K, char* smem) {
  constexpr int NTW = BN / 32;
  constexpr int BUF = (128 + BN) * 72;
  bf16_t* As0 = (bf16_t*)smem;
  bf16_t* Ws0 = As0 + 128 * 72;
  bf16_t* As1 = As0 + BUF;
  bf16_t* Ws1 = As1 + 128 * 72;
  const int tid = tidx(), lane = tid & 63, w = tid >> 6;
  const int wm = w & 1, wn = w >> 1;
  const int r16 = lane & 15, g = lane >> 4;
  const int lrow = tid >> 3, loff = (tid & 7) * 8;
  u32x4 ra0[4], rw0[NTW], ra1[4], rw1[NTW];
  const int nk = K >> 6;
  g_load<NTW>(ra0, rw0, A, lda, W, ldw, 0, lrow, loff);
  g_load<NTW>(ra1, rw1, A, lda, W, ldw, 64, lrow, loff);
  __syncthreads();
  s_store<NTW>(ra0, rw0, As0, Ws0, lrow, loff);
  g_load<NTW>(ra0, rw0, A, lda, W, ldw, 128, lrow, loff);
  __syncthreads();
  for (int kt = 0; kt < nk; kt += 2) {
    s_store<NTW>(ra1, rw1, As1, Ws1, lrow, loff);
    g_load<NTW>(ra1, rw1, A, lda, W, ldw, min(kt + 3, nk - 1) << 6, lrow, loff);
    g_compute<BN>(acc, As0, Ws0, wm, wn, r16, g);
    __syncthreads();
    s_store<NTW>(ra0, rw0, As0, Ws0, lrow, loff);
    g_load<NTW>(ra0, rw0, A, lda, W, ldw, min(kt + 4, nk - 1) << 6, lrow, loff);
    g_compute<BN>(acc, As1, Ws1, wm, wn, r16, g);
    __syncthreads();
  }
}

template <int NT>
DEV void zero_acc(f32x4 (&acc)[4][NT]) {
#pragma unroll
  for (int i = 0; i < 4; ++i)
#pragma unroll
    for (int j = 0; j < NT; ++j) acc[i][j] = f32x4{0.f, 0.f, 0.f, 0.f};
}

DEV int mod_row(int m) { return m < NLAT ? (m >> 12) : 8; }

DEV void transpose_tile(const float* __restrict__ src, int N, bf16_t* __restrict__ dst, int K, int k0, int n0, char* smem) {
  float* tile = (float*)smem;
  const int tid = tidx();
  __syncthreads();
  {
    const int n = tid & 63, kk = tid >> 6;
#pragma unroll
    for (int i = 0; i < 16; ++i) {
      int k = kk + 4 * i;
      tile[k * 65 + n] = src[(size_t)(k0 + k) * N + n0 + n];
    }
  }
  __syncthreads();
  {
    const int k = tid & 63, nn = tid >> 6;
#pragma unroll
    for (int i = 0; i < 16; ++i) {
      int n = nn + 4 * i;
      dst[(size_t)(n0 + n) * K + k0 + k] = f2bf(tile[k * 65 + n]);
    }
  }
}

DEV void transpose_tile2(const float* __restrict__ src, int N, bf16_t* __restrict__ dst, int K, int k0, int n0, char* smem) {
  float* tile = (float*)smem;
  const int tid = tidx();
  __syncthreads();
  {
    const int n = tid & 63, kk = tid >> 6;
#pragma unroll
    for (int i = 0; i < 32; ++i) {
      int k = kk + 4 * i;
      tile[k * 65 + n] = src[(size_t)(k0 + k) * N + n0 + n];
    }
  }
  __syncthreads();
  {
    const int kp = tid & 63, nn = tid >> 6;
#pragma unroll
    for (int i = 0; i < 16; ++i) {
      int n = nn + 4 * i;
      unsigned v = pack2(tile[(2 * kp) * 65 + n], tile[(2 * kp + 1) * 65 + n]);
      *(unsigned*)(dst + (size_t)(n0 + n) * K + k0 + 2 * kp) = v;
    }
  }
}

struct TrJob { const float* src; bf16_t* dst; int N, K, k0, n0, rows; };
DEV TrJob prep_job(const Params& P, int l, int job) {
  TrJob t;
  int j = job;
  if (j < 896) {
    t.src = P.w_in + (size_t)l * 1024 * 7168; t.dst = P.WinT + (size_t)l * 7168 * 1024; t.N = 7168; t.K = 1024;
    t.k0 = (j / 112) * 128; t.n0 = (j % 112) * 64; t.rows = 128; return t;
  }
  j -= 896;
  if (j < 192) {
    const int mat = l * 3 + j / 64, q = j % 64;
    t.src = P.w_branch + (size_t)mat * 512 * 1024; t.dst = P.WbT + (size_t)mat * 1024 * 512; t.N = 1024; t.K = 512;
    t.k0 = (q / 16) * 128; t.n0 = (q % 16) * 64; t.rows = 128; return t;
  }
  j -= 192;
  if (j < 128) {
    t.src = P.w_out + (size_t)l * 1024 * 1024; t.dst = P.WoT + (size_t)l * 1024 * 1024; t.N = 1024; t.K = 1024;
    t.k0 = (j / 16) * 128; t.n0 = (j % 16) * 64; t.rows = 128; return t;
  }
  j -= 128;
  if (j < 32) {
    t.src = P.s5_w_glu + (size_t)l * 512 * 512; t.dst = P.WgT + (size_t)l * 512 * 512; t.N = 512; t.K = 512;
    t.k0 = (j / 8) * 128; t.n0 = (j % 8) * 64; t.rows = 128; return t;
  }
  j -= 32;
  {
    const int jj = l * 32 + j;
    const int blk = jj & 7, which = (jj >> 3) & 1, ld = jj >> 4;
    t.src = (which ? P.lru_wx : P.lru_wa) + (size_t)(ld * 8 + blk) * 4096; t.dst = P.WlT + (size_t)jj * 4096; t.N = 64; t.K = 64;
    t.k0 = 0; t.n0 = 0; t.rows = 64; return t;
  }
}
DEV void prep_load(const TrJob& t, float (&v)[32], int tid) {
  const int n = tid & 63, kk = tid >> 6;
#pragma unroll
  for (int i = 0; i < 32; ++i) {
    const int k = kk + 4 * i;
    v[i] = (k < t.rows) ? t.src[(size_t)(t.k0 + k) * t.N + t.n0 + n] : 0.f;
  }
}
DEV void prep_layer_weights(const Params& P, int l, int first, int stride, char* smem) {
  float* tile = (float*)smem;
  const int tid = tidx();
  if (first >= 1280) return;
  TrJob cur = prep_job(P, l, first);
  float v[32];
  prep_load(cur, v, tid);
  for (int job = first; job < 1280; job += stride) {
    __syncthreads();
    {
      const int n = tid & 63, kk = tid >> 6;
#pragma unroll
      for (int i = 0; i < 32; ++i) tile[(kk + 4 * i) * 65 + n] = v[i];
    }
    const bool has_next = job + stride < 1280;
    TrJob nxt = cur;
    if (has_next) { nxt = prep_job(P, l, job + stride); prep_load(nxt, v, tid); }
    __syncthreads();
    {
      const int kp = tid & 63, nn = tid >> 6;
      if (2 * kp < cur.rows) {
#pragma unroll
        for (int i = 0; i < 16; ++i) {
          const int n = nn + 4 * i;
          const unsigned pk = pack2(tile[(2 * kp) * 65 + n], tile[(2 * kp + 1) * 65 + n]);
          *(unsigned*)(cur.dst + (size_t)(cur.n0 + n) * cur.K + cur.k0 + 2 * kp) = pk;
        }
      }
    }
    cur = nxt;
  }
}

DEV void phase0(const Params& P, char* smem) {
  const int tid = tidx();
  prep_layer_weights(P, 0, vb(), vg(), smem);
  constexpr int J_MOD = 768, J_ROPE = 512, J_S5 = 256;
  constexpr int JT = J_MOD + J_ROPE + J_S5 + 1;
  for (int job = vb(); job < JT; job += vg()) {
    int j = job;
    if (j < J_MOD) {
      int l = j / 192, jt = j % 192;
      float* sc = (float*)smem;
      float* red = sc + 9216;
      __syncthreads();
      for (int idx = tid; idx < 9216; idx += 256) {
        int r = idx >> 10, k = idx & 1023;
        float v = r < 8 ? P.c[r * 1024 + k] : P.c_ctx[k];
        sc[idx] = siluf_(v);
      }
      __syncthreads();
      const int jj = tid & 15, kq = tid >> 4, col = jt * 16 + jj;
      float a[9];
#pragma unroll
      for (int r = 0; r < 9; ++r) a[r] = 0.f;
      const float* wp = P.w_mod + (size_t)l * 1024 * 3072 + col;
#pragma unroll 16
      for (int k = kq * 64; k < kq * 64 + 64; ++k) {
        float wv = wp[(size_t)k * 3072];
#pragma unroll
        for (int r = 0; r < 9; ++r) a[r] += sc[r * 1024 + k] * wv;
      }
#pragma unroll
      for (int r = 0; r < 9; ++r) red[(kq * 9 + r) * 16 + jj] = a[r];
      __syncthreads();
      if (tid < 144) {
        int r = tid >> 4, j2 = tid & 15;
        float s_ = 0.f;
#pragma unroll
        for (int q = 0; q < 16; ++q) s_ += red[(q * 9 + r) * 16 + j2];
        int cc = jt * 16 + j2;
        P.mods[(size_t)(l * 9 + r) * 3072 + cc] = s_ + P.b_mod[l * 3072 + cc];
      }
      continue;
    }
    j -= J_MOD;
    if (j < J_ROPE) {
      int e = j * 256 + tid;
      int t = e >> 5, i = e & 31, f = i & 15;
      float inv = powf(10000.f, -(float)f / 16.f);
      float pos = (float)(i < 16 ? (t >> 6) : (t & 63));
      float ang = pos * inv;
      P.rope[e] = make_float2(cosf(ang), sinf(ang));
      continue;
    }
    j -= J_ROPE;
    if (j < J_S5) {
      const int g = j & 31, ld = j >> 5, l = ld >> 1, d = ld & 1;
      float* crs = (float*)smem;
      __syncthreads();
      if (tid < 64) {
        int p = tid;
        float lr = P.s5_lam_re[(size_t)j * 64 + p], li = P.s5_lam_im[(size_t)j * 64 + p];
        float dt = expf(P.s5_log_dt[j]);
        float mag = expf(lr * dt);
        float ar = mag * cosf(li * dt), ai = mag * sinf(li * dt);
        float den = lr * lr + li * li;
        float nr = ar - 1.f;
        crs[p] = (nr * lr + ai * li) / den;
        crs[64 + p] = (ai * lr - nr * li) / den;
        P.s5A[(size_t)j * 64 + p] = make_float2(ar, ai);
        float pr = ar, pi = ai;
#pragma unroll
        for (int s = 0; s < 6; ++s) {
          float nr2 = pr * pr - pi * pi, ni2 = 2.f * pr * pi;
          pr = nr2; pi = ni2;
        }
        P.s5A64[(size_t)j * 64 + p] = make_float2(pr, pi);
      }
      __syncthreads();
      for (int e = tid; e < 512; e += 256) {
        int nt = e >> 6, ln = e & 63;
        int ri = nt >> 2, p = (nt & 3) * 16 + (ln & 15), kg = ln >> 4;
        float cr = crs[p], ci = crs[64 + p];
        unsigned v[4] = {0u, 0u, 0u, 0u};
        if (kg < 2) {
          const float* bre = P.s5_b_re + ((size_t)j * 64 + p) * 16 + kg * 8;
          const float* bim = P.s5_b_im + ((size_t)j * 64 + p) * 16 + kg * 8;
#pragma unroll
          for (int q = 0; q < 4; ++q) {
            float r0 = bre[2 * q], i0 = bim[2 * q], r1 = bre[2 * q + 1], i1 = bim[2 * q + 1];
            float v0 = ri == 0 ? cr * r0 - ci * i0 : cr * i0 + ci * r0;
            float v1 = ri == 0 ? cr * r1 - ci * i1 : cr * i1 + ci * r1;
            v[q] = pack2(v0, v1);
          }
        }
        P.s5drvB[((size_t)j * 8 + nt) * 64 + ln] = u32x4_mk(v[0], v[1], v[2], v[3]);
      }
      if (d == 0) {
        int kk = tid >> 6, ln = tid & 63;
        int h = ln & 15;
        unsigned v[4];
#pragma unroll
        for (int q = 0; q < 4; ++q) {
          float vv[2];
#pragma unroll
          for (int s = 0; s < 2; ++s) {
            int k = kk * 32 + (ln >> 4) * 8 + 2 * q + s;
            size_t base = ((size_t)(l * 32 + g) * 16 + h) * 64;
            vv[s] = (k & 1) == 0 ? P.s5_c_re[base + (k >> 1)] : -P.s5_c_im[base + (k >> 1)];
          }
          v[q] = pack2(vv[0], vv[1]);
        }
        P.s5C[((size_t)(l * 32 + g) * 4 + kk) * 64 + ln] = u32x4_mk(v[0], v[1], v[2], v[3]);
      }
      continue;
    }
    j -= J_S5;
    {
      int l = tid >> 6, lane = tid & 63;
      const float* lq = P.lam_qk + l * 256;
      float s1 = lq[lane] * lq[64 + lane], s2 = lq[128 + lane] * lq[192 + lane];
#pragma unroll
      for (int o = 32; o > 0; o >>= 1) {
        s1 += shx(s1, o, lane);
        s2 += shx(s2, o, lane);
      }
      float lam_init = 0.8f - 0.6f * expf(-0.3f * (float)l);
      if (lane == 0) P.lamv[l] = expf(s1) - expf(s2) + lam_init;
    }
  }
}

DEV void phase_norm(const Params& P, int l) {
  const int tid_ = tidx(); const int lane = tid_ & 63, w = tid_ >> 6;
  const float* ng = P.norm_g + l * 1024;
  auto rowptr = [&](int r) -> const float* {
    if (r < NLAT) return (l == 0 ? P.x : P.out) + (size_t)r * 1024;
    return (l == 0 ? P.ctx : P.ctxres) + (size_t)(r - NLAT) * 1024;
  };
  const int stride = vg() * 4;
  int r = vb() * 4 + w;
  float4 v[4], vn[4];
  if (r < NR) {
    const float* src = rowptr(r);
#pragma unroll
    for (int i = 0; i < 4; ++i) v[i] = *(const float4*)(src + i * 256 + lane * 4);
  }
  for (; r < NR; r += stride) {
    const int rn = r + stride;
    if (rn < NR) {
      const float* srcn = rowptr(rn);
#pragma unroll
      for (int i = 0; i < 4; ++i) vn[i] = *(const float4*)(srcn + i * 256 + lane * 4);
    }
    const float* md = P.mods + (size_t)(l * 9 + mod_row(r)) * 3072;
    float ss = 0.f;
#pragma unroll
    for (int i = 0; i < 4; ++i) ss += v[i].x * v[i].x + v[i].y * v[i].y + v[i].z * v[i].z + v[i].w * v[i].w;
#pragma unroll
    for (int o = 32; o > 0; o >>= 1) ss += __shfl_xor(ss, o);
    float rstd = rsqrtf(ss * (1.f / 1024.f) + 1e-6f);
#pragma unroll
    for (int i = 0; i < 4; ++i) {
      int k = i * 256 + lane * 4;
      float4 g4 = *(const float4*)(ng + k);
      float4 sh = *(const float4*)(md + k);
      float4 sc = *(const float4*)(md + 1024 + k);
      float o0 = v[i].x * rstd * g4.x * (1.f + sc.x) + sh.x;
      float o1 = v[i].y * rstd * g4.y * (1.f + sc.y) + sh.y;
      float o2 = v[i].z * rstd * g4.z * (1.f + sc.z) + sh.z;
      float o3 = v[i].w * rstd * g4.w * (1.f + sc.w) + sh.w;
      u32x2 pk = u32x2_mk(pack2(o0, o1), pack2(o2, o3));
      *(u32x2*)(P.hbuf + (size_t)r * 1024 + k) = pk;
    }
#pragma unroll
    for (int i = 0; i < 4; ++i) v[i] = vn[i];
  }
}

DEV void phase_proj(const Params& P, int l, char* smem) {
  const int tid_ = tidx(); const int lane = tid_ & 63, w = tid_ >> 6;
  const int wm = w & 1, wn = w >> 1, r16 = lane & 15, g = lane >> 4;
  const bf16_t* Wl = P.WinT + (size_t)l * 7168 * 1024;
  const float QS = 0.125f * 1.4426950408889634f;
  for (int tile = vb(); tile < 272 * 32; tile += vg()) {
    const int mtile = tile >> 5, ntile = tile & 31;
    const int m0 = mtile * 128, n0 = ntile * 128;
    f32x4 acc[4][4];
    zero_acc<4>(acc);
    gemm_main<128>(acc, P.hbuf + (size_t)m0 * 1024, 1024, Wl + (size_t)n0 * 1024, 1024, 1024, smem);
    const int region = n0 >> 9;
#pragma unroll
    for (int mt = 0; mt < 4; ++mt) {
      const int m = m0 + wm * 64 + mt * 16 + r16;
#pragma unroll
      for (int nt = 0; nt < 4; ++nt) {
        const int n = n0 + wn * 64 + nt * 16 + g * 4;
        f32x4 v = acc[mt][nt];
        if (region <= 1) {
          if (m < NLAT) {
            int t = m & 4095;
            int i0 = (n & 63) >> 1;
            float4 cs = *(const float4*)(P.rope + (size_t)t * 32 + i0);
            float a0 = v[0] * cs.x - v[1] * cs.y, a1 = v[0] * cs.y + v[1] * cs.x;
            float a2 = v[2] * cs.z - v[3] * cs.w, a3 = v[2] * cs.w + v[3] * cs.z;
            v = f32x4{a0, a1, a2, a3};
          }
          if (region == 0) v = v * QS;
          *(u32x2*)(P.proj + (size_t)m * PW + n) = u32x2_mk(pack2(v[0], v[1]), pack2(v[2], v[3]));
        } else if (region == 2) {
          int b, key;
          if (m < NLAT) { b = m >> 12; key = m & 4095; }
          else { b = (m - NLAT) >> 8; key = 4096 + ((m - NLAT) & 255); }
          int nn = n - 1024;
          bf16_t* vp = P.Vt + ((size_t)b * 512 + nn) * 4352 + key;
#pragma unroll
          for (int j = 0; j < 4; ++j) vp[(size_t)j * 4352] = f2bf(v[j]);
        } else {
          if (region == 3 || region == 5 || region == 7) {
#pragma unroll
            for (int j = 0; j < 4; ++j) v[j] = siluf_(v[j]);
          }
          *(u32x2*)(P.proj + (size_t)m * PW + n) = u32x2_mk(pack2(v[0], v[1]), pack2(v[2], v[3]));
        }
      }
    }
  }
}

struct ChunkGeo { int row0, seqrow0, seqlen, tloc0; };
DEV ChunkGeo chunk_geo(int cid) {
  ChunkGeo c;
  if (cid < 512) {
    int b = cid >> 6, lc = cid & 63;
    c.row0 = b * 4096 + lc * 64; c.seqrow0 = b * 4096; c.seqlen = 4096; c.tloc0 = lc * 64;
  } else {
    int cc = cid - 512, b = cc >> 2;
    c.row0 = NLAT + cc * 64; c.seqrow0 = NLAT + b * 256; c.seqlen = 256; c.tloc0 = (cc & 3) * 64;
  }
  return c;
}
DEV int chunk_at(int b, int d, int pos) {
  if (d == 0) return pos < 4 ? 512 + b * 4 + pos : b * 64 + (pos - 4);
  return pos < 4 ? 512 + b * 4 + (3 - pos) : b * 64 + (63 - (pos - 4));
}

DEV void lru_item(const Params& P, int l, int item, bool step3, char* smem) {
  const int tid = tidx(), lane = tid & 63, w = tid >> 6, r16 = lane & 15, g = lane >> 4;
  const int cid = item >> 3, cb = item & 7;
  const ChunkGeo cg_ = chunk_geo(cid);
  bf16_t* Us = (bf16_t*)smem;
  const int c8 = tid & 7, tr = tid >> 3;
  const int ch0 = cb * 64 + c8 * 8;
  u32x4 xin[2][4];
#pragma unroll
  for (int pass = 0; pass < 2; ++pass)
#pragma unroll
    for (int jt = 0; jt < 4; ++jt) {
      const int tt = cg_.tloc0 + tr + 32 * pass + jt - 2;
      u32x4 xv = u32x4_mk(0u, 0u, 0u, 0u);
      if (tt >= 0 && tt < cg_.seqlen) xv = *(const u32x4*)(P.proj + (size_t)(cg_.seqrow0 + tt) * PW + CXR + ch0);
      xin[pass][jt] = xv;
    }
  float wt[4][8], cbv[8];
  {
    const float4 b0 = *(const float4*)(P.conv_b + l * 512 + ch0), b1 = *(const float4*)(P.conv_b + l * 512 + ch0 + 4);
    cbv[0] = b0.x; cbv[1] = b0.y; cbv[2] = b0.z; cbv[3] = b0.w; cbv[4] = b1.x; cbv[5] = b1.y; cbv[6] = b1.z; cbv[7] = b1.w;
#pragma unroll
    for (int jt = 0; jt < 4; ++jt) {
      const float4 w0 = *(const float4*)(P.conv_w + (l * 4 + jt) * 512 + ch0), w1 = *(const float4*)(P.conv_w + (l * 4 + jt) * 512 + ch0 + 4);
      wt[jt][0] = w0.x; wt[jt][1] = w0.y; wt[jt][2] = w0.z; wt[jt][3] = w0.w; wt[jt][4] = w1.x; wt[jt][5] = w1.y; wt[jt][6] = w1.z; wt[jt][7] = w1.w;
    }
  }
  const int ch = cb * 64 + w * 16 + r16;
  bf16_t zep[4][4];
  float cin[2] = {0.f, 0.f};
  if (step3) {
    cin[0] = P.lruS[(size_t)(0 * NCH + cid) * 512 + ch];
    cin[1] = P.lruS[(size_t)(1 * NCH + cid) * 512 + ch];
#pragma unroll
    for (int tt = 0; tt < 4; ++tt)
#pragma unroll
      for (int j = 0; j < 4; ++j) zep[tt][j] = P.proj[(size_t)(cg_.row0 + tt * 16 + g * 4 + j) * PW + CZR + ch];
  }
  bf16x8 wfr[2][2][2];
  float bav[2], bxv[2], lmv[2];
#pragma unroll
  for (int d = 0; d < 2; ++d) {
#pragma unroll
    for (int wh = 0; wh < 2; ++wh)
#pragma unroll
      for (int kb = 0; kb < 2; ++kb)
        wfr[d][wh][kb] = *(const bf16x8*)(P.WlT + (size_t)(((l * 2 + d) * 2 + wh) * 8 + cb) * 4096 + (w * 16 + r16) * 64 + kb * 32 + g * 8);
    bav[d] = P.lru_ba[(l * 2 + d) * 512 + ch];
    bxv[d] = P.lru_bx[(l * 2 + d) * 512 + ch];
    lmv[d] = P.lru_lam[(l * 2 + d) * 512 + ch];
  }
  __syncthreads();
#pragma unroll
  for (int pass = 0; pass < 2; ++pass) {
    const int t = tr + 32 * pass;
    float a[8];
#pragma unroll
    for (int e = 0; e < 8; ++e) a[e] = cbv[e];
#pragma unroll
    for (int jt = 0; jt < 4; ++jt) {
      const u32x4 xv = xin[pass][jt];
      const unsigned xs[4] = {xv.x, xv.y, xv.z, xv.w};
#pragma unroll
      for (int q = 0; q < 4; ++q) {
        a[2 * q] += wt[jt][2 * q] * bf2f((bf16_t)(xs[q] & 0xffffu));
        a[2 * q + 1] += wt[jt][2 * q + 1] * bf2f((bf16_t)(xs[q] >> 16));
      }
    }
    *(u32x4*)(Us + t * 72 + c8 * 8) = u32x4_mk(pack2(a[0], a[1]), pack2(a[2], a[3]), pack2(a[4], a[5]), pack2(a[6], a[7]));
  }
  __syncthreads();
  bf16x8 uf[4][2];
#pragma unroll
  for (int tt = 0; tt < 4; ++tt)
#pragma unroll
    for (int kb = 0; kb < 2; ++kb) uf[tt][kb] = *(const bf16x8*)(Us + (tt * 16 + r16) * 72 + kb * 32 + g * 8);
  float uval[4][4];
#pragma unroll
  for (int tt = 0; tt < 4; ++tt)
#pragma unroll
    for (int j = 0; j < 4; ++j) uval[tt][j] = bf2f(Us[(tt * 16 + g * 4 + j) * 72 + w * 16 + r16]);
  float outv[4][4];
#pragma unroll
  for (int tt = 0; tt < 4; ++tt)
#pragma unroll
    for (int j = 0; j < 4; ++j) outv[tt][j] = 0.f;

#pragma unroll
  for (int d = 0; d < 2; ++d) {
    f32x4 ga[4], gx[4];
#pragma unroll
    for (int tt = 0; tt < 4; ++tt) { ga[tt] = f32x4{0.f, 0.f, 0.f, 0.f}; gx[tt] = f32x4{0.f, 0.f, 0.f, 0.f}; }
#pragma unroll
    for (int kb = 0; kb < 2; ++kb) {
#pragma unroll
      for (int tt = 0; tt < 4; ++tt) {
        ga[tt] = mfma16(uf[tt][kb], wfr[d][0][kb], ga[tt]);
        gx[tt] = mfma16(uf[tt][kb], wfr[d][1][kb], gx[tt]);
      }
    }
    const float ba = bav[d], bx = bxv[d];
    const float ex_ = __expf(-lmv[d]);
    const float sp = ex_ < 0.05f ? ex_ * (1.f - ex_ * (0.5f - ex_ * (0.33333334f - ex_ * (0.25f - 0.2f * ex_)))) : __logf(1.f + ex_);
    float av[4][4], bv[4][4];
#pragma unroll
    for (int tt = 0; tt < 4; ++tt)
#pragma unroll
      for (int j = 0; j < 4; ++j) {
        float r = sigmoidf_(ga[tt][j] + ba), ii = sigmoidf_(gx[tt][j] + bx);
        float log_a = -8.f * r * sp;
        float a_ = __expf(log_a);
        float x2 = 2.f * log_a;
        float ser = -x2 * (1.f + x2 * (0.5f + x2 * (0.16666667f + x2 * (0.041666668f + x2 * (0.0083333338f + x2 * 0.0013888889f)))));
        float om = x2 > -0.25f ? ser : 1.f - a_ * a_;
        av[tt][j] = a_;
        bv[tt][j] = __builtin_amdgcn_sqrtf(om) * (ii * uval[tt][j]);
      }
    float Ps[4], Ss[4];
#pragma unroll
    for (int tt = 0; tt < 4; ++tt) {
      float p_ = 1.f, s_ = 0.f;
      if (d == 0) {
#pragma unroll
        for (int j = 0; j < 4; ++j) { p_ *= av[tt][j]; s_ = s_ * av[tt][j] + bv[tt][j]; }
      } else {
#pragma unroll
        for (int j = 3; j >= 0; --j) { p_ *= av[tt][j]; s_ = s_ * av[tt][j] + bv[tt][j]; }
      }
      Ps[tt] = p_; Ss[tt] = s_;
    }
    const size_t cidx = (size_t)(d * NCH + cid) * 512 + ch;
    if (!step3) {
      float Pc = 1.f, Sc = 0.f;
#pragma unroll
      for (int q = 0; q < 4; ++q) {
        const int tt = d == 0 ? q : 3 - q;
#pragma unroll
        for (int q2 = 0; q2 < 4; ++q2) {
          const int gg = d == 0 ? q2 : 3 - q2;
          float Pg = shi(Ps[tt], gg * 16 + r16), Sg = shi(Ss[tt], gg * 16 + r16);
          Sc = Sc * Pg + Sg;
          Pc = Pc * Pg;
        }
      }
      if (g == 0) { P.lruP[cidx] = Pc; P.lruS[cidx] = Sc; }
    } else {
      float carry = cin[d];
#pragma unroll
      for (int q = 0; q < 4; ++q) {
        const int tt = d == 0 ? q : 3 - q;
        float run = carry, hstart = 0.f;
#pragma unroll
        for (int q2 = 0; q2 < 4; ++q2) {
          const int gg = d == 0 ? q2 : 3 - q2;
          float Pg = shi(Ps[tt], gg * 16 + r16), Sg = shi(Ss[tt], gg * 16 + r16);
          if (gg == g) hstart = run;
          run = run * Pg + Sg;
        }
        carry = run;
        float h = hstart;
        if (d == 0) {
#pragma unroll
          for (int j = 0; j < 4; ++j) { h = av[tt][j] * h + bv[tt][j]; outv[tt][j] += h; }
        } else {
#pragma unroll
          for (int j = 3; j >= 0; --j) { h = av[tt][j] * h + bv[tt][j]; outv[tt][j] += h; }
        }
      }
    }
  }
  if (step3) {
#pragma unroll
    for (int tt = 0; tt < 4; ++tt)
#pragma unroll
      for (int j = 0; j < 4; ++j) {
        bf16_t* zp = P.proj + (size_t)(cg_.row0 + tt * 16 + g * 4 + j) * PW + CZR + ch;
        *zp = f2bf(outv[tt][j] * bf2f(zep[tt][j]));
      }
  }
}

DEV void s5_item(const Params& P, int l, int item, bool step3, char* smem) {
  const int tid = tidx(), lane = tid & 63, w = tid >> 6, r16 = lane & 15, g = lane >> 4;
  const int cid = item >> 3, gq = item & 7;
  const int grp = gq * 4 + w;
  const ChunkGeo cg_ = chunk_geo(cid);
  bf16_t* BUh = (bf16_t*)(smem + w * 16896);
  bf16_t* Hs = (bf16_t*)(smem + w * 16896 + 8192);
  f32x4 Y[4];
#pragma unroll
  for (int s_ = 0; s_ < 4; ++s_) Y[s_] = f32x4{0.f, 0.f, 0.f, 0.f};
  bf16x8 ufr[4];
#pragma unroll
  for (int sub = 0; sub < 4; ++sub) {
    u32x4 uv = u32x4_mk(0u, 0u, 0u, 0u);
    if (g < 2) uv = *(const u32x4*)(P.proj + (size_t)(cg_.row0 + sub * 16 + r16) * PW + CUS + grp * 16 + g * 8);
    ufr[sub] = as_bf16x8(uv);
  }
  bf16x8 cf[4];
  bf16_t uep[4][4];
  if (step3) {
#pragma unroll
    for (int kk = 0; kk < 4; ++kk) cf[kk] = as_bf16x8(P.s5C[((size_t)(l * 32 + grp) * 4 + kk) * 64 + lane]);
#pragma unroll
    for (int sub = 0; sub < 4; ++sub)
#pragma unroll
      for (int j = 0; j < 4; ++j) uep[sub][j] = P.proj[(size_t)(cg_.row0 + sub * 16 + g * 4 + j) * PW + CUS + grp * 16 + r16];
  }
  const int jd0 = (l * 2 + 0) * 32 + grp, jd1 = (l * 2 + 1) * 32 + grp;
  bf16x8 bfrA[8], bfrB[8];
#pragma unroll
  for (int nt = 0; nt < 8; ++nt) {
    bfrA[nt] = as_bf16x8(P.s5drvB[((size_t)jd0 * 8 + nt) * 64 + lane]);
    bfrB[nt] = as_bf16x8(P.s5drvB[((size_t)jd1 * 8 + nt) * 64 + lane]);
  }
  const float2 A0 = P.s5A[(size_t)jd0 * 64 + lane], A1 = P.s5A[(size_t)jd1 * 64 + lane];
  const size_t eidx0 = ((size_t)(0 * NCH + cid) * 32 + grp) * 64 + lane, eidx1 = ((size_t)(1 * NCH + cid) * 32 + grp) * 64 + lane;
  float h0r = 0.f, h0i = 0.f, h1r = 0.f, h1i = 0.f;
  if (step3) { float2 a_ = P.s5E[eidx0], b_ = P.s5E[eidx1]; h0r = a_.x; h0i = a_.y; h1r = b_.x; h1i = b_.y; }
#pragma unroll
  for (int si = 0; si < 4; ++si) {
    const int sub0 = si, sub1 = 3 - si;
    __syncthreads();
#pragma unroll
    for (int nt = 0; nt < 8; ++nt) {
      f32x4 b0 = mfma16(ufr[sub0], bfrA[nt], f32x4{0.f, 0.f, 0.f, 0.f});
      f32x4 b1 = mfma16(ufr[sub1], bfrB[nt], f32x4{0.f, 0.f, 0.f, 0.f});
      *(u32x2*)(BUh + (nt * 16 + r16) * 16 + g * 4) = u32x2_mk(pack2(b0[0], b0[1]), pack2(b0[2], b0[3]));
      *(u32x2*)(BUh + 2048 + (nt * 16 + r16) * 16 + g * 4) = u32x2_mk(pack2(b1[0], b1[1]), pack2(b1[2], b1[3]));
    }
    __syncthreads();
    u32x4 r0a = *(const u32x4*)(BUh + lane * 16), r0b = *(const u32x4*)(BUh + lane * 16 + 8);
    u32x4 i0a = *(const u32x4*)(BUh + (64 + lane) * 16), i0b = *(const u32x4*)(BUh + (64 + lane) * 16 + 8);
    u32x4 r1a = *(const u32x4*)(BUh + 2048 + lane * 16), r1b = *(const u32x4*)(BUh + 2048 + lane * 16 + 8);
    u32x4 i1a = *(const u32x4*)(BUh + 2048 + (64 + lane) * 16), i1b = *(const u32x4*)(BUh + 2048 + (64 + lane) * 16 + 8);
    const unsigned re0[8] = {r0a.x, r0a.y, r0a.z, r0a.w, r0b.x, r0b.y, r0b.z, r0b.w};
    const unsigned im0[8] = {i0a.x, i0a.y, i0a.z, i0a.w, i0b.x, i0b.y, i0b.z, i0b.w};
    const unsigned re1[8] = {r1a.x, r1a.y, r1a.z, r1a.w, r1b.x, r1b.y, r1b.z, r1b.w};
    const unsigned im1[8] = {i1a.x, i1a.y, i1a.z, i1a.w, i1b.x, i1b.y, i1b.z, i1b.w};
#pragma unroll
    for (int ti = 0; ti < 16; ++ti) {
      {
        const int t = ti;
        const unsigned rw_ = re0[t >> 1], iw_ = im0[t >> 1];
        const float re = (t & 1) ? __uint_as_float(rw_ & 0xffff0000u) : __uint_as_float(rw_ << 16);
        const float im = (t & 1) ? __uint_as_float(iw_ & 0xffff0000u) : __uint_as_float(iw_ << 16);
        const float nr = A0.x * h0r - A0.y * h0i + re, ni = A0.x * h0i + A0.y * h0r + im;
        h0r = nr; h0i = ni;
        if (step3) *(unsigned*)(Hs + t * 136 + 2 * lane) = pack2(h0r, h0i);
      }
      {
        const int t = 15 - ti;
        const unsigned rw_ = re1[t >> 1], iw_ = im1[t >> 1];
        const float re = (t & 1) ? __uint_as_float(rw_ & 0xffff0000u) : __uint_as_float(rw_ << 16);
        const float im = (t & 1) ? __uint_as_float(iw_ & 0xffff0000u) : __uint_as_float(iw_ << 16);
        const float nr = A1.x * h1r - A1.y * h1i + re, ni = A1.x * h1i + A1.y * h1r + im;
        h1r = nr; h1i = ni;
        if (step3) *(unsigned*)(Hs + 2176 + t * 136 + 2 * lane) = pack2(h1r, h1i);
      }
    }
    if (step3) {
      __syncthreads();
#pragma unroll
      for (int kk = 0; kk < 4; ++kk) {
        bf16x8 hf0 = *(const bf16x8*)(Hs + r16 * 136 + kk * 32 + g * 8);
        bf16x8 hf1 = *(const bf16x8*)(Hs + 2176 + r16 * 136 + kk * 32 + g * 8);
        Y[sub0] = mfma16(hf0, cf[kk], Y[sub0]);
        Y[sub1] = mfma16(hf1, cf[kk], Y[sub1]);
      }
    }
  }
  if (!step3) { P.s5E[eidx0] = make_float2(h0r, h0i); P.s5E[eidx1] = make_float2(h1r, h1i); }
  if (step3) {
    const float dsk = P.s5_d[l * 512 + grp * 16 + r16];
#pragma unroll
    for (int sub = 0; sub < 4; ++sub)
#pragma unroll
      for (int j = 0; j < 4; ++j) {
        bf16_t* up = P.proj + (size_t)(cg_.row0 + sub * 16 + g * 4 + j) * PW + CUS + grp * 16 + r16;
        float y = Y[sub][j] + dsk * bf2f(uep[sub][j]);
        *up = f2bf(gelu_tanh(y));
      }
  }
}

DEV void phase_scan(const Params& P, int l, bool step3, char* smem) {
  const int ncid = (step3 && l == 3) ? 512 : NCH;
  const int nitems = ncid * 8;
  for (int it = vb(); it < 2 * nitems; it += vg()) {
    if (it < nitems) s5_item(P, l, it, step3, smem);
    else lru_item(P, l, it - nitems, step3, smem);
  }
}

DEV void carry_job(const Params& P, int l, int job) {
  const int tid = tidx();
  if (job < 32) {
    int id = job * 256 + tid;
    int ch = id & 511, d = (id >> 9) & 1, b = id >> 10;
    float carry = 0.f;
#pragma unroll 4
    for (int pos = 0; pos < 68; ++pos) {
      size_t idx = (size_t)(d * NCH + chunk_at(b, d, pos)) * 512 + ch;
      float Pv = P.lruP[idx], Sv = P.lruS[idx];
      P.lruS[idx] = carry;
      carry = Pv * carry + Sv;
    }
  } else {
    int id = (job - 32) * 256 + tid;
    int p = id & 63, g = (id >> 6) & 31, d = (id >> 11) & 1, b = id >> 12;
    float2 A = P.s5A64[((size_t)(l * 2 + d) * 32 + g) * 64 + p];
    float cr = 0.f, ci = 0.f;
#pragma unroll 4
    for (int pos = 0; pos < 68; ++pos) {
      size_t idx = ((size_t)(d * NCH + chunk_at(b, d, pos)) * 32 + g) * 64 + p;
      float2 e = P.s5E[idx];
      P.s5E[idx] = make_float2(cr, ci);
      float nr = A.x * cr - A.y * ci + e.x;
      float ni = A.x * ci + A.y * cr + e.y;
      cr = nr; ci = ni;
    }
  }
}

DEV void attn_item(const Params& P, int l, int item, char* smem, int dowrite = 1) {
  const int tid = tidx(), lane = tid & 63, w = tid >> 6, r16 = lane & 15, g = lane >> 4;
  bf16_t* Ks = (bf16_t*)smem;
  bf16_t* Vs = Ks + 64 * 136;
  int b, h, qrow0, kt0, nkt;
  if (item < 2048) {
    b = item >> 8; h = (item >> 6) & 3;
    qrow0 = b * 4096 + (item & 63) * 64; kt0 = 0; nkt = 68;
  } else {
    int i2 = item - 2048;
    b = i2 >> 4; h = (i2 >> 2) & 3;
    qrow0 = NLAT + b * 256 + (i2 & 3) * 64; kt0 = 64; nkt = 4;
  }
  const int qrow = qrow0 + w * 16 + r16;
  bf16x8 qf[2][2];
#pragma unroll
  for (int c = 0; c < 2; ++c)
#pragma unroll
    for (int kb = 0; kb < 2; ++kb)
      qf[c][kb] = *(const bf16x8*)(P.proj + (size_t)qrow * PW + CQ + h * 128 + c * 64 + kb * 32 + g * 8);
  f32x4 o[2][8];
#pragma unroll
  for (int c = 0; c < 2; ++c)
#pragma unroll
    for (int dv = 0; dv < 8; ++dv) o[c][dv] = f32x4{0.f, 0.f, 0.f, 0.f};
  float mrun[2] = {-1e30f, -1e30f}, lsum[2] = {0.f, 0.f};
  const bf16_t* Vbase = P.Vt + (size_t)(b * 4 + h) * 128 * 4352;
  u32x4 rk[4], rv[4];
  auto gl = [&](int kt) {
    int krow0, vkey0;
    if (kt < 64) { krow0 = b * 4096 + kt * 64; vkey0 = kt * 64; }
    else { krow0 = NLAT + b * 256 + (kt - 64) * 64; vkey0 = 4096 + (kt - 64) * 64; }
#pragma unroll
    for (int i = 0; i < 4; ++i) {
      int cidx = tid + 256 * i;
      rk[i] = *(const u32x4*)(P.proj + (size_t)(krow0 + (cidx >> 4)) * PW + CK + h * 128 + (cidx & 15) * 8);
      rv[i] = *(const u32x4*)(Vbase + (size_t)(cidx >> 3) * 4352 + vkey0 + (cidx & 7) * 8);
    }
  };
  auto st = [&](int buf) {
    bf16_t* Kd = Ks + buf * (64 * 136 + 128 * 72);
    bf16_t* Vd = Vs + buf * (64 * 136 + 128 * 72);
#pragma unroll
    for (int i = 0; i < 4; ++i) {
      int cidx = tid + 256 * i;
      *(u32x4*)(Kd + (cidx >> 4) * 136 + (cidx & 15) * 8) = rk[i];
      *(u32x4*)(Vd + (cidx >> 3) * 72 + (cidx & 7) * 8) = rv[i];
    }
  };
  gl(kt0);
  __syncthreads();
  st(0);
  gl(kt0 + 1);
  __syncthreads();
  for (int it = 0; it < nkt; ++it) {
    const int cur = it & 1;
    if (it + 1 < nkt) st(cur ^ 1);
    if (it + 2 < nkt) gl(kt0 + it + 2);
    const bf16_t* Kc = Ks + cur * (64 * 136 + 128 * 72);
    const bf16_t* Vc = Vs + cur * (64 * 136 + 128 * 72);
#pragma unroll
    for (int c = 0; c < 2; ++c) {
      f32x4 s[4];
#pragma unroll
      for (int kt = 0; kt < 4; ++kt) {
        s[kt] = f32x4{0.f, 0.f, 0.f, 0.f};
#pragma unroll
        for (int kb = 0; kb < 2; ++kb) {
          bf16x8 kf = *(const bf16x8*)(Kc + (kt * 16 + r16) * 136 + c * 64 + kb * 32 + g * 8);
          s[kt] = mfma16(kf, qf[c][kb], s[kt]);
        }
      }
      float mx = fmaxf(fmaxf(s[0][0], s[0][1]), fmaxf(s[0][2], s[0][3]));
#pragma unroll
      for (int kt = 1; kt < 4; ++kt) mx = fmaxf(mx, fmaxf(fmaxf(s[kt][0], s[kt][1]), fmaxf(s[kt][2], s[kt][3])));
      mx = fmaxf(mx, shx(mx, 16, lane));
      mx = fmaxf(mx, shx(mx, 32, lane));
      const bool need = mx > mrun[c] + 8.f;
      if (__any(need)) {
        const float mnew = need ? mx : mrun[c];
        const float alpha = fexp2(mrun[c] - mnew);
        mrun[c] = mnew;
        lsum[c] *= alpha;
#pragma unroll
        for (int dv = 0; dv < 8; ++dv) o[c][dv] = o[c][dv] * alpha;
      }
      const float mref = mrun[c];
      float ps = 0.f;
#pragma unroll
      for (int kt = 0; kt < 4; ++kt) {
        s[kt] = s[kt] - mref;
#pragma unroll
        for (int j = 0; j < 4; ++j) { s[kt][j] = fexp2(s[kt][j]); ps += s[kt][j]; }
      }
      lsum[c] += ps;
      bf16x8 pf[2];
#pragma unroll
      for (int kb2 = 0; kb2 < 2; ++kb2) {
        u32x4 pk = u32x4_mk(pack2(s[2 * kb2][0], s[2 * kb2][1]), pack2(s[2 * kb2][2], s[2 * kb2][3]),
                            pack2(s[2 * kb2 + 1][0], s[2 * kb2 + 1][1]), pack2(s[2 * kb2 + 1][2], s[2 * kb2 + 1][3]));
        pf[kb2] = as_bf16x8(pk);
      }
#pragma unroll
      for (int dv = 0; dv < 8; ++dv) {
        if ((dv & 1) == 0) __builtin_amdgcn_sched_barrier(0);
#pragma unroll
        for (int kb2 = 0; kb2 < 2; ++kb2) {
          const bf16_t* vp = Vc + (dv * 16 + r16) * 72 + kb2 * 32 + g * 4;
          u32x2 v0 = *(const u32x2*)vp, v1 = *(const u32x2*)(vp + 16);
          bf16x8 vf = as_bf16x8(u32x4_mk(v0.x, v0.y, v1.x, v1.y));
          o[c][dv] = mfma16(vf, pf[kb2], o[c][dv]);
        }
      }
      __builtin_amdgcn_sched_barrier(0);
    }
    __syncthreads();
  }
  float l0 = lsum[0], l1 = lsum[1];
  l0 += shx(l0, 16, lane); l0 += shx(l0, 32, lane);
  l1 += shx(l1, 16, lane); l1 += shx(l1, 32, lane);
  const float lam = P.lamv[l];
  const float i0 = 1.f / l0, i1 = lam / l1;
  float ss = 0.f;
#pragma unroll
  for (int dv = 0; dv < 8; ++dv)
#pragma unroll
    for (int j = 0; j < 4; ++j) {
      float v = o[0][dv][j] * i0 - o[1][dv][j] * i1;
      o[0][dv][j] = v;
      ss += v * v;
    }
  ss += shx(ss, 16, lane); ss += shx(ss, 32, lane);
  const float lam_init = 0.8f - 0.6f * expf(-0.3f * (float)l);
  const float rs = rsqrtf(ss * (1.f / 128.f) + 1e-6f) * (1.f - lam_init);
#pragma unroll
  for (int dv = 0; dv < 8; ++dv) {
    const int dcol = dv * 16 + g * 4;
    float4 sg = *(const float4*)(P.subln_g + l * 128 + dcol);
    u32x2 zz = *(const u32x2*)(P.proj + (size_t)qrow * PW + CZA + h * 128 + dcol);
    float z0 = bf2f((bf16_t)(zz.x & 0xffffu)), z1 = bf2f((bf16_t)(zz.x >> 16));
    float z2 = bf2f((bf16_t)(zz.y & 0xffffu)), z3 = bf2f((bf16_t)(zz.y >> 16));
    float y0 = o[0][dv][0] * rs * sg.x * z0, y1 = o[0][dv][1] * rs * sg.y * z1;
    float y2 = o[0][dv][2] * rs * sg.z * z2, y3 = o[0][dv][3] * rs * sg.w * z3;
    if (dowrite) *(u32x2*)(P.proj + (size_t)qrow * PW + CQ + h * 128 + dcol) = u32x2_mk(pack2(y0, y1), pack2(y2, y3));
  }
}

DEV void phase_attn(const Params& P, int l, char* smem) {
  const int nattn = 2048 + (l < 3 ? 128 : 0);
  const int total = 160 + nattn;
  (void)total;
  for (int it = vb(); it < 160; it += vg()) carry_job(P, l, it);
#if PROBE_PH == 3
  { int flag = 0; asm volatile("" : "+s"(flag));
    for (int it = vg() - 1 - vb(); it < nattn; it += vg()) attn_item(P, l, it, smem, flag); }
#endif
  for (int it = vg() - 1 - vb(); it < nattn; it += vg()) attn_item(P, l, it, smem);
}


DEV void attn_item8(const Params& P, int l, int item, char* smem) {
  const int tid = tid512(), lane = tid & 63, wv = tid >> 6, r16 = lane & 15, g = lane >> 4;
  const int c = wv & 1, qg = wv >> 1;
  bf16_t* Ks = (bf16_t*)smem;
  bf16_t* Vs = Ks + 64 * 136;
  constexpr int BUFE = 64 * 136 + 128 * 72;
  float* X = (float*)(smem + SMEM_HALF);
  int b, h, qrow0, kt0, nkt;
  if (item < 1024) {
    b = item >> 7; h = (item >> 5) & 3;
    qrow0 = b * 4096 + (item & 31) * 128; kt0 = 0; nkt = 68;
  } else {
    int i2 = item - 1024;
    b = i2 >> 3; h = (i2 >> 1) & 3;
    qrow0 = NLAT + b * 256 + (i2 & 1) * 128; kt0 = 64; nkt = 4;
  }
  const int qrowb = qrow0 + qg * 32 + r16;
  bf16x8 qf[2][2];
#pragma unroll
  for (int qt = 0; qt < 2; ++qt)
#pragma unroll
    for (int kb = 0; kb < 2; ++kb)
      qf[qt][kb] = *(const bf16x8*)(P.proj + (size_t)(qrowb + qt * 16) * PW + CQ + h * 128 + c * 64 + kb * 32 + g * 8);
  f32x4 o[2][8];
#pragma unroll
  for (int qt = 0; qt < 2; ++qt)
#pragma unroll
    for (int dv = 0; dv < 8; ++dv) o[qt][dv] = f32x4{0.f, 0.f, 0.f, 0.f};
  float mrun[2] = {0.f, 0.f}, lsum[2] = {0.f, 0.f};
  const bf16_t* Vbase = P.Vt + (size_t)(b * 4 + h) * 128 * 4352;
  u32x4 rk[2], rv[2];
  auto gl = [&](int kt) {
    int krow0, vkey0;
    if (kt < 64) { krow0 = b * 4096 + kt * 64; vkey0 = kt * 64; }
    else { krow0 = NLAT + b * 256 + (kt - 64) * 64; vkey0 = 4096 + (kt - 64) * 64; }
#pragma unroll
    for (int i = 0; i < 2; ++i) {
      int cidx = tid + 512 * i;
      rk[i] = *(const u32x4*)(P.proj + (size_t)(krow0 + (cidx >> 4)) * PW + CK + h * 128 + (cidx & 15) * 8);
      rv[i] = *(const u32x4*)(Vbase + (size_t)(cidx >> 3) * 4352 + vkey0 + (cidx & 7) * 8);
    }
  };
  auto st = [&](int buf) {
    bf16_t* Kd = Ks + buf * BUFE;
    bf16_t* Vd = Vs + buf * BUFE;
#pragma unroll
    for (int i = 0; i < 2; ++i) {
      int cidx = tid + 512 * i;
      *(u32x4*)(Kd + (cidx >> 4) * 136 + (cidx & 15) * 8) = rk[i];
      *(u32x4*)(Vd + (cidx >> 3) * 72 + (cidx & 7) * 8) = rv[i];
    }
  };
  auto tile_compute = [&](const int CUR_, const bool FIRST_) {
    const bf16_t* Kc = Ks + CUR_ * BUFE;
    const bf16_t* Vc = Vs + CUR_ * BUFE;
    f32x4 s[2][4];
#pragma unroll
    for (int qt = 0; qt < 2; ++qt) {
      const float ninit = -mrun[qt];
#pragma unroll
      for (int kt = 0; kt < 4; ++kt) s[qt][kt] = f32x4{ninit, ninit, ninit, ninit};
    }
#pragma unroll
    for (int kt = 0; kt < 4; ++kt)
#pragma unroll
      for (int kb = 0; kb < 2; ++kb) {
        bf16x8 kf = *(const bf16x8*)(Kc + (kt * 16 + r16) * 136 + c * 64 + kb * 32 + g * 8);
        s[0][kt] = mfma16(kf, qf[0][kb], s[0][kt]);
        s[1][kt] = mfma16(kf, qf[1][kb], s[1][kt]);
      }
    bf16x8 pf[2][2];
#pragma unroll
    for (int qt = 0; qt < 2; ++qt) {
      float mx = fmaxf(fmaxf(s[qt][0][0], s[qt][0][1]), fmaxf(s[qt][0][2], s[qt][0][3]));
#pragma unroll
      for (int kt = 1; kt < 4; ++kt) mx = fmaxf(mx, fmaxf(fmaxf(s[qt][kt][0], s[qt][kt][1]), fmaxf(s[qt][kt][2], s[qt][kt][3])));
      const bool first = FIRST_;
      if (__any(first || mx > 8.f)) {
        mx = fmaxf(mx, shx(mx, 16, lane));
        mx = fmaxf(mx, shx(mx, 32, lane));
        const bool need = first || mx > 8.f;
        const float dm = need ? mx : 0.f;
        const float alpha = first ? 1.f : fexp2(-dm);
        mrun[qt] += dm;
        lsum[qt] *= alpha;
#pragma unroll
        for (int dv = 0; dv < 8; ++dv) o[qt][dv] = o[qt][dv] * alpha;
#pragma unroll
        for (int kt = 0; kt < 4; ++kt) s[qt][kt] = s[qt][kt] - dm;
      }
      float ps = 0.f;
#pragma unroll
      for (int kt = 0; kt < 4; ++kt)
#pragma unroll
        for (int j = 0; j < 4; ++j) { s[qt][kt][j] = fexp2(s[qt][kt][j]); ps += s[qt][kt][j]; }
      lsum[qt] += ps;
#pragma unroll
      for (int kb2 = 0; kb2 < 2; ++kb2) {
        u32x4 pk = u32x4_mk(pack2(s[qt][2 * kb2][0], s[qt][2 * kb2][1]), pack2(s[qt][2 * kb2][2], s[qt][2 * kb2][3]),
                            pack2(s[qt][2 * kb2 + 1][0], s[qt][2 * kb2 + 1][1]), pack2(s[qt][2 * kb2 + 1][2], s[qt][2 * kb2 + 1][3]));
        pf[qt][kb2] = as_bf16x8(pk);
      }
    }
    bf16x8 vfr[2][2][2];
    auto ldv = [&](int slot, int dvp) {
#pragma unroll
      for (int e = 0; e < 2; ++e)
#pragma unroll
        for (int kb2 = 0; kb2 < 2; ++kb2) {
          const bf16_t* vp = Vc + ((dvp * 2 + e) * 16 + r16) * 72 + kb2 * 32 + g * 4;
          u32x2 v0 = *(const u32x2*)vp, v1 = *(const u32x2*)(vp + 16);
          vfr[slot][e][kb2] = as_bf16x8(u32x4_mk(v0.x, v0.y, v1.x, v1.y));
        }
    };
    ldv(0, 0);
#pragma unroll
    for (int dvp = 0; dvp < 4; ++dvp) {
      if (dvp < 3) ldv((dvp + 1) & 1, dvp + 1);
      __builtin_amdgcn_sched_barrier(0);
#pragma unroll
      for (int e = 0; e < 2; ++e)
#pragma unroll
        for (int kb2 = 0; kb2 < 2; ++kb2) {
          o[0][dvp * 2 + e] = mfma16(vfr[dvp & 1][e][kb2], pf[0][kb2], o[0][dvp * 2 + e]);
          o[1][dvp * 2 + e] = mfma16(vfr[dvp & 1][e][kb2], pf[1][kb2], o[1][dvp * 2 + e]);
        }
      __builtin_amdgcn_sched_barrier(0);
    }
  };
  const int ktl = kt0 + nkt - 1;
  gl(kt0);
  __syncthreads();
  st(0);
  gl(kt0 + 1);
  st(1);
  gl(min(kt0 + 2, ktl));
  __syncthreads();
  for (int T = 0; 2 * T < nkt; ++T) {
    const int base = (T & 1) * 2, nbase = 2 - base;
    if (2 * T + 2 < nkt) st(nbase);
    gl(min(kt0 + 2 * T + 3, ktl));
    tile_compute(base, T == 0);
    if (2 * T + 3 < nkt) st(nbase + 1);
    gl(min(kt0 + 2 * T + 4, ktl));
    tile_compute(base + 1, false);
    __syncthreads();
  }
  const float lam = P.lamv[l];
#pragma unroll
  for (int qt = 0; qt < 2; ++qt) {
    float lq = lsum[qt];
    lq += shx(lq, 16, lane); lq += shx(lq, 32, lane);
    const float sc = (c == 0 ? 1.f : lam) / lq;
#pragma unroll
    for (int dv = 0; dv < 8; ++dv) o[qt][dv] = o[qt][dv] * sc;
  }
  if (c == 1) {
#pragma unroll
    for (int qt = 0; qt < 2; ++qt)
#pragma unroll
      for (int dv = 0; dv < 8; ++dv)
        *(f32x4*)(X + (size_t)((qg * 2 + qt) * 16 + r16) * 128 + dv * 16 + g * 4) = o[qt][dv];
  }
  __syncthreads();
  if (c == 0) {
    const float lam_init = 0.8f - 0.6f * expf(-0.3f * (float)l);
#pragma unroll
    for (int qt = 0; qt < 2; ++qt) {
      float ss = 0.f;
#pragma unroll
      for (int dv = 0; dv < 8; ++dv) {
        f32x4 o1 = *(const f32x4*)(X + (size_t)((qg * 2 + qt) * 16 + r16) * 128 + dv * 16 + g * 4);
        f32x4 v = o[qt][dv] - o1;
        o[qt][dv] = v;
        ss += v[0] * v[0] + v[1] * v[1] + v[2] * v[2] + v[3] * v[3];
      }
      ss += shx(ss, 16, lane); ss += shx(ss, 32, lane);
      const float rs = rsqrtf(ss * (1.f / 128.f) + 1e-6f) * (1.f - lam_init);
      const int qrow = qrowb + qt * 16;
#pragma unroll
      for (int dv = 0; dv < 8; ++dv) {
        const int dcol = dv * 16 + g * 4;
        float4 sg = *(const float4*)(P.subln_g + l * 128 + dcol);
        u32x2 zz = *(const u32x2*)(P.proj + (size_t)qrow * PW + CZA + h * 128 + dcol);
        float z0 = bf2f((bf16_t)(zz.x & 0xffffu)), z1 = bf2f((bf16_t)(zz.x >> 16));
        float z2 = bf2f((bf16_t)(zz.y & 0xffffu)), z3 = bf2f((bf16_t)(zz.y >> 16));
        float y0 = o[qt][dv][0] * rs * sg.x * z0, y1 = o[qt][dv][1] * rs * sg.y * z1;
        float y2 = o[qt][dv][2] * rs * sg.z * z2, y3 = o[qt][dv][3] * rs * sg.w * z3;
        *(u32x2*)(P.proj + (size_t)qrow * PW + CQ + h * 128 + dcol) = u32x2_mk(pack2(y0, y1), pack2(y2, y3));
      }
    }
  }
  __syncthreads();
}

DEV void phase_attn8(const Params& P, int l, char* smem_all) {
  const int nattn = 1024 + (l < 3 ? 64 : 0);
  for (int it = vb(); it < 160; it += vg()) carry_job(P, l, it);
  if (gridDim.x == 256) {
    const int xcd = (int)blockIdx.x & 7, slot = (int)blockIdx.x >> 3;
#pragma unroll 1
    for (int k = 0; k < 4; ++k) attn_item8(P, l, (k * 8 + xcd) * 32 + slot, smem_all);
    if (nattn > 1024 && (int)blockIdx.x >= 192) attn_item8(P, l, 1024 + 255 - (int)blockIdx.x, smem_all);
  } else {
    for (int it = (int)gridDim.x - 1 - (int)blockIdx.x; it < nattn; it += (int)gridDim.x) attn_item8(P, l, it, smem_all);
  }
}

DEV void phase_glu(const Params& P, int l, char* smem) {
  const int tid_ = tidx(); const int lane = tid_ & 63, w = tid_ >> 6;
  const int wm = w & 1, wn = w >> 1, r16 = lane & 15, g = lane >> 4;
  const bf16_t* Wl = P.WgT + (size_t)l * 512 * 512;
  for (int tile = vb(); tile < 16 * 16; tile += vg()) {
    const int m0 = (256 + (tile >> 4)) * 128, n0 = (tile & 15) * 32;
    f32x4 acc[4][1];
    zero_acc<1>(acc);
    gemm_main<32>(acc, P.proj + (size_t)m0 * PW + CUS, PW, Wl + (size_t)n0 * 512, 512, 512, smem);
#pragma unroll
    for (int mt = 0; mt < 4; ++mt) {
      const int m = m0 + wm * 64 + mt * 16 + r16;
#pragma unroll
      for (int nt = 0; nt < 1; ++nt) {
        const int n = n0 + wn * 16 + nt * 16 + g * 4;
        float4 bg = *(const float4*)(P.s5_b_glu + l * 512 + n);
        u32x2 gg = *(const u32x2*)(P.proj + (size_t)m * PW + CUS + n);
        u32x2 zz = *(const u32x2*)(P.proj + (size_t)m * PW + CZS + n);
        float y0 = bf2f((bf16_t)(gg.x & 0xffffu)) * sigmoidf_(acc[mt][nt][0] + bg.x) * bf2f((bf16_t)(zz.x & 0xffffu));
        float y1 = bf2f((bf16_t)(gg.x >> 16)) * sigmoidf_(acc[mt][nt][1] + bg.y) * bf2f((bf16_t)(zz.x >> 16));
        float y2 = bf2f((bf16_t)(gg.y & 0xffffu)) * sigmoidf_(acc[mt][nt][2] + bg.z) * bf2f((bf16_t)(zz.y & 0xffffu));
        float y3 = bf2f((bf16_t)(gg.y >> 16)) * sigmoidf_(acc[mt][nt][3] + bg.w) * bf2f((bf16_t)(zz.y >> 16));
        *(u32x2*)(P.proj + (size_t)m * PW + CZS + n) = u32x2_mk(pack2(y0, y1), pack2(y2, y3));
      }
    }
  }
}

DEV void phase_merge(const Params& P, int l, char* smem) {
  const int tid_ = tidx(); const int lane = tid_ & 63, w = tid_ >> 6;
  const int wm = w & 1, wn = w >> 1, r16 = lane & 15, g = lane >> 4;
  const bf16_t* Wl = P.WinT + (size_t)l * 7168 * 1024;
  for (int tile = vb(); tile < 16 * 32; tile += vg()) {
    const int m0 = (256 + (tile >> 5)) * 128, n0 = (tile & 31) * 32;
    f32x4 accM[4][1];
    zero_acc<1>(accM);
#pragma unroll 1
    for (int nb = 0; nb < 3; ++nb) {
      f32x4 accG[4][1], accY[4][1];
      zero_acc<1>(accG);
      zero_acc<1>(accY);
      gemm_main<32>(accG, P.hbuf + (size_t)m0 * 1024, 1024, Wl + (size_t)(4096 + nb * 1024 + n0) * 1024, 1024, 1024, smem);
      const int cofs = nb == 0 ? CQ : (nb == 1 ? CZR : CZS);
      gemm_main<32>(accY, P.proj + (size_t)m0 * PW + cofs, PW, P.WbT + ((size_t)(l * 3 + nb) * 1024 + n0) * 512, 512, 512, smem);
#pragma unroll
      for (int mt = 0; mt < 4; ++mt)
#pragma unroll
        for (int nt = 0; nt < 1; ++nt)
#pragma unroll
          for (int j = 0; j < 4; ++j) accM[mt][nt][j] += sigmoidf_(accG[mt][nt][j]) * accY[mt][nt][j];
    }
#pragma unroll
    for (int mt = 0; mt < 4; ++mt) {
      const int m = m0 + wm * 64 + mt * 16 + r16;
#pragma unroll
      for (int nt = 0; nt < 1; ++nt) {
        const int n = n0 + wn * 16 + nt * 16 + g * 4;
        f32x4 v = accM[mt][nt];
        *(u32x2*)(P.proj + (size_t)m * PW + CM + n) = u32x2_mk(pack2(v[0], v[1]), pack2(v[2], v[3]));
      }
    }
  }
}

DEV void phase_out(const Params& P, int l, char* smem) {
  const int tid_ = tidx(); const int lane = tid_ & 63, w = tid_ >> 6;
  const int wm = w & 1, wn = w >> 1, r16 = lane & 15, g = lane >> 4;
  const bf16_t* Wl = P.WoT + (size_t)l * 1024 * 1024;
  for (int tile = vb(); tile < 16 * 32; tile += vg()) {
    const int m0 = (256 + (tile >> 5)) * 128, n0 = (tile & 31) * 32;
    f32x4 acc[4][1];
    zero_acc<1>(acc);
    gemm_main<32>(acc, P.proj + (size_t)m0 * PW + CM, PW, Wl + (size_t)n0 * 1024, 1024, 1024, smem);
#pragma unroll
    for (int mt = 0; mt < 4; ++mt) {
      const int m = m0 + wm * 64 + mt * 16 + r16;
      const float* src;
      float* dst;
      if (m < NLAT) { src = (l == 0 ? P.x : P.out) + (size_t)m * 1024; dst = P.out + (size_t)m * 1024; }
      else { src = (l == 0 ? P.ctx : P.ctxres) + (size_t)(m - NLAT) * 1024; dst = P.ctxres + (size_t)(m - NLAT) * 1024; }
      const float* gt = P.mods + (size_t)(l * 9 + mod_row(m)) * 3072 + 2048;
#pragma unroll
      for (int nt = 0; nt < 1; ++nt) {
        const int n = n0 + wn * 16 + nt * 16 + g * 4;
        float4 xo = *(const float4*)(src + n);
        float4 gg = *(const float4*)(gt + n);
        float4 r;
        r.x = xo.x + gg.x * acc[mt][nt][0];
        r.y = xo.y + gg.y * acc[mt][nt][1];
        r.z = xo.z + gg.z * acc[mt][nt][2];
        r.w = xo.w + gg.w * acc[mt][nt][3];
        *(float4*)(dst + n) = r;
      }
    }
  }
}

DEV void phase_final(const Params& P) {
  const int tid_ = tidx(); const int lane = tid_ & 63, w = tid_ >> 6;
  const int stride = vg() * 4;
  int r = vb() * 4 + w;
  float4 v[4], vn[4];
  if (r < NLAT) {
#pragma unroll
    for (int i = 0; i < 4; ++i) v[i] = *(const float4*)(P.out + (size_t)r * 1024 + i * 256 + lane * 4);
  }
  for (; r < NLAT; r += stride) {
    const int rn = r + stride;
    if (rn < NLAT) {
#pragma unroll
      for (int i = 0; i < 4; ++i) vn[i] = *(const float4*)(P.out + (size_t)rn * 1024 + i * 256 + lane * 4);
    }
    float* src = P.out + (size_t)r * 1024;
    float ss = 0.f;
#pragma unroll
    for (int i = 0; i < 4; ++i) ss += v[i].x * v[i].x + v[i].y * v[i].y + v[i].z * v[i].z + v[i].w * v[i].w;
#pragma unroll
    for (int o = 32; o > 0; o >>= 1) ss += __shfl_xor(ss, o);
    float rstd = rsqrtf(ss * (1.f / 1024.f) + 1e-6f);
#pragma unroll
    for (int i = 0; i < 4; ++i) {
      int k = i * 256 + lane * 4;
      float4 g4 = *(const float4*)(P.final_g + k);
      float4 r4;
      r4.x = v[i].x * rstd * g4.x; r4.y = v[i].y * rstd * g4.y; r4.z = v[i].z * rstd * g4.z; r4.w = v[i].w * rstd * g4.w;
      *(float4*)(src + k) = r4;
    }
#pragma unroll
    for (int i = 0; i < 4; ++i) v[i] = vn[i];
  }
}

namespace pg8 {
#define PG8_LAS __attribute__((address_space(3)))
constexpr int BM = 256, BK = 64, HALF = 128, HTB = HALF * BK * 2, NXCD = 8, WGM = 8;
DEV int lds_byte(int r, int c) { const int st = (r >> 4) * 2 + (c >> 5), rr = r & 15, cc = c & 31, ob = rr * 64 + cc * 2; return st * 1024 + (ob ^ (((ob >> 9) & 1) << 5)); }
DEV void stage_rc(int b, int& R, int& C) { const int st = b / 1024, sb = b % 1024, swz = sb ^ (((sb >> 9) & 1) << 5); R = (st >> 1) * 16 + swz / 64; C = (st & 1) * 32 + (swz % 64) / 2; }
DEV int perm32(int rho) { const int n = rho >> 4, i = rho & 15; return 8 * (i >> 2) + 4 * n + (i & 3); }
struct Unit { int pm, pn; };
struct Gemm { const bf16_t* A; const bf16_t* Bt; int M, N, K, lda; };
struct StaticOrder {
  int nM, nN, nwg, G, c;
  DEV void init(int M, int N, int G_, int c_) { nM = M / BM; nN = N / BM; nwg = nM * nN; G = G_; c = c_; }
  DEV bool next(int i, Unit& u) const {
    const long L = (long)i * G + c; if (L >= nwg) return false;
    int wgid = (int)L; { const int q = nwg / NXCD, r = nwg % NXCD, xcd = wgid % NXCD, off = wgid / NXCD; wgid = (xcd < r ? xcd * (q + 1) : r * (q + 1) + (xcd - r) * q) + off; }
    const int nig = WGM * nN, gid = wgid / nig, fm = gid * WGM, gsz = (nM - fm) < WGM ? (nM - fm) : WGM;
    u.pm = fm + ((wgid % nig) % gsz); u.pn = (wgid % nig) / gsz; return true;
  }
};
template <class Epi>
DEV void gemm_phase(PG8_LAS unsigned char* lds, const Gemm g, const StaticOrder& S, const Epi& E) {
  const int tid = tid512(), wid = __builtin_amdgcn_readfirstlane(tid >> 6), lane = tid & 63, wr = wid >> 2, wc = wid & 3, fr = lane & 15, fq = lane >> 4;
  const int K = g.K, nt = K / BK, lda = g.lda;
  unsigned voffA[2], voffB[2];
#pragma unroll
  for (int i = 0; i < 2; ++i) { int R, C; stage_rc(tid * 16 + i * 8192, R, C);
    const int Rb = (R & ~31) + perm32(R & 31);
    voffA[i] = (unsigned)(R * lda + C) * 2u; voffB[i] = (unsigned)(Rb * K + C) * 2u; }
  const size_t kstep = (size_t)(BK * 2);
  const size_t hstepA = (size_t)HALF * lda * 2, hstepB = (size_t)HALF * K * 2;
  const size_t tstepA = 2 * hstepA, tstepB = 2 * hstepB;
  const unsigned ldsw = (unsigned)wid * 1024u;
  const int aoff = lds_byte(wr * 64 + fr, fq * 8), boff = lds_byte(wc * 32 + fr, fq * 8);
#define PG8_SA(b, h) (((b) * 2 + (h)) * HTB)
#define PG8_SB(b, h) ((4 + (b) * 2 + (h)) * HTB)
#define PG8_STAGE(bufoff, gbase, voff) do { _Pragma("unroll") for (int _i = 0; _i < 2; ++_i) \
    __builtin_amdgcn_global_load_lds((const unsigned*)((const char*)(gbase) + (voff)[_i]), (PG8_LAS unsigned*)(lds + (bufoff) + ldsw + _i * 8192), 16, 0, 0); } while (0)
#define PG8_LDA(dst, b, h) do { _Pragma("unroll") for (int m = 0; m < 4; ++m) _Pragma("unroll") for (int k = 0; k < 2; ++k) dst[m][k] = *(const PG8_LAS bf16x8*)(lds + PG8_SA(b, h) + aoff + m * 2048 + k * 1024); } while (0)
#define PG8_LDB(dst, b, h) do { _Pragma("unroll") for (int n = 0; n < 2; ++n) _Pragma("unroll") for (int k = 0; k < 2; ++k) dst[n][k] = *(const PG8_LAS bf16x8*)(lds + PG8_SB(b, h) + boff + n * 2048 + k * 1024); } while (0)
#define PG8_MMA(ai, bj, At, Bt) do { __builtin_amdgcn_s_setprio(1); _Pragma("unroll") for (int m = 0; m < 4; ++m) _Pragma("unroll") for (int n = 0; n < 2; ++n) _Pragma("unroll") for (int k = 0; k < 2; ++k) \
    acc[ai][bj][m][n] = __builtin_amdgcn_mfma_f32_16x16x32_bf16(Bt[n][k], At[m][k], acc[ai][bj][m][n], 0, 0, 0); __builtin_amdgcn_s_setprio(0); } while (0)
#define PG8_WAIT_V(n) asm volatile("s_waitcnt vmcnt(" #n ")" ::: "memory")
#define PG8_WAIT_L(n) asm volatile("s_waitcnt lgkmcnt(" #n ")" ::: "memory")
#define PG8_BAR __builtin_amdgcn_s_barrier()
#define PG8_SCHED __builtin_amdgcn_sched_barrier(0)
  Unit cur, nxt; int ui = 0;
  if (!S.next(0, cur)) return;
  f32x4 acc[2][2][4][2];
#pragma unroll
  for (int a = 0; a < 2; ++a)
#pragma unroll
    for (int b = 0; b < 2; ++b)
#pragma unroll
      for (int m = 0; m < 4; ++m)
#pragma unroll
        for (int n = 0; n < 2; ++n) acc[a][b][m][n] = f32x4{0.f, 0.f, 0.f, 0.f};
  bf16x8 At[4][2], B0[2][2], B1[2][2];
  const char* cA = (const char*)g.A + (size_t)cur.pm * tstepA; const char* cB = (const char*)g.Bt + (size_t)cur.pn * tstepB;
  PG8_STAGE(PG8_SB(0, 0), cB, voffB); PG8_STAGE(PG8_SA(0, 0), cA, voffA); PG8_STAGE(PG8_SB(0, 1), cB + hstepB, voffB); PG8_STAGE(PG8_SA(0, 1), cA + hstepA, voffA);
  if (wr == 1) PG8_BAR;
  PG8_WAIT_V(4); PG8_BAR;
  PG8_STAGE(PG8_SB(1, 0), cB + kstep, voffB); PG8_STAGE(PG8_SA(1, 0), cA + kstep, voffA); PG8_STAGE(PG8_SB(1, 1), cB + hstepB + kstep, voffB);
  PG8_WAIT_V(6); PG8_BAR;
  for (;;) {
    const bool has_next = S.next(ui + 1, nxt);
    const char* nA = has_next ? (const char*)g.A + (size_t)nxt.pm * tstepA : cA; const char* nB = has_next ? (const char*)g.Bt + (size_t)nxt.pn * tstepB : cB;
    for (int t = 0; t < nt; t += 2) {
      const bool last = (t == nt - 2);
      const char* a1 = cA + (size_t)(t + 1) * kstep;
      const char* a2 = last ? nA : cA + (size_t)(t + 2) * kstep; const char* b2 = last ? nB : cB + (size_t)(t + 2) * kstep;
      const char* a3 = a2 + kstep; const char* b3 = b2 + kstep;
      PG8_LDB(B0, 0, 0); PG8_SCHED; PG8_LDA(At, 0, 0); PG8_STAGE(PG8_SA(1, 1), a1 + hstepA, voffA);
      PG8_WAIT_L(8); PG8_BAR; PG8_WAIT_L(0); PG8_MMA(0, 0, At, B0); PG8_BAR; PG8_SCHED;
      PG8_LDB(B1, 0, 1); PG8_STAGE(PG8_SB(0, 0), b2, voffB);
      PG8_BAR; PG8_WAIT_L(0); PG8_MMA(0, 1, At, B1); PG8_BAR;
      PG8_LDA(At, 0, 1); PG8_STAGE(PG8_SA(0, 0), a2, voffA);
      PG8_BAR; PG8_WAIT_L(0); PG8_MMA(1, 0, At, B0); PG8_BAR; PG8_SCHED;
      PG8_STAGE(PG8_SB(0, 1), b2 + hstepB, voffB);
      PG8_WAIT_V(6); PG8_BAR; PG8_MMA(1, 1, At, B1); PG8_BAR;
      PG8_LDB(B0, 1, 0); PG8_SCHED; PG8_LDA(At, 1, 0); PG8_STAGE(PG8_SA(0, 1), a2 + hstepA, voffA);
      PG8_WAIT_L(8); PG8_BAR; PG8_WAIT_L(0); PG8_MMA(0, 0, At, B0); PG8_BAR; PG8_SCHED;
      PG8_LDB(B1, 1, 1); PG8_STAGE(PG8_SB(1, 0), b3, voffB);
      PG8_BAR; PG8_WAIT_L(0); PG8_MMA(0, 1, At, B1); PG8_BAR;
      PG8_LDA(At, 1, 1); PG8_STAGE(PG8_SA(1, 0), a3, voffA);
      PG8_BAR; PG8_WAIT_L(0); PG8_MMA(1, 0, At, B0); PG8_BAR; PG8_SCHED;
      PG8_STAGE(PG8_SB(1, 1), b3 + hstepB, voffB);
      PG8_WAIT_V(6); PG8_BAR; PG8_MMA(1, 1, At, B1); PG8_BAR;
    }
    E(acc, cur, wr, wc, fr, fq);
    if (!has_next) break;
#pragma unroll
    for (int a = 0; a < 2; ++a)
#pragma unroll
      for (int b = 0; b < 2; ++b)
#pragma unroll
        for (int m = 0; m < 4; ++m)
#pragma unroll
          for (int n = 0; n < 2; ++n) acc[a][b][m][n] = f32x4{0.f, 0.f, 0.f, 0.f};
    cur = nxt; cA = nA; cB = nB; ++ui;
  }
  PG8_WAIT_V(0);
  if (wr == 0) PG8_BAR;
  PG8_BAR;
#undef PG8_SA
#undef PG8_SB
#undef PG8_STAGE
#undef PG8_LDA
#undef PG8_LDB
#undef PG8_MMA
#undef PG8_WAIT_V
#undef PG8_WAIT_L
#undef PG8_BAR
#undef PG8_SCHED
}
}

DEV u32x4 pack8(const f32x4& v0, const f32x4& v1) { return u32x4_mk(pack2(v0[0], v0[1]), pack2(v0[2], v0[3]), pack2(v1[0], v1[1]), pack2(v1[2], v1[3])); }
DEV float bflo(unsigned w) { return __uint_as_float(w << 16); }
DEV float bfhi(unsigned w) { return __uint_as_float(w & 0xffff0000u); }
struct EpiProj {
  const Params* Pp; int l;
  DEV void operator()(const f32x4 (&acc)[2][2][4][2], const pg8::Unit& u, int wr, int wc, int fr, int fq) const {
    const Params& P = *Pp;
    const float QS = 0.125f * 1.4426950408889634f;
#pragma unroll
    for (int ai = 0; ai < 2; ++ai)
#pragma unroll
      for (int mm = 0; mm < 4; ++mm) {
        const int m = u.pm * 256 + ai * 128 + wr * 64 + mm * 16 + fr;
#pragma unroll
        for (int bj = 0; bj < 2; ++bj) {
          const int region = (u.pn * 256 + bj * 128) >> 9;
          const int n8 = u.pn * 256 + bj * 128 + wc * 32 + 8 * fq;
          f32x4 v0 = acc[ai][bj][mm][0], v1 = acc[ai][bj][mm][1];
          if (region <= 1) {
            if (m < NLAT) {
              const int t = m & 4095;
              const int i0 = (n8 & 63) >> 1;
              const float4 c0 = *(const float4*)(P.rope + (size_t)t * 32 + i0);
              const float4 c1 = *(const float4*)(P.rope + (size_t)t * 32 + i0 + 2);
              v0 = f32x4{v0[0] * c0.x - v0[1] * c0.y, v0[0] * c0.y + v0[1] * c0.x, v0[2] * c0.z - v0[3] * c0.w, v0[2] * c0.w + v0[3] * c0.z};
              v1 = f32x4{v1[0] * c1.x - v1[1] * c1.y, v1[0] * c1.y + v1[1] * c1.x, v1[2] * c1.z - v1[3] * c1.w, v1[2] * c1.w + v1[3] * c1.z};
            }
            if (region == 0) { v0 = v0 * QS; v1 = v1 * QS; }
            *(u32x4*)(P.proj + (size_t)m * PW + n8) = pack8(v0, v1);
          } else if (region == 2) {
            int b, key;
            if (m < NLAT) { b = m >> 12; key = m & 4095; }
            else { b = (m - NLAT) >> 8; key = 4096 + ((m - NLAT) & 255); }
            bf16_t* vp = P.Vt + ((size_t)b * 512 + (n8 - 1024)) * 4352 + key;
#pragma unroll
            for (int j = 0; j < 4; ++j) { vp[(size_t)j * 4352] = f2bf(v0[j]); vp[(size_t)(4 + j) * 4352] = f2bf(v1[j]); }
          } else {
            if (region == 3 || region == 5 || region == 7) {
#pragma unroll
              for (int j = 0; j < 4; ++j) { v0[j] = siluf_(v0[j]); v1[j] = siluf_(v1[j]); }
            }
            *(u32x4*)(P.proj + (size_t)m * PW + n8) = pack8(v0, v1);
          }
        }
      }
  }
};
struct EpiGlu {
  const Params* Pp; int l;
  DEV void operator()(const f32x4 (&acc)[2][2][4][2], const pg8::Unit& u, int wr, int wc, int fr, int fq) const {
    const Params& P = *Pp;
#pragma unroll
    for (int ai = 0; ai < 2; ++ai)
#pragma unroll
      for (int mm = 0; mm < 4; ++mm) {
        const int m = u.pm * 256 + ai * 128 + wr * 64 + mm * 16 + fr;
#pragma unroll
        for (int bj = 0; bj < 2; ++bj) {
          const int n8 = u.pn * 256 + bj * 128 + wc * 32 + 8 * fq;
          const f32x4 a0 = acc[ai][bj][mm][0], a1 = acc[ai][bj][mm][1];
          const float4 b0 = *(const float4*)(P.s5_b_glu + l * 512 + n8), b1 = *(const float4*)(P.s5_b_glu + l * 512 + n8 + 4);
          const u32x4 gg = *(const u32x4*)(P.proj + (size_t)m * PW + CUS + n8);
          const u32x4 zz = *(const u32x4*)(P.proj + (size_t)m * PW + CZS + n8);
          f32x4 y0, y1;
          y0[0] = bflo(gg.x) * sigmoidf_(a0[0] + b0.x) * bflo(zz.x); y0[1] = bfhi(gg.x) * sigmoidf_(a0[1] + b0.y) * bfhi(zz.x);
          y0[2] = bflo(gg.y) * sigmoidf_(a0[2] + b0.z) * bflo(zz.y); y0[3] = bfhi(gg.y) * sigmoidf_(a0[3] + b0.w) * bfhi(zz.y);
          y1[0] = bflo(gg.z) * sigmoidf_(a1[0] + b1.x) * bflo(zz.z); y1[1] = bfhi(gg.z) * sigmoidf_(a1[1] + b1.y) * bfhi(zz.z);
          y1[2] = bflo(gg.w) * sigmoidf_(a1[2] + b1.z) * bflo(zz.w); y1[3] = bfhi(gg.w) * sigmoidf_(a1[3] + b1.w) * bfhi(zz.w);
          *(u32x4*)(P.proj + (size_t)m * PW + CZS + n8) = pack8(y0, y1);
        }
      }
  }
};
struct EpiOut {
  const Params* Pp; int l;
  DEV void operator()(const f32x4 (&acc)[2][2][4][2], const pg8::Unit& u, int wr, int wc, int fr, int fq) const {
    const Params& P = *Pp;
#pragma unroll
    for (int ai = 0; ai < 2; ++ai)
#pragma unroll
      for (int mm = 0; mm < 4; ++mm) {
        const int m = u.pm * 256 + ai * 128 + wr * 64 + mm * 16 + fr;
        const float* src;
        float* dst;
        if (m < NLAT) { src = (l == 0 ? P.x : P.out) + (size_t)m * 1024; dst = P.out + (size_t)m * 1024; }
        else { src = (l == 0 ? P.ctx : P.ctxres) + (size_t)(m - NLAT) * 1024; dst = P.ctxres + (size_t)(m - NLAT) * 1024; }
        const float* gt = P.mods + (size_t)(l * 9 + mod_row(m)) * 3072 + 2048;
#pragma unroll
        for (int bj = 0; bj < 2; ++bj) {
          const int n8 = u.pn * 256 + bj * 128 + wc * 32 + 8 * fq;
#pragma unroll
          for (int nn = 0; nn < 2; ++nn) {
            const f32x4 a = acc[ai][bj][mm][nn];
            const int n = n8 + 4 * nn;
            float4 xo = *(const float4*)(src + n);
            float4 gg = *(const float4*)(gt + n);
            float4 r;
            r.x = xo.x + gg.x * a[0];
            r.y = xo.y + gg.y * a[1];
            r.z = xo.z + gg.z * a[2];
            r.w = xo.w + gg.w * a[3];
            *(float4*)(dst + n) = r;
          }
        }
      }
  }
};
struct EpiYB {
  const Params* Pp; int l;
  DEV void operator()(const f32x4 (&acc)[2][2][4][2], const pg8::Unit& u, int wr, int wc, int fr, int fq) const {
    const Params& P = *Pp;
#pragma unroll
    for (int ai = 0; ai < 2; ++ai)
#pragma unroll
      for (int mm = 0; mm < 4; ++mm) {
        const int m = u.pm * 256 + ai * 128 + wr * 64 + mm * 16 + fr;
#pragma unroll
        for (int bj = 0; bj < 2; ++bj) {
          const int n8 = u.pn * 256 + bj * 128 + wc * 32 + 8 * fq;
          *(u32x4*)(P.proj + (size_t)m * PW + CZA + n8) = pack8(acc[ai][bj][mm][0], acc[ai][bj][mm][1]);
        }
      }
  }
};
struct EpiGate {
  const Params* Pp; int nb;
  DEV void operator()(const f32x4 (&acc)[2][2][4][2], const pg8::Unit& u, int wr, int wc, int fr, int fq) const {
    const Params& P = *Pp;
#pragma unroll
    for (int ai = 0; ai < 2; ++ai)
#pragma unroll
      for (int mm = 0; mm < 4; ++mm) {
        const int m = u.pm * 256 + ai * 128 + wr * 64 + mm * 16 + fr;
#pragma unroll
        for (int bj = 0; bj < 2; ++bj) {
          const int n8 = u.pn * 256 + bj * 128 + wc * 32 + 8 * fq;
          const f32x4 a0 = acc[ai][bj][mm][0], a1 = acc[ai][bj][mm][1];
          const u32x4 yb = *(const u32x4*)(P.proj + (size_t)m * PW + CZA + n8);
          f32x4 v0, v1;
          v0[0] = sigmoidf_(a0[0]) * bflo(yb.x); v0[1] = sigmoidf_(a0[1]) * bfhi(yb.x);
          v0[2] = sigmoidf_(a0[2]) * bflo(yb.y); v0[3] = sigmoidf_(a0[3]) * bfhi(yb.y);
          v1[0] = sigmoidf_(a1[0]) * bflo(yb.z); v1[1] = sigmoidf_(a1[1]) * bfhi(yb.z);
          v1[2] = sigmoidf_(a1[2]) * bflo(yb.w); v1[3] = sigmoidf_(a1[3]) * bfhi(yb.w);
          if (nb > 0) {
            const u32x4 pv = *(const u32x4*)(P.proj + (size_t)m * PW + CM + n8);
            v0[0] += bflo(pv.x); v0[1] += bfhi(pv.x); v0[2] += bflo(pv.y); v0[3] += bfhi(pv.y);
            v1[0] += bflo(pv.z); v1[1] += bfhi(pv.z); v1[2] += bflo(pv.w); v1[3] += bfhi(pv.w);
          }
          *(u32x4*)(P.proj + (size_t)m * PW + CM + n8) = pack8(v0, v1);
        }
      }
  }
};
template <class Epi>
DEV void engine_gemm_e(const Epi& E, char* smem, const bf16_t* A, int lda, const bf16_t* Bt, int M, int N, int K) {
  pg8::Gemm g{A, Bt, M, N, K, lda};
  pg8::StaticOrder S;
  S.init(M, N, (int)gridDim.x, (int)blockIdx.x);
  pg8::gemm_phase<Epi>((PG8_LAS unsigned char*)smem, g, S, E);
}
template <class Epi>
DEV void engine_gemm(const Params& P, int l, char* smem, const bf16_t* A, int lda, const bf16_t* Bt, int M, int N, int K) {
  Epi E{&P, l};
  engine_gemm_e<Epi>(E, smem, A, lda, Bt, M, N, K);
}
DEV void engine_merge(const Params& P, int l, char* smem, int M) {
#pragma unroll 1
  for (int nb = 0; nb < 3; ++nb) {
    const int cofs = nb == 0 ? CQ : (nb == 1 ? CZR : CZS);
    EpiYB ey{&P, l};
    engine_gemm_e<EpiYB>(ey, smem, P.proj + cofs, PW, P.WbT + (size_t)(l * 3 + nb) * 1024 * 512, M, 1024, 512);
    EpiGate eg{&P, nb};
    engine_gemm_e<EpiGate>(eg, smem, P.hbuf, 1024, P.WinT + ((size_t)l * 7168 + 4096 + nb * 1024) * 1024, M, 1024, 1024);
  }
}

#define XB_TMO      128
#define XB_XCNT(j)  (256  + 64 * (j))
#define XB_XSUB(j)  (1280 + 64 * (j))
#define XB_XGEN(j)  (2304 + 64 * (j))
#define XB_TOP      3328
#define XB_TOPGEN   3392
#define XCD_BAR_WORDS 3456
#define XB_SPIN_CAP (1u << 18)
#define LAS __attribute__((address_space(3)))

__device__ __forceinline__ unsigned xb_ld(unsigned* p)              { return __hip_atomic_load(p, __ATOMIC_RELAXED, __HIP_MEMORY_SCOPE_AGENT); }
__device__ __forceinline__ unsigned xb_add(unsigned* p, unsigned v) { return __hip_atomic_fetch_add(p, v, __ATOMIC_RELAXED, __HIP_MEMORY_SCOPE_AGENT); }
__device__ __forceinline__ unsigned xb_xcc_id() { return (unsigned)__builtin_amdgcn_s_getreg((3 << 11) | 20) & 0xFu; }
#define XB_SPIN(cond, bar) do { unsigned _sp = 0; while (cond) { __builtin_amdgcn_s_sleep(1); \
    if ((++_sp & 255u) == 0u) { if (xb_ld(&(bar)[XB_TMO])) break; if (_sp > XB_SPIN_CAP) { atomicAdd(&(bar)[XB_TMO], 1u); break; } } } } while (0)

struct XcdBarrier {
    unsigned* bar; unsigned x;
    volatile LAS unsigned* st;
};

__device__ __forceinline__ XcdBarrier xcd_barrier_post(unsigned* bar, volatile LAS unsigned* st) {
    XcdBarrier b; b.bar = bar; b.x = xb_xcc_id(); b.st = st;
    if (threadIdx.x == 0) (void)xb_add(&bar[XB_XCNT(b.x)], 1u);
    return b;
}
__device__ __forceinline__ void xcd_barrier_complete(unsigned* bar, unsigned x, unsigned& nloc, unsigned& nx) {
    const unsigned G = gridDim.x * gridDim.y * gridDim.z;
    unsigned sum, cnt, mine, sp = 0u;
    for (;;) {
        sum = 0u; cnt = 0u; mine = 0u;
#pragma unroll
        for (unsigned j = 0; j < 16; ++j) { const unsigned c = xb_ld(&bar[XB_XCNT(j)]); sum += c; cnt += (c > 0u) ? 1u : 0u; mine = (j == x) ? c : mine; }
        if (sum == G) break;
        __builtin_amdgcn_s_sleep(1);
        if ((++sp & 255u) == 0u) { if (xb_ld(&bar[XB_TMO])) break; if (sp > XB_SPIN_CAP) { atomicAdd(&bar[XB_TMO], 1u); break; } }
    }
    nloc = mine > 0u ? mine : 1u; nx = cnt > 0u ? cnt : 1u;
}

__device__ __forceinline__ void xcd_barrier(const XcdBarrier& b) {
    asm volatile("s_waitcnt vmcnt(0)" ::: "memory");
    __syncthreads();
    if (threadIdx.x == 0) {
        unsigned* bar = b.bar;
        __builtin_amdgcn_s_waitcnt(0);
        unsigned nloc = b.st[0], nx = b.st[1];
        if (nloc == 0u) { xcd_barrier_complete(bar, b.x, nloc, nx); b.st[0] = nloc; b.st[1] = nx; }
        const unsigned old = xb_add(&bar[XB_XSUB(b.x)], 1u);
        const unsigned gen = old / nloc;
        if (old + 1u == (gen + 1u) * nloc) {
            __builtin_amdgcn_fence(__ATOMIC_RELEASE, "agent");
            asm volatile("s_waitcnt vmcnt(0)" ::: "memory");
            const unsigned og = xb_add(&bar[XB_TOP], 1u);
            const unsigned tg = og / nx;
            if (og + 1u == (tg + 1u) * nx) xb_add(&bar[XB_TOPGEN], 1u);
            else XB_SPIN(xb_ld(&bar[XB_TOPGEN]) == tg, bar);
            __builtin_amdgcn_fence(__ATOMIC_ACQUIRE, "agent");
            xb_add(&bar[XB_XGEN(b.x)], 1u);
            asm volatile("s_waitcnt vmcnt(0)" ::: "memory");
        } else {
            XB_SPIN(xb_ld(&bar[XB_XGEN(b.x)]) == gen, bar);
            __builtin_amdgcn_fence(__ATOMIC_ACQUIRE, "agent");
            asm volatile("s_waitcnt vmcnt(0)" ::: "memory");
        }
    }
    __syncthreads();
}


#ifndef PROBE_PH
#define PROBE_PH -1
#endif
#define REPEAT(id, body) { int nrep_ = (PROBE_PH == (id)) ? 2 : 1; asm volatile("" : "+s"(nrep_)); _Pragma("unroll 1") for (int rep_ = 0; rep_ < nrep_; ++rep_) { body } }
__global__ void __launch_bounds__(512, 2) mega_kernel(Params P) {
  __shared__ __attribute__((aligned(16))) char smem_all[SMEM_BYTES];
  cg::grid_group grid = cg::this_grid();
  char* smem = smem_all + vhalf() * SMEM_HALF;
  __shared__ __attribute__((aligned(16))) unsigned xb_st[4];
  if (threadIdx.x < 4) xb_st[threadIdx.x] = 0u;
  __syncthreads();
  const XcdBarrier xb = xcd_barrier_post(P.bar, (volatile LAS unsigned*)xb_st);
  REPEAT(0, phase0(P, smem); grid.sync();)
#pragma unroll 1
  for (int l = 0; l < 4; ++l) {
    REPEAT(5, phase_norm(P, l); xcd_barrier(xb);)
    engine_gemm<EpiProj>(P, l, smem_all, P.hbuf, 1024, P.WinT + (size_t)l * 7168 * 1024, NR, 4096, 1024);
    if (l < 3 && gridDim.x == 256 && blockIdx.x >= 128) prep_layer_weights(P, l + 1, ((int)blockIdx.x - 128) * 2 + vhalf(), 256, smem);
    if (l < 3 && gridDim.x != 256) prep_layer_weights(P, l + 1, vb(), vg(), smem);
    xcd_barrier(xb);
#if PROBE_PH == 1
    engine_gemm<EpiProj>(P, l, smem_all, P.hbuf, 1024, P.WinT + (size_t)l * 7168 * 1024, NR, 4096, 1024);
    xcd_barrier(xb);
#endif
    REPEAT(2, phase_scan(P, l, false, smem); xcd_barrier(xb);)
    phase_attn8(P, l, smem_all);
    xcd_barrier(xb);
    phase_scan(P, l, true, smem);
    xcd_barrier(xb);
    engine_gemm<EpiGlu>(P, l, smem_all, P.proj + CUS, PW, P.WgT + (size_t)l * 512 * 512, NLAT, 512, 512);
    if (l < 3) phase_glu(P, l, smem);
    xcd_barrier(xb);
    engine_merge(P, l, smem_all, NLAT);
    if (l < 3) phase_merge(P, l, smem);
    xcd_barrier(xb);
#if PROBE_PH == 4
    engine_merge(P, l, smem_all, Mrows);
    xcd_barrier(xb);
#endif
    engine_gemm<EpiOut>(P, l, smem_all, P.proj + CM, PW, P.WoT + (size_t)l * 1024 * 1024, NLAT, 1024, 1024);
    if (l < 3) phase_out(P, l, smem);
    xcd_barrier(xb);
  }
  phase_final(P);
}

extern "C" void kernel_launch(void* const* d_in, const int* in_sizes, int n_in, void* d_out, int out_size, void* d_ws,
                              size_t ws_size, hipStream_t stream) {
  Params p{};
  const float** fp = (const float**)&p;
  for (int i = 0; i < 30; ++i) fp[i] = (const float*)d_in[i];
  p.out = (float*)d_out;
  char* ws = (char*)d_ws;
  size_t off = 0;
  auto take = [&](size_t bytes) { char* r = ws + off; off += (bytes + 255) & ~(size_t)255; return r; };
  p.proj = (bf16_t*)take((size_t)NR * PW * 2);
  p.hbuf = (bf16_t*)take((size_t)NR * 1024 * 2);
  p.WinT = (bf16_t*)take((size_t)4 * 7168 * 1024 * 2);
  p.WbT = (bf16_t*)take((size_t)12 * 1024 * 512 * 2);
  p.WoT = (bf16_t*)take((size_t)4 * 1024 * 1024 * 2);
  p.WgT = (bf16_t*)take((size_t)4 * 512 * 512 * 2);
  p.WlT = (bf16_t*)take((size_t)128 * 4096 * 2);
  p.Vt = (bf16_t*)take((size_t)32 * 128 * 4352 * 2);
  p.ctxres = (float*)take((size_t)2048 * 1024 * 4);
  p.mods = (float*)take((size_t)4 * 9 * 3072 * 4);
  p.lamv = (float*)take(256);
  p.lruP = (float*)take((size_t)2 * NCH * 512 * 4);
  p.lruS = (float*)take((size_t)2 * NCH * 512 * 4);
  p.rope = (float2*)take((size_t)4096 * 32 * 8);
  p.s5A = (float2*)take((size_t)256 * 64 * 8);
  p.s5A64 = (float2*)take((size_t)256 * 64 * 8);
  p.s5E = (float2*)take((size_t)2 * NCH * 32 * 64 * 8);
  p.s5drvB = (u32x4*)take((size_t)256 * 8 * 64 * 16);
  p.s5C = (u32x4*)take((size_t)128 * 4 * 64 * 16);
  p.bar = (unsigned*)take((size_t)XCD_BAR_WORDS * 4);
  if (off > ws_size) { fprintf(stderr, "workspace too small: need %zu have %zu\n", off, ws_size); return; }

  static int grid_blocks = 0;
  if (!grid_blocks) {
    int dev = 0, cus = 0, per_cu = 0;
    (void)hipGetDevice(&dev);
    (void)hipDeviceGetAttribute(&cus, hipDeviceAttributeMultiprocessorCount, dev);
    (void)hipOccupancyMaxActiveBlocksPerMultiprocessor(&per_cu, mega_kernel, 512, 0);
    if (per_cu < 1) per_cu = 1;
    if (per_cu > 1) per_cu = 1;
    grid_blocks = cus * per_cu;
  }
  (void)hipMemsetAsync(p.bar, 0, (size_t)XCD_BAR_WORDS * 4, stream);
  void* args[] = {&p};
  hipError_t e = hipLaunchCooperativeKernel((void*)mega_kernel, dim3(grid_blocks), dim3(512), args, 0, stream);
  if (e != hipSuccess) fprintf(stderr, "cooperative launch failed: %s (grid %d)\n", hipGetErrorString(e), grid_blocks);
}
```

```cpp
#include <hip/hip_runtime.h>
#include <hip/hip_bf16.h>
#include <hip/hip_cooperative_groups.h>
#include <cstdio>
#include <cstdint>
namespace cg = cooperative_groups;

#ifndef MULTI_LAUNCH
#define MULTI_LAUNCH 0
#endif

#define DEV __device__ __forceinline__
typedef unsigned short bf16_t;
using bf16x8 = __attribute__((ext_vector_type(8))) short;
using f32x4 = __attribute__((ext_vector_type(4))) float;
using u32x4 = __attribute__((ext_vector_type(4))) unsigned;
using u32x2 = __attribute__((ext_vector_type(2))) unsigned;

constexpr int NR = 34816;
constexpr int NLAT = 32768;
constexpr int PW = 4096;
constexpr int CQ = 0, CK = 512, CZA = 1536, CXR = 2048, CZR = 2560, CUS = 3072, CZS = 3584, CM = 512;
constexpr int NCH = 544;
constexpr int NPHASE = 34;
constexpr int SMEM_HALF = 73728;
constexpr int SMEM_BYTES = 2 * SMEM_HALF;

struct Params {
  const float *x, *c, *ctx, *c_ctx, *w_mod, *b_mod, *norm_g, *w_in, *lam_qk, *subln_g, *conv_w, *conv_b,
      *lru_wa, *lru_ba, *lru_wx, *lru_bx, *lru_lam, *s5_lam_re, *s5_lam_im, *s5_log_dt, *s5_b_re, *s5_b_im,
      *s5_c_re, *s5_c_im, *s5_d, *s5_w_glu, *s5_b_glu, *w_branch, *w_out, *final_g;
  float* out;
  bf16_t *proj, *hbuf, *WinT, *WbT, *WoT, *WgT, *WlT, *Vt;
  float *ctxres, *mods, *lamv, *lruP, *lruS;
  float2 *rope, *s5A, *s5A64, *s5E;
  u32x4 *s5drvB, *s5C;
  unsigned* bar;
};

DEV int tidx() { int t = threadIdx.x & 255; asm volatile("" : "+v"(t)); return t; }
DEV int tid512() { int t = threadIdx.x; asm volatile("" : "+v"(t)); return t; }
DEV int vhalf() { return __builtin_amdgcn_readfirstlane((int)(threadIdx.x >> 8)); }
DEV int vb() { return (int)blockIdx.x * 2 + vhalf(); }
DEV int vg() { return (int)gridDim.x * 2; }
DEV u32x4 u32x4_mk(unsigned a, unsigned b, unsigned c, unsigned d) { return u32x4{a, b, c, d}; }
DEV u32x2 u32x2_mk(unsigned a, unsigned b) { return u32x2{a, b}; }
typedef float f32x2_t __attribute__((ext_vector_type(2)));
typedef __bf16 bf16x2_t __attribute__((ext_vector_type(2)));
DEV bf16_t f2bf(float f) { return __builtin_bit_cast(unsigned short, (__bf16)f); }
DEV float bf2f(bf16_t h) { return __uint_as_float(((unsigned)h) << 16); }
DEV unsigned pack2(float a, float b) {
  f32x2_t v = {a, b};
  return __builtin_bit_cast(unsigned, __builtin_convertvector(v, bf16x2_t));
}
DEV float fexp2(float x) { return __builtin_amdgcn_exp2f(x); }
DEV float frcp(float x) { return __builtin_amdgcn_rcpf(x); }
DEV float sigmoidf_(float x) { return frcp(1.f + __expf(-x)); }
DEV float siluf_(float x) { return x * frcp(1.f + __expf(-x)); }
DEV float gelu_tanh(float x) {
  float u = 0.7978845608028654f * (x + 0.044715f * x * x * x);
  return x * frcp(1.f + __expf(-2.f * u));
}
DEV float shx(float v, int mask, int lane) { return __int_as_float(__builtin_amdgcn_ds_bpermute((lane ^ mask) << 2, __float_as_int(v))); }
DEV float shi(float v, int src) { return __int_as_float(__builtin_amdgcn_ds_bpermute(src << 2, __float_as_int(v))); }
DEV f32x4 mfma16(bf16x8 a, bf16x8 b, f32x4 c) { return __builtin_amdgcn_mfma_f32_16x16x32_bf16(a, b, c, 0, 0, 0); }
DEV bf16x8 as_bf16x8(u32x4 v) {
  return __builtin_bit_cast(bf16x8, v);
}

template <int NTW>
DEV void g_load(u32x4 (&ra)[4], u32x4 (&rw)[NTW], const bf16_t* __restrict__ A, int lda, const bf16_t* __restrict__ W,
                int ldw, int k0, int lrow, int loff) {
#pragma unroll
  for (int i = 0; i < 4; ++i) ra[i] = *(const u32x4*)(A + (size_t)(lrow + 32 * i) * lda + k0 + loff);
#pragma unroll
  for (int i = 0; i < NTW; ++i) rw[i] = *(const u32x4*)(W + (size_t)(lrow + 32 * i) * ldw + k0 + loff);
}
template <int NTW>
DEV void s_store(const u32x4 (&ra)[4], const u32x4 (&rw)[NTW], bf16_t* As, bf16_t* Ws, int lrow, int loff) {
#pragma unroll
  for (int i = 0; i < 4; ++i) *(u32x4*)(As + (lrow + 32 * i) * 72 + loff) = ra[i];
#pragma unroll
  for (int i = 0; i < NTW; ++i) *(u32x4*)(Ws + (lrow + 32 * i) * 72 + loff) = rw[i];
}
template <int BN>
DEV void g_compute(f32x4 (&acc)[4][BN / 32], const bf16_t* As, const bf16_t* Ws, int wm, int wn, int r16, int g) {
  constexpr int NTW = BN / 32;
#pragma unroll
  for (int kb = 0; kb < 2; ++kb) {
    bf16x8 af[4], wf[NTW];
#pragma unroll
    for (int mt = 0; mt < 4; ++mt) af[mt] = *(const bf16x8*)(As + (wm * 64 + mt * 16 + r16) * 72 + kb * 32 + g * 8);
#pragma unroll
    for (int nt = 0; nt < NTW; ++nt)
      wf[nt] = *(const bf16x8*)(Ws + (wn * (BN / 2) + nt * 16 + r16) * 72 + kb * 32 + g * 8);
#pragma unroll
    for (int mt = 0; mt < 4; ++mt)
#pragma unroll
      for (int nt = 0; nt < NTW; ++nt) acc[mt][nt] = mfma16(wf[nt], af[mt], acc[mt][nt]);
  }
}
template <int BN>
DEV void gemm_main(f32x4 (&acc)[4][BN / 32], const bf16_t* __restrict__ A, int lda, const bf16_t* __restrict__ W,
                   int ldw, int K, char* smem) {
  constexpr int NTW = BN / 32;
  constexpr int BUF = (128 + BN) * 72;
  bf16_t* As0 = (bf16_t*)smem;
  bf16_t* Ws0 = As0 + 128 * 72;
  bf16_t* As1 = As0 + BUF;
  bf16_t* Ws1 = As1 + 128 * 72;
  const int tid = tidx(), lane = tid & 63, w = tid >> 6;
  const int wm = w & 1, wn = w >> 1;
  const int r16 = lane & 15, g = lane >> 4;
  const int lrow = tid >> 3, loff = (tid & 7) * 8;
  u32x4 ra0[4], rw0[NTW], ra1[4], rw1[NTW];
  const int nk = K >> 6;
  g_load<NTW>(ra0, rw0, A, lda, W, ldw, 0, lrow, loff);
  g_load<NTW>(ra1, rw1, A, lda, W, ldw, 64, lrow, loff);
  __syncthreads();
  s_store<NTW>(ra0, rw0, As0, Ws0, lrow, loff);
  g_load<NTW>(ra0, rw0, A, lda, W, ldw, 128, lrow, loff);
  __syncthreads();
  for (int kt = 0; kt < nk; kt += 2) {
    s_store<NTW>(ra1, rw1, As1, Ws1, lrow, loff);
    g_load<NTW>(ra1, rw1, A, lda, W, ldw, min(kt + 3, nk - 1) << 6, lrow, loff);
    g_compute<BN>(acc, As0, Ws0, wm, wn, r16, g);
    __syncthreads();
    s_store<NTW>(ra0, rw0, As0, Ws0, lrow, loff);
    g_load<NTW>(ra0, rw0, A, lda, W, ldw, min(kt + 4, nk - 1) << 6, lrow, loff);
    g_compute<BN>(acc, As1, Ws1, wm, wn, r16, g);
    __syncthreads();
  }
}

template <int NT>
DEV void zero_acc(f32x4 (&acc)[4][NT]) {
#pragma unroll
  for (int i = 0; i < 4; ++i)
#pragma unroll
    for (int j = 0; j < NT; ++j) acc[i][j] = f32x4{0.f, 0.f, 0.f, 0.f};
}

DEV int mod_row(int m) { return m < NLAT ? (m >> 12) : 8; }

DEV void transpose_tile(const float* __restrict__ src, int N, bf16_t* __restrict__ dst, int K, int k0, int n0, char* smem) {
  float* tile = (float*)smem;
  const int tid = tidx();
  __syncthreads();
  {
    const int n = tid & 63, kk = tid >> 6;
#pragma unroll
    for (int i = 0; i < 16; ++i) {
      int k = kk + 4 * i;
      tile[k * 65 + n] = src[(size_t)(k0 + k) * N + n0 + n];
    }
  }
  __syncthreads();
  {
    const int k = tid & 63, nn = tid >> 6;
#pragma unroll
    for (int i = 0; i < 16; ++i) {
      int n = nn + 4 * i;
      dst[(size_t)(n0 + n) * K + k0 + k] = f2bf(tile[k * 65 + n]);
    }
  }
}

DEV void transpose_tile2(const float* __restrict__ src, int N, bf16_t* __restrict__ dst, int K, int k0, int n0, char* smem) {
  float* tile = (float*)smem;
  const int tid = tidx();
  __syncthreads();
  {
    const int n = tid & 63, kk = tid >> 6;
#pragma unroll
    for (int i = 0; i < 32; ++i) {
      int k = kk + 4 * i;
      tile[k * 65 + n] = src[(size_t)(k0 + k) * N + n0 + n];
    }
  }
  __syncthreads();
  {
    const int kp = tid & 63, nn = tid >> 6;
#pragma unroll
    for (int i = 0; i < 16; ++i) {
      int n = nn + 4 * i;
      unsigned v = pack2(tile[(2 * kp) * 65 + n], tile[(2 * kp + 1) * 65 + n]);
      *(unsigned*)(dst + (size_t)(n0 + n) * K + k0 + 2 * kp) = v;
    }
  }
}

struct TrJob { const float* src; bf16_t* dst; int N, K, k0, n0, rows; };
DEV TrJob prep_job(const Params& P, int l, int job) {
  TrJob t;
  int j = job;
  if (j < 896) {
    t.src = P.w_in + (size_t)l * 1024 * 7168; t.dst = P.WinT + (size_t)l * 7168 * 1024; t.N = 7168; t.K = 1024;
    t.k0 = (j / 112) * 128; t.n0 = (j % 112) * 64; t.rows = 128; return t;
  }
  j -= 896;
  if (j < 192) {
    const int mat = l * 3 + j / 64, q = j % 64;
    t.src = P.w_branch + (size_t)mat * 512 * 1024; t.dst = P.WbT + (size_t)mat * 1024 * 512; t.N = 1024; t.K = 512;
    t.k0 = (q / 16) * 128; t.n0 = (q % 16) * 64; t.rows = 128; return t;
  }
  j -= 192;
  if (j < 128) {
    t.src = P.w_out + (size_t)l * 1024 * 1024; t.dst = P.WoT + (size_t)l * 1024 * 1024; t.N = 1024; t.K = 1024;
    t.k0 = (j / 16) * 128; t.n0 = (j % 16) * 64; t.rows = 128; return t;
  }
  j -= 128;
  if (j < 32) {
    t.src = P.s5_w_glu + (size_t)l * 512 * 512; t.dst = P.WgT + (size_t)l * 512 * 512; t.N = 512; t.K = 512;
    t.k0 = (j / 8) * 128; t.n0 = (j % 8) * 64; t.rows = 128; return t;
  }
  j -= 32;
  {
    const int jj = l * 32 + j;
    const int blk = jj & 7, which = (jj >> 3) & 1, ld = jj >> 4;
    t.src = (which ? P.lru_wx : P.lru_wa) + (size_t)(ld * 8 + blk) * 4096; t.dst = P.WlT + (size_t)jj * 4096; t.N = 64; t.K = 64;
    t.k0 = 0; t.n0 = 0; t.rows = 64; return t;
  }
}
DEV void prep_load(const TrJob& t, float (&v)[32], int tid) {
  const int n = tid & 63, kk = tid >> 6;
#pragma unroll
  for (int i = 0; i < 32; ++i) {
    const int k = kk + 4 * i;
    v[i] = (k < t.rows) ? t.src[(size_t)(t.k0 + k) * t.N + t.n0 + n] : 0.f;
  }
}
DEV void prep_layer_weights(const Params& P, int l, int first, int stride, char* smem) {
  float* tile = (float*)smem;
  const int tid = tidx();
  if (first >= 1280) return;
  TrJob cur = prep_job(P, l, first);
  float v[32];
  prep_load(cur, v, tid);
  for (int job = first; job < 1280; job += stride) {
    __syncthreads();
    {
      const int n = tid & 63, kk = tid >> 6;
#pragma unroll
      for (int i = 0; i < 32; ++i) tile[(kk + 4 * i) * 65 + n] = v[i];
    }
    const bool has_next = job + stride < 1280;
    TrJob nxt = cur;
    if (has_next) { nxt = prep_job(P, l, job + stride); prep_load(nxt, v, tid); }
    __syncthreads();
    {
      const int kp = tid & 63, nn = tid >> 6;
      if (2 * kp < cur.rows) {
#pragma unroll
        for (int i = 0; i < 16; ++i) {
          const int n = nn + 4 * i;
          const unsigned pk = pack2(tile[(2 * kp) * 65 + n], tile[(2 * kp + 1) * 65 + n]);
          *(unsigned*)(cur.dst + (size_t)(cur.n0 + n) * cur.K + cur.k0 + 2 * kp) = pk;
        }
      }
    }
    cur = nxt;
  }
}

DEV void phase0(const Params& P, char* smem) {
  const int tid = tidx();
  prep_layer_weights(P, 0, vb(), vg(), smem);
  constexpr int J_MOD = 768, J_ROPE = 512, J_S5 = 256;
  constexpr int JT = J_MOD + J_ROPE + J_S5 + 1;
  for (int job = vb(); job < JT; job += vg()) {
    int j = job;
    if (j < J_MOD) {
      int l = j / 192, jt = j % 192;
      float* sc = (float*)smem;
      float* red = sc + 9216;
      __syncthreads();
      for (int idx = tid; idx < 9216; idx += 256) {
        int r = idx >> 10, k = idx & 1023;
        float v = r < 8 ? P.c[r * 1024 + k] : P.c_ctx[k];
        sc[idx] = siluf_(v);
      }
      __syncthreads();
      const int jj = tid & 15, kq = tid >> 4, col = jt * 16 + jj;
      float a[9];
#pragma unroll
      for (int r = 0; r < 9; ++r) a[r] = 0.f;
      const float* wp = P.w_mod + (size_t)l * 1024 * 3072 + col;
#pragma unroll 16
      for (int k = kq * 64; k < kq * 64 + 64; ++k) {
        float wv = wp[(size_t)k * 3072];
#pragma unroll
        for (int r = 0; r < 9; ++r) a[r] += sc[r * 1024 + k] * wv;
      }
#pragma unroll
      for (int r = 0; r < 9; ++r) red[(kq * 9 + r) * 16 + jj] = a[r];
      __syncthreads();
      if (tid < 144) {
        int r = tid >> 4, j2 = tid & 15;
        float s_ = 0.f;
#pragma unroll
        for (int q = 0; q < 16; ++q) s_ += red[(q * 9 + r) * 16 + j2];
        int cc = jt * 16 + j2;
        P.mods[(size_t)(l * 9 + r) * 3072 + cc] = s_ + P.b_mod[l * 3072 + cc];
      }
      continue;
    }
    j -= J_MOD;
    if (j < J_ROPE) {
      int e = j * 256 + tid;
      int t = e >> 5, i = e & 31, f = i & 15;
      float inv = powf(10000.f, -(float)f / 16.f);
      float pos = (float)(i < 16 ? (t >> 6) : (t & 63));
      float ang = pos * inv;
      P.rope[e] = make_float2(cosf(ang), sinf(ang));
      continue;
    }
    j -= J_ROPE;
    if (j < J_S5) {
      const int g = j & 31, ld = j >> 5, l = ld >> 1, d = ld & 1;
      float* crs = (float*)smem;
      __syncthreads();
      if (tid < 64) {
        int p = tid;
        float lr = P.s5_lam_re[(size_t)j * 64 + p], li = P.s5_lam_im[(size_t)j * 64 + p];
        float dt = expf(P.s5_log_dt[j]);
        float mag = expf(lr * dt);
        float ar = mag * cosf(li * dt), ai = mag * sinf(li * dt);
        float den = lr * lr + li * li;
        float nr = ar - 1.f;
        crs[p] = (nr * lr + ai * li) / den;
        crs[64 + p] = (ai * lr - nr * li) / den;
        P.s5A[(size_t)j * 64 + p] = make_float2(ar, ai);
        float pr = ar, pi = ai;
#pragma unroll
        for (int s = 0; s < 6; ++s) {
          float nr2 = pr * pr - pi * pi, ni2 = 2.f * pr * pi;
          pr = nr2; pi = ni2;
        }
        P.s5A64[(size_t)j * 64 + p] = make_float2(pr, pi);
      }
      __syncthreads();
      for (int e = tid; e < 512; e += 256) {
        int nt = e >> 6, ln = e & 63;
        int ri = nt >> 2, p = (nt & 3) * 16 + (ln & 15), kg = ln >> 4;
        float cr = crs[p], ci = crs[64 + p];
        unsigned v[4] = {0u, 0u, 0u, 0u};
        if (kg < 2) {
          const float* bre = P.s5_b_re + ((size_t)j * 64 + p) * 16 + kg * 8;
          const float* bim = P.s5_b_im + ((size_t)j * 64 + p) * 16 + kg * 8;
#pragma unroll
          for (int q = 0; q < 4; ++q) {
            float r0 = bre[2 * q], i0 = bim[2 * q], r1 = bre[2 * q + 1], i1 = bim[2 * q + 1];
            float v0 = ri == 0 ? cr * r0 - ci * i0 : cr * i0 + ci * r0;
            float v1 = ri == 0 ? cr * r1 - ci * i1 : cr * i1 + ci * r1;
            v[q] = pack2(v0, v1);
          }
        }
        P.s5drvB[((size_t)j * 8 + nt) * 64 + ln] = u32x4_mk(v[0], v[1], v[2], v[3]);
      }
      if (d == 0) {
        int kk = tid >> 6, ln = tid & 63;
        int h = ln & 15;
        unsigned v[4];
#pragma unroll
        for (int q = 0; q < 4; ++q) {
          float vv[2];
#pragma unroll
          for (int s = 0; s < 2; ++s) {
            int k = kk * 32 + (ln >> 4) * 8 + 2 * q + s;
            size_t base = ((size_t)(l * 32 + g) * 16 + h) * 64;
            vv[s] = (k & 1) == 0 ? P.s5_c_re[base + (k >> 1)] : -P.s5_c_im[base + (k >> 1)];
          }
          v[q] = pack2(vv[0], vv[1]);
        }
        P.s5C[((size_t)(l * 32 + g) * 4 + kk) * 64 + ln] = u32x4_mk(v[0], v[1], v[2], v[3]);
      }
      continue;
    }
    j -= J_S5;
    {
      int l = tid >> 6, lane = tid & 63;
      const float* lq = P.lam_qk + l * 256;
      float s1 = lq[lane] * lq[64 + lane], s2 = lq[128 + lane] * lq[192 + lane];
#pragma unroll
      for (int o = 32; o > 0; o >>= 1) {
        s1 += shx(s1, o, lane);
        s2 += shx(s2, o, lane);
      }
      float lam_init = 0.8f - 0.6f * expf(-0.3f * (float)l);
      if (lane == 0) P.lamv[l] = expf(s1) - expf(s2) + lam_init;
    }
  }
}

DEV void phase_norm(const Params& P, int l) {
  const int tid_ = tidx(); const int lane = tid_ & 63, w = tid_ >> 6;
  const float* ng = P.norm_g + l * 1024;
  auto rowptr = [&](int r) -> const float* {
    if (r < NLAT) return (l == 0 ? P.x : P.out) + (size_t)r * 1024;
    return (l == 0 ? P.ctx : P.ctxres) + (size_t)(r - NLAT) * 1024;
  };
  const int stride = vg() * 4;
  int r = vb() * 4 + w;
  float4 v[4], vn[4];
  if (r < NR) {
    const float* src = rowptr(r);
#pragma unroll
    for (int i = 0; i < 4; ++i) v[i] = *(const float4*)(src + i * 256 + lane * 4);
  }
  for (; r < NR; r += stride) {
    const int rn = r + stride;
    if (rn < NR) {
      const float* srcn = rowptr(rn);
#pragma unroll
      for (int i = 0; i < 4; ++i) vn[i] = *(const float4*)(srcn + i * 256 + lane * 4);
    }
    const float* md = P.mods + (size_t)(l * 9 + mod_row(r)) * 3072;
    float ss = 0.f;
#pragma unroll
    for (int i = 0; i < 4; ++i) ss += v[i].x * v[i].x + v[i].y * v[i].y + v[i].z * v[i].z + v[i].w * v[i].w;
#pragma unroll
    for (int o = 32; o > 0; o >>= 1) ss += __shfl_xor(ss, o);
    float rstd = rsqrtf(ss * (1.f / 1024.f) + 1e-6f);
#pragma unroll
    for (int i = 0; i < 4; ++i) {
      int k = i * 256 + lane * 4;
      float4 g4 = *(const float4*)(ng + k);
      float4 sh = *(const float4*)(md + k);
      float4 sc = *(const float4*)(md + 1024 + k);
      float o0 = v[i].x * rstd * g4.x * (1.f + sc.x) + sh.x;
      float o1 = v[i].y * rstd * g4.y * (1.f + sc.y) + sh.y;
      float o2 = v[i].z * rstd * g4.z * (1.f + sc.z) + sh.z;
      float o3 = v[i].w * rstd * g4.w * (1.f + sc.w) + sh.w;
      u32x2 pk = u32x2_mk(pack2(o0, o1), pack2(o2, o3));
      *(u32x2*)(P.hbuf + (size_t)r * 1024 + k) = pk;
    }
#pragma unroll
    for (int i = 0; i < 4; ++i) v[i] = vn[i];
  }
}

DEV void phase_proj(const Params& P, int l, char* smem) {
  const int tid_ = tidx(); const int lane = tid_ & 63, w = tid_ >> 6;
  const int wm = w & 1, wn = w >> 1, r16 = lane & 15, g = lane >> 4;
  const bf16_t* Wl = P.WinT + (size_t)l * 7168 * 1024;
  const float QS = 0.125f * 1.4426950408889634f;
  for (int tile = vb(); tile < 272 * 32; tile += vg()) {
    const int mtile = tile >> 5, ntile = tile & 31;
    const int m0 = mtile * 128, n0 = ntile * 128;
    f32x4 acc[4][4];
    zero_acc<4>(acc);
    gemm_main<128>(acc, P.hbuf + (size_t)m0 * 1024, 1024, Wl + (size_t)n0 * 1024, 1024, 1024, smem);
    const int region = n0 >> 9;
#pragma unroll
    for (int mt = 0; mt < 4; ++mt) {
      const int m = m0 + wm * 64 + mt * 16 + r16;
#pragma unroll
      for (int nt = 0; nt < 4; ++nt) {
        const int n = n0 + wn * 64 + nt * 16 + g * 4;
        f32x4 v = acc[mt][nt];
        if (region <= 1) {
          if (m < NLAT) {
            int t = m & 4095;
            int i0 = (n & 63) >> 1;
            float4 cs = *(const float4*)(P.rope + (size_t)t * 32 + i0);
            float a0 = v[0] * cs.x - v[1] * cs.y, a1 = v[0] * cs.y + v[1] * cs.x;
            float a2 = v[2] * cs.z - v[3] * cs.w, a3 = v[2] * cs.w + v[3] * cs.z;
            v = f32x4{a0, a1, a2, a3};
          }
          if (region == 0) v = v * QS;
          *(u32x2*)(P.proj + (size_t)m * PW + n) = u32x2_mk(pack2(v[0], v[1]), pack2(v[2], v[3]));
        } else if (region == 2) {
          int b, key;
          if (m < NLAT) { b = m >> 12; key = m & 4095; }
          else { b = (m - NLAT) >> 8; key = 4096 + ((m - NLAT) & 255); }
          int nn = n - 1024;
          bf16_t* vp = P.Vt + ((size_t)b * 512 + nn) * 4352 + key;
#pragma unroll
          for (int j = 0; j < 4; ++j) vp[(size_t)j * 4352] = f2bf(v[j]);
        } else {
          if (region == 3 || region == 5 || region == 7) {
#pragma unroll
            for (int j = 0; j < 4; ++j) v[j] = siluf_(v[j]);
          }
          *(u32x2*)(P.proj + (size_t)m * PW + n) = u32x2_mk(pack2(v[0], v[1]), pack2(v[2], v[3]));
        }
      }
    }
  }
}

struct ChunkGeo { int row0, seqrow0, seqlen, tloc0; };
DEV ChunkGeo chunk_geo(int cid) {
  ChunkGeo c;
  if (cid < 512) {
    int b = cid >> 6, lc = cid & 63;
    c.row0 = b * 4096 + lc * 64; c.seqrow0 = b * 4096; c.seqlen = 4096; c.tloc0 = lc * 64;
  } else {
    int cc = cid - 512, b = cc >> 2;
    c.row0 = NLAT + cc * 64; c.seqrow0 = NLAT + b * 256; c.seqlen = 256; c.tloc0 = (cc & 3) * 64;
  }
  return c;
}
DEV int chunk_at(int b, int d, int pos) {
  if (d == 0) return pos < 4 ? 512 + b * 4 + pos : b * 64 + (pos - 4);
  return pos < 4 ? 512 + b * 4 + (3 - pos) : b * 64 + (63 - (pos - 4));
}

DEV void lru_item(const Params& P, int l, int item, bool step3, char* smem) {
  const int tid = tidx(), lane = tid & 63, w = tid >> 6, r16 = lane & 15, g = lane >> 4;
  const int cid = item >> 3, cb = item & 7;
  const ChunkGeo cg_ = chunk_geo(cid);
  bf16_t* Us = (bf16_t*)smem;
  const int c8 = tid & 7, tr = tid >> 3;
  const int ch0 = cb * 64 + c8 * 8;
  u32x4 xin[2][4];
#pragma unroll
  for (int pass = 0; pass < 2; ++pass)
#pragma unroll
    for (int jt = 0; jt < 4; ++jt) {
      const int tt = cg_.tloc0 + tr + 32 * pass + jt - 2;
      u32x4 xv = u32x4_mk(0u, 0u, 0u, 0u);
      if (tt >= 0 && tt < cg_.seqlen) xv = *(const u32x4*)(P.proj + (size_t)(cg_.seqrow0 + tt) * PW + CXR + ch0);
      xin[pass][jt] = xv;
    }
  float wt[4][8], cbv[8];
  {
    const float4 b0 = *(const float4*)(P.conv_b + l * 512 + ch0), b1 = *(const float4*)(P.conv_b + l * 512 + ch0 + 4);
    cbv[0] = b0.x; cbv[1] = b0.y; cbv[2] = b0.z; cbv[3] = b0.w; cbv[4] = b1.x; cbv[5] = b1.y; cbv[6] = b1.z; cbv[7] = b1.w;
#pragma unroll
    for (int jt = 0; jt < 4; ++jt) {
      const float4 w0 = *(const float4*)(P.conv_w + (l * 4 + jt) * 512 + ch0), w1 = *(const float4*)(P.conv_w + (l * 4 + jt) * 512 + ch0 + 4);
      wt[jt][0] = w0.x; wt[jt][1] = w0.y; wt[jt][2] = w0.z; wt[jt][3] = w0.w; wt[jt][4] = w1.x; wt[jt][5] = w1.y; wt[jt][6] = w1.z; wt[jt][7] = w1.w;
    }
  }
  const int ch = cb * 64 + w * 16 + r16;
  bf16_t zep[4][4];
  float cin[2] = {0.f, 0.f};
  if (step3) {
    cin[0] = P.lruS[(size_t)(0 * NCH + cid) * 512 + ch];
    cin[1] = P.lruS[(size_t)(1 * NCH + cid) * 512 + ch];
#pragma unroll
    for (int tt = 0; tt < 4; ++tt)
#pragma unroll
      for (int j = 0; j < 4; ++j) zep[tt][j] = P.proj[(size_t)(cg_.row0 + tt * 16 + g * 4 + j) * PW + CZR + ch];
  }
  bf16x8 wfr[2][2][2];
  float bav[2], bxv[2], lmv[2];
#pragma unroll
  for (int d = 0; d < 2; ++d) {
#pragma unroll
    for (int wh = 0; wh < 2; ++wh)
#pragma unroll
      for (int kb = 0; kb < 2; ++kb)
        wfr[d][wh][kb] = *(const bf16x8*)(P.WlT + (size_t)(((l * 2 + d) * 2 + wh) * 8 + cb) * 4096 + (w * 16 + r16) * 64 + kb * 32 + g * 8);
    bav[d] = P.lru_ba[(l * 2 + d) * 512 + ch];
    bxv[d] = P.lru_bx[(l * 2 + d) * 512 + ch];
    lmv[d] = P.lru_lam[(l * 2 + d) * 512 + ch];
  }
  __syncthreads();
#pragma unroll
  for (int pass = 0; pass < 2; ++pass) {
    const int t = tr + 32 * pass;
    float a[8];
#pragma unroll
    for (int e = 0; e < 8; ++e) a[e] = cbv[e];
#pragma unroll
    for (int jt = 0; jt < 4; ++jt) {
      const u32x4 xv = xin[pass][jt];
      const unsigned xs[4] = {xv.x, xv.y, xv.z, xv.w};
#pragma unroll
      for (int q = 0; q < 4; ++q) {
        a[2 * q] += wt[jt][2 * q] * bf2f((bf16_t)(xs[q] & 0xffffu));
        a[2 * q + 1] += wt[jt][2 * q + 1] * bf2f((bf16_t)(xs[q] >> 16));
      }
    }
    *(u32x4*)(Us + t * 72 + c8 * 8) = u32x4_mk(pack2(a[0], a[1]), pack2(a[2], a[3]), pack2(a[4], a[5]), pack2(a[6], a[7]));
  }
  __syncthreads();
  bf16x8 uf[4][2];
#pragma unroll
  for (int tt = 0; tt < 4; ++tt)
#pragma unroll
    for (int kb = 0; kb < 2; ++kb) uf[tt][kb] = *(const bf16x8*)(Us + (tt * 16 + r16) * 72 + kb * 32 + g * 8);
  float uval[4][4];
#pragma unroll
  for (int tt = 0; tt < 4; ++tt)
#pragma unroll
    for (int j = 0; j < 4; ++j) uval[tt][j] = bf2f(Us[(tt * 16 + g * 4 + j) * 72 + w * 16 + r16]);
  float outv[4][4];
#pragma unroll
  for (int tt = 0; tt < 4; ++tt)
#pragma unroll
    for (int j = 0; j < 4; ++j) outv[tt][j] = 0.f;

#pragma unroll
  for (int d = 0; d < 2; ++d) {
    f32x4 ga[4], gx[4];
#pragma unroll
    for (int tt = 0; tt < 4; ++tt) { ga[tt] = f32x4{0.f, 0.f, 0.f, 0.f}; gx[tt] = f32x4{0.f, 0.f, 0.f, 0.f}; }
#pragma unroll
    for (int kb = 0; kb < 2; ++kb) {
#pragma unroll
      for (int tt = 0; tt < 4; ++tt) {
        ga[tt] = mfma16(uf[tt][kb], wfr[d][0][kb], ga[tt]);
        gx[tt] = mfma16(uf[tt][kb], wfr[d][1][kb], gx[tt]);
      }
    }
    const float ba = bav[d], bx = bxv[d];
    const float ex_ = __expf(-lmv[d]);
    const float sp = ex_ < 0.05f ? ex_ * (1.f - ex_ * (0.5f - ex_ * (0.33333334f - ex_ * (0.25f - 0.2f * ex_)))) : __logf(1.f + ex_);
    float av[4][4], bv[4][4];
#pragma unroll
    for (int tt = 0; tt < 4; ++tt)
#pragma unroll
      for (int j = 0; j < 4; ++j) {
        float r = sigmoidf_(ga[tt][j] + ba), ii = sigmoidf_(gx[tt][j] + bx);
        float log_a = -8.f * r * sp;
        float a_ = __expf(log_a);
        float x2 = 2.f * log_a;
        float ser = -x2 * (1.f + x2 * (0.5f + x2 * (0.16666667f + x2 * (0.041666668f + x2 * (0.0083333338f + x2 * 0.0013888889f)))));
        float om = x2 > -0.25f ? ser : 1.f - a_ * a_;
        av[tt][j] = a_;
        bv[tt][j] = __builtin_amdgcn_sqrtf(om) * (ii * uval[tt][j]);
      }
    float Ps[4], Ss[4];
#pragma unroll
    for (int tt = 0; tt < 4; ++tt) {
      float p_ = 1.f, s_ = 0.f;
      if (d == 0) {
#pragma unroll
        for (int j = 0; j < 4; ++j) { p_ *= av[tt][j]; s_ = s_ * av[tt][j] + bv[tt][j]; }
      } else {
#pragma unroll
        for (int j = 3; j >= 0; --j) { p_ *= av[tt][j]; s_ = s_ * av[tt][j] + bv[tt][j]; }
      }
      Ps[tt] = p_; Ss[tt] = s_;
    }
    const size_t cidx = (size_t)(d * NCH + cid) * 512 + ch;
    if (!step3) {
      float Pc = 1.f, Sc = 0.f;
#pragma unroll
      for (int q = 0; q < 4; ++q) {
        const int tt = d == 0 ? q : 3 - q;
#pragma unroll
        for (int q2 = 0; q2 < 4; ++q2) {
          const int gg = d == 0 ? q2 : 3 - q2;
          float Pg = shi(Ps[tt], gg * 16 + r16), Sg = shi(Ss[tt], gg * 16 + r16);
          Sc = Sc * Pg + Sg;
          Pc = Pc * Pg;
        }
      }
      if (g == 0) { P.lruP[cidx] = Pc; P.lruS[cidx] = Sc; }
    } else {
      float carry = cin[d];
#pragma unroll
      for (int q = 0; q < 4; ++q) {
        const int tt = d == 0 ? q : 3 - q;
        float run = carry, hstart = 0.f;
#pragma unroll
        for (int q2 = 0; q2 < 4; ++q2) {
          const int gg = d == 0 ? q2 : 3 - q2;
          float Pg = shi(Ps[tt], gg * 16 + r16), Sg = shi(Ss[tt], gg * 16 + r16);
          if (gg == g) hstart = run;
          run = run * Pg + Sg;
        }
        carry = run;
        float h = hstart;
        if (d == 0) {
#pragma unroll
          for (int j = 0; j < 4; ++j) { h = av[tt][j] * h + bv[tt][j]; outv[tt][j] += h; }
        } else {
#pragma unroll
          for (int j = 3; j >= 0; --j) { h = av[tt][j] * h + bv[tt][j]; outv[tt][j] += h; }
        }
      }
    }
  }
  if (step3) {
#pragma unroll
    for (int tt = 0; tt < 4; ++tt)
#pragma unroll
      for (int j = 0; j < 4; ++j) {
        bf16_t* zp = P.proj + (size_t)(cg_.row0 + tt * 16 + g * 4 + j) * PW + CZR + ch;
        *zp = f2bf(outv[tt][j] * bf2f(zep[tt][j]));
      }
  }
}

DEV void s5_item(const Params& P, int l, int item, bool step3, char* smem) {
  const int tid = tidx(), lane = tid & 63, w = tid >> 6, r16 = lane & 15, g = lane >> 4;
  const int cid = item >> 3, gq = item & 7;
  const int grp = gq * 4 + w;
  const ChunkGeo cg_ = chunk_geo(cid);
  bf16_t* BUh = (bf16_t*)(smem + w * 16896);
  bf16_t* Hs = (bf16_t*)(smem + w * 16896 + 8192);
  f32x4 Y[4];
#pragma unroll
  for (int s_ = 0; s_ < 4; ++s_) Y[s_] = f32x4{0.f, 0.f, 0.f, 0.f};
  bf16x8 ufr[4];
#pragma unroll
  for (int sub = 0; sub < 4; ++sub) {
    u32x4 uv = u32x4_mk(0u, 0u, 0u, 0u);
    if (g < 2) uv = *(const u32x4*)(P.proj + (size_t)(cg_.row0 + sub * 16 + r16) * PW + CUS + grp * 16 + g * 8);
    ufr[sub] = as_bf16x8(uv);
  }
  bf16x8 cf[4];
  bf16_t uep[4][4];
  if (step3) {
#pragma unroll
    for (int kk = 0; kk < 4; ++kk) cf[kk] = as_bf16x8(P.s5C[((size_t)(l * 32 + grp) * 4 + kk) * 64 + lane]);
#pragma unroll
    for (int sub = 0; sub < 4; ++sub)
#pragma unroll
      for (int j = 0; j < 4; ++j) uep[sub][j] = P.proj[(size_t)(cg_.row0 + sub * 16 + g * 4 + j) * PW + CUS + grp * 16 + r16];
  }
  const int jd0 = (l * 2 + 0) * 32 + grp, jd1 = (l * 2 + 1) * 32 + grp;
  bf16x8 bfrA[8], bfrB[8];
#pragma unroll
  for (int nt = 0; nt < 8; ++nt) {
    bfrA[nt] = as_bf16x8(P.s5drvB[((size_t)jd0 * 8 + nt) * 64 + lane]);
    bfrB[nt] = as_bf16x8(P.s5drvB[((size_t)jd1 * 8 + nt) * 64 + lane]);
  }
  const float2 A0 = P.s5A[(size_t)jd0 * 64 + lane], A1 = P.s5A[(size_t)jd1 * 64 + lane];
  const size_t eidx0 = ((size_t)(0 * NCH + cid) * 32 + grp) * 64 + lane, eidx1 = ((size_t)(1 * NCH + cid) * 32 + grp) * 64 + lane;
  float h0r = 0.f, h0i = 0.f, h1r = 0.f, h1i = 0.f;
  if (step3) { float2 a_ = P.s5E[eidx0], b_ = P.s5E[eidx1]; h0r = a_.x; h0i = a_.y; h1r = b_.x; h1i = b_.y; }
#pragma unroll
  for (int si = 0; si < 4; ++si) {
    const int sub0 = si, sub1 = 3 - si;
    __syncthreads();
#pragma unroll
    for (int nt = 0; nt < 8; ++nt) {
      f32x4 b0 = mfma16(ufr[sub0], bfrA[nt], f32x4{0.f, 0.f, 0.f, 0.f});
      f32x4 b1 = mfma16(ufr[sub1], bfrB[nt], f32x4{0.f, 0.f, 0.f, 0.f});
      *(u32x2*)(BUh + (nt * 16 + r16) * 16 + g * 4) = u32x2_mk(pack2(b0[0], b0[1]), pack2(b0[2], b0[3]));
      *(u32x2*)(BUh + 2048 + (nt * 16 + r16) * 16 + g * 4) = u32x2_mk(pack2(b1[0], b1[1]), pack2(b1[2], b1[3]));
    }
    __syncthreads();
    u32x4 r0a = *(const u32x4*)(BUh + lane * 16), r0b = *(const u32x4*)(BUh + lane * 16 + 8);
    u32x4 i0a = *(const u32x4*)(BUh + (64 + lane) * 16), i0b = *(const u32x4*)(BUh + (64 + lane) * 16 + 8);
    u32x4 r1a = *(const u32x4*)(BUh + 2048 + lane * 16), r1b = *(const u32x4*)(BUh + 2048 + lane * 16 + 8);
    u32x4 i1a = *(const u32x4*)(BUh + 2048 + (64 + lane) * 16), i1b = *(const u32x4*)(BUh + 2048 + (64 + lane) * 16 + 8);
    const unsigned re0[8] = {r0a.x, r0a.y, r0a.z, r0a.w, r0b.x, r0b.y, r0b.z, r0b.w};
    const unsigned im0[8] = {i0a.x, i0a.y, i0a.z, i0a.w, i0b.x, i0b.y, i0b.z, i0b.w};
    const unsigned re1[8] = {r1a.x, r1a.y, r1a.z, r1a.w, r1b.x, r1b.y, r1b.z, r1b.w};
    const unsigned im1[8] = {i1a.x, i1a.y, i1a.z, i1a.w, i1b.x, i1b.y, i1b.z, i1b.w};
    {
      f32x2_t HR = {h0r, h1r}, HI = {h0i, h1i};
      const f32x2_t AX = {A0.x, A1.x}, AY = {A0.y, A1.y}, NAY = {-A0.y, -A1.y};
#pragma unroll
      for (int ti = 0; ti < 16; ++ti) {
        const int tf = ti, tb = 15 - ti;
        const unsigned rwf = re0[tf >> 1], iwf = im0[tf >> 1], rwb = re1[tb >> 1], iwb = im1[tb >> 1];
        const f32x2_t RE = {(tf & 1) ? __uint_as_float(rwf & 0xffff0000u) : __uint_as_float(rwf << 16),
                            (tb & 1) ? __uint_as_float(rwb & 0xffff0000u) : __uint_as_float(rwb << 16)};
        const f32x2_t IM = {(tf & 1) ? __uint_as_float(iwf & 0xffff0000u) : __uint_as_float(iwf << 16),
                            (tb & 1) ? __uint_as_float(iwb & 0xffff0000u) : __uint_as_float(iwb << 16)};
        const f32x2_t NR = __builtin_elementwise_fma(AX, HR, __builtin_elementwise_fma(NAY, HI, RE));
        const f32x2_t NI = __builtin_elementwise_fma(AX, HI, __builtin_elementwise_fma(AY, HR, IM));
        HR = NR; HI = NI;
        if (step3) {
          *(unsigned*)(Hs + tf * 136 + 2 * lane) = pack2(HR[0], HI[0]);
          *(unsigned*)(Hs + 2176 + tb * 136 + 2 * lane) = pack2(HR[1], HI[1]);
        }
      }
      h0r = HR[0]; h1r = HR[1]; h0i = HI[0]; h1i = HI[1];
    }
    if (step3) {
      __syncthreads();
#pragma unroll
      for (int kk = 0; kk < 4; ++kk) {
        bf16x8 hf0 = *(const bf16x8*)(Hs + r16 * 136 + kk * 32 + g * 8);
        bf16x8 hf1 = *(const bf16x8*)(Hs + 2176 + r16 * 136 + kk * 32 + g * 8);
        Y[sub0] = mfma16(hf0, cf[kk], Y[sub0]);
        Y[sub1] = mfma16(hf1, cf[kk], Y[sub1]);
      }
    }
  }
  if (!step3) { P.s5E[eidx0] = make_float2(h0r, h0i); P.s5E[eidx1] = make_float2(h1r, h1i); }
  if (step3) {
    const float dsk = P.s5_d[l * 512 + grp * 16 + r16];
#pragma unroll
    for (int sub = 0; sub < 4; ++sub)
#pragma unroll
      for (int j = 0; j < 4; ++j) {
        bf16_t* up = P.proj + (size_t)(cg_.row0 + sub * 16 + g * 4 + j) * PW + CUS + grp * 16 + r16;
        float y = Y[sub][j] + dsk * bf2f(uep[sub][j]);
        *up = f2bf(gelu_tanh(y));
      }
  }
}

DEV void phase_scan(const Params& P, int l, bool step3, char* smem) {
  const int ncid = (step3 && l == 3) ? 512 : NCH;
  const int nitems = ncid * 8;
  for (int it = vb(); it < 2 * nitems; it += vg()) {
    if (it < nitems) s5_item(P, l, it, step3, smem);
    else lru_item(P, l, it - nitems, step3, smem);
  }
}

DEV void carry_job(const Params& P, int l, int job) {
  const int tid = tidx();
  if (job < 32) {
    int id = job * 256 + tid;
    int ch = id & 511, d = (id >> 9) & 1, b = id >> 10;
    float carry = 0.f;
#pragma unroll 4
    for (int pos = 0; pos < 68; ++pos) {
      size_t idx = (size_t)(d * NCH + chunk_at(b, d, pos)) * 512 + ch;
      float Pv = P.lruP[idx], Sv = P.lruS[idx];
      P.lruS[idx] = carry;
      carry = Pv * carry + Sv;
    }
  } else {
    int id = (job - 32) * 256 + tid;
    int p = id & 63, g = (id >> 6) & 31, d = (id >> 11) & 1, b = id >> 12;
    float2 A = P.s5A64[((size_t)(l * 2 + d) * 32 + g) * 64 + p];
    float cr = 0.f, ci = 0.f;
#pragma unroll 4
    for (int pos = 0; pos < 68; ++pos) {
      size_t idx = ((size_t)(d * NCH + chunk_at(b, d, pos)) * 32 + g) * 64 + p;
      float2 e = P.s5E[idx];
      P.s5E[idx] = make_float2(cr, ci);
      float nr = A.x * cr - A.y * ci + e.x;
      float ni = A.x * ci + A.y * cr + e.y;
      cr = nr; ci = ni;
    }
  }
}

DEV void attn_item(const Params& P, int l, int item, char* smem, int dowrite = 1) {
  const int tid = tidx(), lane = tid & 63, w = tid >> 6, r16 = lane & 15, g = lane >> 4;
  bf16_t* Ks = (bf16_t*)smem;
  bf16_t* Vs = Ks + 64 * 136;
  int b, h, qrow0, kt0, nkt;
  if (item < 2048) {
    b = item >> 8; h = (item >> 6) & 3;
    qrow0 = b * 4096 + (item & 63) * 64; kt0 = 0; nkt = 68;
  } else {
    int i2 = item - 2048;
    b = i2 >> 4; h = (i2 >> 2) & 3;
    qrow0 = NLAT + b * 256 + (i2 & 3) * 64; kt0 = 64; nkt = 4;
  }
  const int qrow = qrow0 + w * 16 + r16;
  bf16x8 qf[2][2];
#pragma unroll
  for (int c = 0; c < 2; ++c)
#pragma unroll
    for (int kb = 0; kb < 2; ++kb)
      qf[c][kb] = *(const bf16x8*)(P.proj + (size_t)qrow * PW + CQ + h * 128 + c * 64 + kb * 32 + g * 8);
  f32x4 o[2][8];
#pragma unroll
  for (int c = 0; c < 2; ++c)
#pragma unroll
    for (int dv = 0; dv < 8; ++dv) o[c][dv] = f32x4{0.f, 0.f, 0.f, 0.f};
  float mrun[2] = {-1e30f, -1e30f}, lsum[2] = {0.f, 0.f};
  const bf16_t* Vbase = P.Vt + (size_t)(b * 4 + h) * 128 * 4352;
  u32x4 rk[4], rv[4];
  auto gl = [&](int kt) {
    int krow0, vkey0;
    if (kt < 64) { krow0 = b * 4096 + kt * 64; vkey0 = kt * 64; }
    else { krow0 = NLAT + b * 256 + (kt - 64) * 64; vkey0 = 4096 + (kt - 64) * 64; }
#pragma unroll
    for (int i = 0; i < 4; ++i) {
      int cidx = tid + 256 * i;
      rk[i] = *(const u32x4*)(P.proj + (size_t)(krow0 + (cidx >> 4)) * PW + CK + h * 128 + (cidx & 15) * 8);
      rv[i] = *(const u32x4*)(Vbase + (size_t)(cidx >> 3) * 4352 + vkey0 + (cidx & 7) * 8);
    }
  };
  auto st = [&](int buf) {
    bf16_t* Kd = Ks + buf * (64 * 136 + 128 * 72);
    bf16_t* Vd = Vs + buf * (64 * 136 + 128 * 72);
#pragma unroll
    for (int i = 0; i < 4; ++i) {
      int cidx = tid + 256 * i;
      *(u32x4*)(Kd + (cidx >> 4) * 136 + (cidx & 15) * 8) = rk[i];
      *(u32x4*)(Vd + (cidx >> 3) * 72 + (cidx & 7) * 8) = rv[i];
    }
  };
  gl(kt0);
  __syncthreads();
  st(0);
  gl(kt0 + 1);
  __syncthreads();
  for (int it = 0; it < nkt; ++it) {
    const int cur = it & 1;
    if (it + 1 < nkt) st(cur ^ 1);
    if (it + 2 < nkt) gl(kt0 + it + 2);
    const bf16_t* Kc = Ks + cur * (64 * 136 + 128 * 72);
    const bf16_t* Vc = Vs + cur * (64 * 136 + 128 * 72);
#pragma unroll
    for (int c = 0; c < 2; ++c) {
      f32x4 s[4];
#pragma unroll
      for (int kt = 0; kt < 4; ++kt) {
        s[kt] = f32x4{0.f, 0.f, 0.f, 0.f};
#pragma unroll
        for (int kb = 0; kb < 2; ++kb) {
          bf16x8 kf = *(const bf16x8*)(Kc + (kt * 16 + r16) * 136 + c * 64 + kb * 32 + g * 8);
          s[kt] = mfma16(kf, qf[c][kb], s[kt]);
        }
      }
      float mx = fmaxf(fmaxf(s[0][0], s[0][1]), fmaxf(s[0][2], s[0][3]));
#pragma unroll
      for (int kt = 1; kt < 4; ++kt) mx = fmaxf(mx, fmaxf(fmaxf(s[kt][0], s[kt][1]), fmaxf(s[kt][2], s[kt][3])));
      mx = fmaxf(mx, shx(mx, 16, lane));
      mx = fmaxf(mx, shx(mx, 32, lane));
      const bool need = mx > mrun[c] + 8.f;
      if (__any(need)) {
        const float mnew = need ? mx : mrun[c];
        const float alpha = fexp2(mrun[c] - mnew);
        mrun[c] = mnew;
        lsum[c] *= alpha;
#pragma unroll
        for (int dv = 0; dv < 8; ++dv) o[c][dv] = o[c][dv] * alpha;
      }
      const float mref = mrun[c];
      float ps = 0.f;
#pragma unroll
      for (int kt = 0; kt < 4; ++kt) {
        s[kt] = s[kt] - mref;
#pragma unroll
        for (int j = 0; j < 4; ++j) { s[kt][j] = fexp2(s[kt][j]); ps += s[kt][j]; }
      }
      lsum[c] += ps;
      bf16x8 pf[2];
#pragma unroll
      for (int kb2 = 0; kb2 < 2; ++kb2) {
        u32x4 pk = u32x4_mk(pack2(s[2 * kb2][0], s[2 * kb2][1]), pack2(s[2 * kb2][2], s[2 * kb2][3]),
                            pack2(s[2 * kb2 + 1][0], s[2 * kb2 + 1][1]), pack2(s[2 * kb2 + 1][2], s[2 * kb2 + 1][3]));
        pf[kb2] = as_bf16x8(pk);
      }
#pragma unroll
      for (int dv = 0; dv < 8; ++dv) {
        if ((dv & 1) == 0) __builtin_amdgcn_sched_barrier(0);
#pragma unroll
        for (int kb2 = 0; kb2 < 2; ++kb2) {
          const bf16_t* vp = Vc + (dv * 16 + r16) * 72 + kb2 * 32 + g * 4;
          u32x2 v0 = *(const u32x2*)vp, v1 = *(const u32x2*)(vp + 16);
          bf16x8 vf = as_bf16x8(u32x4_mk(v0.x, v0.y, v1.x, v1.y));
          o[c][dv] = mfma16(vf, pf[kb2], o[c][dv]);
        }
      }
      __builtin_amdgcn_sched_barrier(0);
    }
    __syncthreads();
  }
  float l0 = lsum[0], l1 = lsum[1];
  l0 += shx(l0, 16, lane); l0 += shx(l0, 32, lane);
  l1 += shx(l1, 16, lane); l1 += shx(l1, 32, lane);
  const float lam = P.lamv[l];
  const float i0 = 1.f / l0, i1 = lam / l1;
  float ss = 0.f;
#pragma unroll
  for (int dv = 0; dv < 8; ++dv)
#pragma unroll
    for (int j = 0; j < 4; ++j) {
      float v = o[0][dv][j] * i0 - o[1][dv][j] * i1;
      o[0][dv][j] = v;
      ss += v * v;
    }
  ss += shx(ss, 16, lane); ss += shx(ss, 32, lane);
  const float lam_init = 0.8f - 0.6f * expf(-0.3f * (float)l);
  const float rs = rsqrtf(ss * (1.f / 128.f) + 1e-6f) * (1.f - lam_init);
#pragma unroll
  for (int dv = 0; dv < 8; ++dv) {
    const int dcol = dv * 16 + g * 4;
    float4 sg = *(const float4*)(P.subln_g + l * 128 + dcol);
    u32x2 zz = *(const u32x2*)(P.proj + (size_t)qrow * PW + CZA + h * 128 + dcol);
    float z0 = bf2f((bf16_t)(zz.x & 0xffffu)), z1 = bf2f((bf16_t)(zz.x >> 16));
    float z2 = bf2f((bf16_t)(zz.y & 0xffffu)), z3 = bf2f((bf16_t)(zz.y >> 16));
    float y0 = o[0][dv][0] * rs * sg.x * z0, y1 = o[0][dv][1] * rs * sg.y * z1;
    float y2 = o[0][dv][2] * rs * sg.z * z2, y3 = o[0][dv][3] * rs * sg.w * z3;
    if (dowrite) *(u32x2*)(P.proj + (size_t)qrow * PW + CQ + h * 128 + dcol) = u32x2_mk(pack2(y0, y1), pack2(y2, y3));
  }
}

DEV void phase_attn(const Params& P, int l, char* smem) {
  const int nattn = 2048 + (l < 3 ? 128 : 0);
  const int total = 160 + nattn;
  (void)total;
  for (int it = vb(); it < 160; it += vg()) carry_job(P, l, it);
#if PROBE_PH == 3
  { int flag = 0; asm volatile("" : "+s"(flag));
    for (int it = vg() - 1 - vb(); it < nattn; it += vg()) attn_item(P, l, it, smem, flag); }
#endif
  for (int it = vg() - 1 - vb(); it < nattn; it += vg()) attn_item(P, l, it, smem);
}


DEV void attn_item8(const Params& P, int l, int item, char* smem) {
  const int tid = tid512(), lane = tid & 63, wv = tid >> 6, r16 = lane & 15, g = lane >> 4;
  const int c = wv & 1, qg = wv >> 1;
  bf16_t* Ks = (bf16_t*)smem;
  bf16_t* Vs = Ks + 64 * 136;
  constexpr int BUFE = 64 * 136 + 128 * 72;
  float* X = (float*)(smem + SMEM_HALF);
  int b, h, qrow0, kt0, nkt;
  if (item < 1024) {
    b = item >> 7; h = (item >> 5) & 3;
    qrow0 = b * 4096 + (item & 31) * 128; kt0 = 0; nkt = 68;
  } else {
    int i2 = item - 1024;
    b = i2 >> 3; h = (i2 >> 1) & 3;
    qrow0 = NLAT + b * 256 + (i2 & 1) * 128; kt0 = 64; nkt = 4;
  }
  const int qrowb = qrow0 + qg * 32 + r16;
  bf16x8 qf[2][2];
#pragma unroll
  for (int qt = 0; qt < 2; ++qt)
#pragma unroll
    for (int kb = 0; kb < 2; ++kb)
      qf[qt][kb] = *(const bf16x8*)(P.proj + (size_t)(qrowb + qt * 16) * PW + CQ + h * 128 + c * 64 + kb * 32 + g * 8);
  f32x4 o[2][8];
#pragma unroll
  for (int qt = 0; qt < 2; ++qt)
#pragma unroll
    for (int dv = 0; dv < 8; ++dv) o[qt][dv] = f32x4{0.f, 0.f, 0.f, 0.f};
  float mrun[2] = {0.f, 0.f}, lsum[2] = {0.f, 0.f};
  const bf16_t* Vbase = P.Vt + (size_t)(b * 4 + h) * 128 * 4352;
  u32x4 rk[2], rv[2];
  auto gl = [&](int kt) {
    int krow0, vkey0;
    if (kt < 64) { krow0 = b * 4096 + kt * 64; vkey0 = kt * 64; }
    else { krow0 = NLAT + b * 256 + (kt - 64) * 64; vkey0 = 4096 + (kt - 64) * 64; }
#pragma unroll
    for (int i = 0; i < 2; ++i) {
      int cidx = tid + 512 * i;
      rk[i] = *(const u32x4*)(P.proj + (size_t)(krow0 + (cidx >> 4)) * PW + CK + h * 128 + (cidx & 15) * 8);
      rv[i] = *(const u32x4*)(Vbase + (size_t)(cidx >> 3) * 4352 + vkey0 + (cidx & 7) * 8);
    }
  };
  auto st = [&](int buf) {
    bf16_t* Kd = Ks + buf * BUFE;
    bf16_t* Vd = Vs + buf * BUFE;
#pragma unroll
    for (int i = 0; i < 2; ++i) {
      int cidx = tid + 512 * i;
      *(u32x4*)(Kd + (cidx >> 4) * 136 + (cidx & 15) * 8) = rk[i];
      *(u32x4*)(Vd + (cidx >> 3) * 72 + (cidx & 7) * 8) = rv[i];
    }
  };
  auto tile_compute = [&](const int CUR_, const bool FIRST_) {
    const bf16_t* Kc = Ks + CUR_ * BUFE;
    const bf16_t* Vc = Vs + CUR_ * BUFE;
    f32x4 s[2][4];
#pragma unroll
    for (int qt = 0; qt < 2; ++qt) {
      const float ninit = -mrun[qt];
#pragma unroll
      for (int kt = 0; kt < 4; ++kt) s[qt][kt] = f32x4{ninit, ninit, ninit, ninit};
    }
#pragma unroll
    for (int kt = 0; kt < 4; ++kt)
#pragma unroll
      for (int kb = 0; kb < 2; ++kb) {
        bf16x8 kf = *(const bf16x8*)(Kc + (kt * 16 + r16) * 136 + c * 64 + kb * 32 + g * 8);
        s[0][kt] = mfma16(kf, qf[0][kb], s[0][kt]);
        s[1][kt] = mfma16(kf, qf[1][kb], s[1][kt]);
      }
    bf16x8 pf[2][2];
#pragma unroll
    for (int qt = 0; qt < 2; ++qt) {
      float mx = fmaxf(fmaxf(s[qt][0][0], s[qt][0][1]), fmaxf(s[qt][0][2], s[qt][0][3]));
#pragma unroll
      for (int kt = 1; kt < 4; ++kt) mx = fmaxf(mx, fmaxf(fmaxf(s[qt][kt][0], s[qt][kt][1]), fmaxf(s[qt][kt][2], s[qt][kt][3])));
      const bool first = FIRST_;
      if (__any(first || mx > 8.f)) {
        mx = fmaxf(mx, shx(mx, 16, lane));
        mx = fmaxf(mx, shx(mx, 32, lane));
        const bool need = first || mx > 8.f;
        const float dm = need ? mx : 0.f;
        const float alpha = first ? 1.f : fexp2(-dm);
        mrun[qt] += dm;
        lsum[qt] *= alpha;
#pragma unroll
        for (int dv = 0; dv < 8; ++dv) o[qt][dv] = o[qt][dv] * alpha;
#pragma unroll
        for (int kt = 0; kt < 4; ++kt) s[qt][kt] = s[qt][kt] - dm;
      }
      float ps = 0.f;
#pragma unroll
      for (int kt = 0; kt < 4; ++kt)
#pragma unroll
        for (int j = 0; j < 4; ++j) { s[qt][kt][j] = fexp2(s[qt][kt][j]); ps += s[qt][kt][j]; }
      lsum[qt] += ps;
#pragma unroll
      for (int kb2 = 0; kb2 < 2; ++kb2) {
        u32x4 pk = u32x4_mk(pack2(s[qt][2 * kb2][0], s[qt][2 * kb2][1]), pack2(s[qt][2 * kb2][2], s[qt][2 * kb2][3]),
                            pack2(s[qt][2 * kb2 + 1][0], s[qt][2 * kb2 + 1][1]), pack2(s[qt][2 * kb2 + 1][2], s[qt][2 * kb2 + 1][3]));
        pf[qt][kb2] = as_bf16x8(pk);
      }
    }
    bf16x8 vfr[2][2][2];
    auto ldv = [&](int slot, int dvp) {
#pragma unroll
      for (int e = 0; e < 2; ++e)
#pragma unroll
        for (int kb2 = 0; kb2 < 2; ++kb2) {
          const bf16_t* vp = Vc + ((dvp * 2 + e) * 16 + r16) * 72 + kb2 * 32 + g * 4;
          u32x2 v0 = *(const u32x2*)vp, v1 = *(const u32x2*)(vp + 16);
          vfr[slot][e][kb2] = as_bf16x8(u32x4_mk(v0.x, v0.y, v1.x, v1.y));
        }
    };
    ldv(0, 0);
#pragma unroll
    for (int dvp = 0; dvp < 4; ++dvp) {
      if (dvp < 3) ldv((dvp + 1) & 1, dvp + 1);
      __builtin_amdgcn_sched_barrier(0);
#pragma unroll
      for (int e = 0; e < 2; ++e)
#pragma unroll
        for (int kb2 = 0; kb2 < 2; ++kb2) {
          o[0][dvp * 2 + e] = mfma16(vfr[dvp & 1][e][kb2], pf[0][kb2], o[0][dvp * 2 + e]);
          o[1][dvp * 2 + e] = mfma16(vfr[dvp & 1][e][kb2], pf[1][kb2], o[1][dvp * 2 + e]);
        }
      __builtin_amdgcn_sched_barrier(0);
    }
  };
  const int ktl = kt0 + nkt - 1;
  gl(kt0);
  __syncthreads();
  st(0);
  gl(kt0 + 1);
  st(1);
  gl(min(kt0 + 2, ktl));
  __syncthreads();
  for (int T = 0; 2 * T < nkt; ++T) {
    const int base = (T & 1) * 2, nbase = 2 - base;
    if (2 * T + 2 < nkt) st(nbase);
    gl(min(kt0 + 2 * T + 3, ktl));
    tile_compute(base, T == 0);
    if (2 * T + 3 < nkt) st(nbase + 1);
    gl(min(kt0 + 2 * T + 4, ktl));
    tile_compute(base + 1, false);
    __syncthreads();
  }
  const float lam = P.lamv[l];
#pragma unroll
  for (int qt = 0; qt < 2; ++qt) {
    float lq = lsum[qt];
    lq += shx(lq, 16, lane); lq += shx(lq, 32, lane);
    const float sc = (c == 0 ? 1.f : lam) / lq;
#pragma unroll
    for (int dv = 0; dv < 8; ++dv) o[qt][dv] = o[qt][dv] * sc;
  }
  if (c == 1) {
#pragma unroll
    for (int qt = 0; qt < 2; ++qt)
#pragma unroll
      for (int dv = 0; dv < 8; ++dv)
        *(f32x4*)(X + (size_t)((qg * 2 + qt) * 16 + r16) * 128 + dv * 16 + g * 4) = o[qt][dv];
  }
  __syncthreads();
  if (c == 0) {
    const float lam_init = 0.8f - 0.6f * expf(-0.3f * (float)l);
#pragma unroll
    for (int qt = 0; qt < 2; ++qt) {
      float ss = 0.f;
#pragma unroll
      for (int dv = 0; dv < 8; ++dv) {
        f32x4 o1 = *(const f32x4*)(X + (size_t)((qg * 2 + qt) * 16 + r16) * 128 + dv * 16 + g * 4);
        f32x4 v = o[qt][dv] - o1;
        o[qt][dv] = v;
        ss += v[0] * v[0] + v[1] * v[1] + v[2] * v[2] + v[3] * v[3];
      }
      ss += shx(ss, 16, lane); ss += shx(ss, 32, lane);
      const float rs = rsqrtf(ss * (1.f / 128.f) + 1e-6f) * (1.f - lam_init);
      const int qrow = qrowb + qt * 16;
#pragma unroll
      for (int dv = 0; dv < 8; ++dv) {
        const int dcol = dv * 16 + g * 4;
        float4 sg = *(const float4*)(P.subln_g + l * 128 + dcol);
        u32x2 zz = *(const u32x2*)(P.proj + (size_t)qrow * PW + CZA + h * 128 + dcol);
        float z0 = bf2f((bf16_t)(zz.x & 0xffffu)), z1 = bf2f((bf16_t)(zz.x >> 16));
        float z2 = bf2f((bf16_t)(zz.y & 0xffffu)), z3 = bf2f((bf16_t)(zz.y >> 16));
        float y0 = o[qt][dv][0] * rs * sg.x * z0, y1 = o[qt][dv][1] * rs * sg.y * z1;
        float y2 = o[qt][dv][2] * rs * sg.z * z2, y3 = o[qt][dv][3] * rs * sg.w * z3;
        *(u32x2*)(P.proj + (size_t)qrow * PW + CQ + h * 128 + dcol) = u32x2_mk(pack2(y0, y1), pack2(y2, y3));
      }
    }
  }
  __syncthreads();
}

DEV void phase_attn8(const Params& P, int l, char* smem_all) {
  const int nattn = 1024 + (l < 3 ? 64 : 0);
  for (int it = vb(); it < 160; it += vg()) carry_job(P, l, it);
  if (gridDim.x == 256) {
    const int xcd = (int)blockIdx.x & 7, slot = (int)blockIdx.x >> 3;
#pragma unroll 1
    for (int k = 0; k < 4; ++k) attn_item8(P, l, (k * 8 + xcd) * 32 + slot, smem_all);
    if (nattn > 1024 && (int)blockIdx.x >= 192) attn_item8(P, l, 1024 + 255 - (int)blockIdx.x, smem_all);
  } else {
    for (int it = (int)gridDim.x - 1 - (int)blockIdx.x; it < nattn; it += (int)gridDim.x) attn_item8(P, l, it, smem_all);
  }
}

DEV void phase_glu(const Params& P, int l, char* smem) {
  const int tid_ = tidx(); const int lane = tid_ & 63, w = tid_ >> 6;
  const int wm = w & 1, wn = w >> 1, r16 = lane & 15, g = lane >> 4;
  const bf16_t* Wl = P.WgT + (size_t)l * 512 * 512;
  for (int tile = vb(); tile < 16 * 16; tile += vg()) {
    const int m0 = (256 + (tile >> 4)) * 128, n0 = (tile & 15) * 32;
    f32x4 acc[4][1];
    zero_acc<1>(acc);
    gemm_main<32>(acc, P.proj + (size_t)m0 * PW + CUS, PW, Wl + (size_t)n0 * 512, 512, 512, smem);
#pragma unroll
    for (int mt = 0; mt < 4; ++mt) {
      const int m = m0 + wm * 64 + mt * 16 + r16;
#pragma unroll
      for (int nt = 0; nt < 1; ++nt) {
        const int n = n0 + wn * 16 + nt * 16 + g * 4;
        float4 bg = *(const float4*)(P.s5_b_glu + l * 512 + n);
        u32x2 gg = *(const u32x2*)(P.proj + (size_t)m * PW + CUS + n);
        u32x2 zz = *(const u32x2*)(P.proj + (size_t)m * PW + CZS + n);
        float y0 = bf2f((bf16_t)(gg.x & 0xffffu)) * sigmoidf_(acc[mt][nt][0] + bg.x) * bf2f((bf16_t)(zz.x & 0xffffu));
        float y1 = bf2f((bf16_t)(gg.x >> 16)) * sigmoidf_(acc[mt][nt][1] + bg.y) * bf2f((bf16_t)(zz.x >> 16));
        float y2 = bf2f((bf16_t)(gg.y & 0xffffu)) * sigmoidf_(acc[mt][nt][2] + bg.z) * bf2f((bf16_t)(zz.y & 0xffffu));
        float y3 = bf2f((bf16_t)(gg.y >> 16)) * sigmoidf_(acc[mt][nt][3] + bg.w) * bf2f((bf16_t)(zz.y >> 16));
        *(u32x2*)(P.proj + (size_t)m * PW + CZS + n) = u32x2_mk(pack2(y0, y1), pack2(y2, y3));
      }
    }
  }
}

DEV void phase_merge(const Params& P, int l, char* smem) {
  const int tid_ = tidx(); const int lane = tid_ & 63, w = tid_ >> 6;
  const int wm = w & 1, wn = w >> 1, r16 = lane & 15, g = lane >> 4;
  const bf16_t* Wl = P.WinT + (size_t)l * 7168 * 1024;
  for (int tile = vb(); tile < 16 * 32; tile += vg()) {
    const int m0 = (256 + (tile >> 5)) * 128, n0 = (tile & 31) * 32;
    f32x4 accM[4][1];
    zero_acc<1>(accM);
#pragma unroll 1
    for (int nb = 0; nb < 3; ++nb) {
      f32x4 accG[4][1], accY[4][1];
      zero_acc<1>(accG);
      zero_acc<1>(accY);
      gemm_main<32>(accG, P.hbuf + (size_t)m0 * 1024, 1024, Wl + (size_t)(4096 + nb * 1024 + n0) * 1024, 1024, 1024, smem);
      const int cofs = nb == 0 ? CQ : (nb == 1 ? CZR : CZS);
      gemm_main<32>(accY, P.proj + (size_t)m0 * PW + cofs, PW, P.WbT + ((size_t)(l * 3 + nb) * 1024 + n0) * 512, 512, 512, smem);
#pragma unroll
      for (int mt = 0; mt < 4; ++mt)
#pragma unroll
        for (int nt = 0; nt < 1; ++nt)
#pragma unroll
          for (int j = 0; j < 4; ++j) accM[mt][nt][j] += sigmoidf_(accG[mt][nt][j]) * accY[mt][nt][j];
    }
#pragma unroll
    for (int mt = 0; mt < 4; ++mt) {
      const int m = m0 + wm * 64 + mt * 16 + r16;
#pragma unroll
      for (int nt = 0; nt < 1; ++nt) {
        const int n = n0 + wn * 16 + nt * 16 + g * 4;
        f32x4 v = accM[mt][nt];
        *(u32x2*)(P.proj + (size_t)m * PW + CM + n) = u32x2_mk(pack2(v[0], v[1]), pack2(v[2], v[3]));
      }
    }
  }
}

DEV void phase_out(const Params& P, int l, char* smem) {
  const int tid_ = tidx(); const int lane = tid_ & 63, w = tid_ >> 6;
  const int wm = w & 1, wn = w >> 1, r16 = lane & 15, g = lane >> 4;
  const bf16_t* Wl = P.WoT + (size_t)l * 1024 * 1024;
  for (int tile = vb(); tile < 16 * 32; tile += vg()) {
    const int m0 = (256 + (tile >> 5)) * 128, n0 = (tile & 31) * 32;
    f32x4 acc[4][1];
    zero_acc<1>(acc);
    gemm_main<32>(acc, P.proj + (size_t)m0 * PW + CM, PW, Wl + (size_t)n0 * 1024, 1024, 1024, smem);
#pragma unroll
    for (int mt = 0; mt < 4; ++mt) {
      const int m = m0 + wm * 64 + mt * 16 + r16;
      const float* src;
      float* dst;
      if (m < NLAT) { src = (l == 0 ? P.x : P.out) + (size_t)m * 1024; dst = P.out + (size_t)m * 1024; }
      else { src = (l == 0 ? P.ctx : P.ctxres) + (size_t)(m - NLAT) * 1024; dst = P.ctxres + (size_t)(m - NLAT) * 1024; }
      const float* gt = P.mods + (size_t)(l * 9 + mod_row(m)) * 3072 + 2048;
#pragma unroll
      for (int nt = 0; nt < 1; ++nt) {
        const int n = n0 + wn * 16 + nt * 16 + g * 4;
        float4 xo = *(const float4*)(src + n);
        float4 gg = *(const float4*)(gt + n);
        float4 r;
        r.x = xo.x + gg.x * acc[mt][nt][0];
        r.y = xo.y + gg.y * acc[mt][nt][1];
        r.z = xo.z + gg.z * acc[mt][nt][2];
        r.w = xo.w + gg.w * acc[mt][nt][3];
        *(float4*)(dst + n) = r;
      }
    }
  }
}

DEV void phase_final(const Params& P) {
  const int tid_ = tidx(); const int lane = tid_ & 63, w = tid_ >> 6;
  const int stride = vg() * 4;
  int r = vb() * 4 + w;
  float4 v[4], vn[4];
  if (r < NLAT) {
#pragma unroll
    for (int i = 0; i < 4; ++i) v[i] = *(const float4*)(P.out + (size_t)r * 1024 + i * 256 + lane * 4);
  }
  for (; r < NLAT; r += stride) {
    const int rn = r + stride;
    if (rn < NLAT) {
#pragma unroll
      for (int i = 0; i < 4; ++i) vn[i] = *(const float4*)(P.out + (size_t)rn * 1024 + i * 256 + lane * 4);
    }
    float* src = P.out + (size_t)r * 1024;
    float ss = 0.f;
#pragma unroll
    for (int i = 0; i < 4; ++i) ss += v[i].x * v[i].x + v[i].y * v[i].y + v[i].z * v[i].z + v[i].w * v[i].w;
#pragma unroll
    for (int o = 32; o > 0; o >>= 1) ss += __shfl_xor(ss, o);
    float rstd = rsqrtf(ss * (1.f / 1024.f) + 1e-6f);
#pragma unroll
    for (int i = 0; i < 4; ++i) {
      int k = i * 256 + lane * 4;
      float4 g4 = *(const float4*)(P.final_g + k);
      float4 r4;
      r4.x = v[i].x * rstd * g4.x; r4.y = v[i].y * rstd * g4.y; r4.z = v[i].z * rstd * g4.z; r4.w = v[i].w * rstd * g4.w;
      *(float4*)(src + k) = r4;
    }
#pragma unroll
    for (int i = 0; i < 4; ++i) v[i] = vn[i];
  }
}

namespace pg8 {
#define PG8_LAS __attribute__((address_space(3)))
constexpr int BM = 256, BK = 64, HALF = 128, HTB = HALF * BK * 2, NXCD = 8, WGM = 8;
DEV int lds_byte(int r, int c) { const int st = (r >> 4) * 2 + (c >> 5), rr = r & 15, cc = c & 31, ob = rr * 64 + cc * 2; return st * 1024 + (ob ^ (((ob >> 9) & 1) << 5)); }
DEV void stage_rc(int b, int& R, int& C) { const int st = b / 1024, sb = b % 1024, swz = sb ^ (((sb >> 9) & 1) << 5); R = (st >> 1) * 16 + swz / 64; C = (st & 1) * 32 + (swz % 64) / 2; }
DEV int perm32(int rho) { const int n = rho >> 4, i = rho & 15; return 8 * (i >> 2) + 4 * n + (i & 3); }
struct Unit { int pm, pn; };
struct Gemm { const bf16_t* A; const bf16_t* Bt; int M, N, K, lda; };
struct StaticOrder {
  int nM, nN, nwg, G, c;
  DEV void init(int M, int N, int G_, int c_) { nM = M / BM; nN = N / BM; nwg = nM * nN; G = G_; c = c_; }
  DEV bool next(int i, Unit& u) const {
    const long L = (long)i * G + c; if (L >= nwg) return false;
    int wgid = (int)L; { const int q = nwg / NXCD, r = nwg % NXCD, xcd = wgid % NXCD, off = wgid / NXCD; wgid = (xcd < r ? xcd * (q + 1) : r * (q + 1) + (xcd - r) * q) + off; }
    const int nig = WGM * nN, gid = wgid / nig, fm = gid * WGM, gsz = (nM - fm) < WGM ? (nM - fm) : WGM;
    u.pm = fm + ((wgid % nig) % gsz); u.pn = (wgid % nig) / gsz; return true;
  }
};
template <class Epi>
DEV void gemm_phase(PG8_LAS unsigned char* lds, const Gemm g, const StaticOrder& S, const Epi& E) {
  const int tid = tid512(), wid = __builtin_amdgcn_readfirstlane(tid >> 6), lane = tid & 63, wr = wid >> 2, wc = wid & 3, fr = lane & 15, fq = lane >> 4;
  const int K = g.K, nt = K / BK, lda = g.lda;
  unsigned voffA[2], voffB[2];
#pragma unroll
  for (int i = 0; i < 2; ++i) { int R, C; stage_rc(tid * 16 + i * 8192, R, C);
    const int Rb = (R & ~31) + perm32(R & 31);
    voffA[i] = (unsigned)(R * lda + C) * 2u; voffB[i] = (unsigned)(Rb * K + C) * 2u; }
  const size_t kstep = (size_t)(BK * 2);
  const size_t hstepA = (size_t)HALF * lda * 2, hstepB = (size_t)HALF * K * 2;
  const size_t tstepA = 2 * hstepA, tstepB = 2 * hstepB;
  const unsigned ldsw = (unsigned)wid * 1024u;
  const int aoff = lds_byte(wr * 64 + fr, fq * 8), boff = lds_byte(wc * 32 + fr, fq * 8);
#define PG8_SA(b, h) (((b) * 2 + (h)) * HTB)
#define PG8_SB(b, h) ((4 + (b) * 2 + (h)) * HTB)
#define PG8_STAGE(bufoff, gbase, voff) do { _Pragma("unroll") for (int _i = 0; _i < 2; ++_i) \
    __builtin_amdgcn_global_load_lds((const unsigned*)((const char*)(gbase) + (voff)[_i]), (PG8_LAS unsigned*)(lds + (bufoff) + ldsw + _i * 8192), 16, 0, 0); } while (0)
#define PG8_LDA(dst, b, h) do { _Pragma("unroll") for (int m = 0; m < 4; ++m) _Pragma("unroll") for (int k = 0; k < 2; ++k) dst[m][k] = *(const PG8_LAS bf16x8*)(lds + PG8_SA(b, h) + aoff + m * 2048 + k * 1024); } while (0)
#define PG8_LDB(dst, b, h) do { _Pragma("unroll") for (int n = 0; n < 2; ++n) _Pragma("unroll") for (int k = 0; k < 2; ++k) dst[n][k] = *(const PG8_LAS bf16x8*)(lds + PG8_SB(b, h) + boff + n * 2048 + k * 1024); } while (0)
#define PG8_MMA(ai, bj, At, Bt) do { __builtin_amdgcn_s_setprio(1); _Pragma("unroll") for (int m = 0; m < 4; ++m) _Pragma("unroll") for (int n = 0; n < 2; ++n) _Pragma("unroll") for (int k = 0; k < 2; ++k) \
    acc[ai][bj][m][n] = __builtin_amdgcn_mfma_f32_16x16x32_bf16(Bt[n][k], At[m][k], acc[ai][bj][m][n], 0, 0, 0); __builtin_amdgcn_s_setprio(0); } while (0)
#define PG8_WAIT_V(n) asm volatile("s_waitcnt vmcnt(" #n ")" ::: "memory")
#define PG8_WAIT_L(n) asm volatile("s_waitcnt lgkmcnt(" #n ")" ::: "memory")
#define PG8_BAR __builtin_amdgcn_s_barrier()
#define PG8_SCHED __builtin_amdgcn_sched_barrier(0)
  Unit cur, nxt; int ui = 0;
  if (!S.next(0, cur)) return;
  f32x4 acc[2][2][4][2];
#pragma unroll
  for (int a = 0; a < 2; ++a)
#pragma unroll
    for (int b = 0; b < 2; ++b)
#pragma unroll
      for (int m = 0; m < 4; ++m)
#pragma unroll
        for (int n = 0; n < 2; ++n) acc[a][b][m][n] = f32x4{0.f, 0.f, 0.f, 0.f};
  bf16x8 At[4][2], B0[2][2], B1[2][2];
  const char* cA = (const char*)g.A + (size_t)cur.pm * tstepA; const char* cB = (const char*)g.Bt + (size_t)cur.pn * tstepB;
  PG8_STAGE(PG8_SB(0, 0), cB, voffB); PG8_STAGE(PG8_SA(0, 0), cA, voffA); PG8_STAGE(PG8_SB(0, 1), cB + hstepB, voffB); PG8_STAGE(PG8_SA(0, 1), cA + hstepA, voffA);
  if (wr == 1) PG8_BAR;
  PG8_WAIT_V(4); PG8_BAR;
  PG8_STAGE(PG8_SB(1, 0), cB + kstep, voffB); PG8_STAGE(PG8_SA(1, 0), cA + kstep, voffA); PG8_STAGE(PG8_SB(1, 1), cB + hstepB + kstep, voffB);
  PG8_WAIT_V(6); PG8_BAR;
  for (;;) {
    const bool has_next = S.next(ui + 1, nxt);
    const char* nA = has_next ? (const char*)g.A + (size_t)nxt.pm * tstepA : cA; const char* nB = has_next ? (const char*)g.Bt + (size_t)nxt.pn * tstepB : cB;
    for (int t = 0; t < nt; t += 2) {
      const bool last = (t == nt - 2);
      const char* a1 = cA + (size_t)(t + 1) * kstep;
      const char* a2 = last ? nA : cA + (size_t)(t + 2) * kstep; const char* b2 = last ? nB : cB + (size_t)(t + 2) * kstep;
      const char* a3 = a2 + kstep; const char* b3 = b2 + kstep;
      PG8_LDB(B0, 0, 0); PG8_SCHED; PG8_LDA(At, 0, 0); PG8_STAGE(PG8_SA(1, 1), a1 + hstepA, voffA);
      PG8_WAIT_L(8); PG8_BAR; PG8_WAIT_L(0); PG8_MMA(0, 0, At, B0); PG8_BAR; PG8_SCHED;
      PG8_LDB(B1, 0, 1); PG8_STAGE(PG8_SB(0, 0), b2, voffB);
      PG8_BAR; PG8_WAIT_L(0); PG8_MMA(0, 1, At, B1); PG8_BAR;
      PG8_LDA(At, 0, 1); PG8_STAGE(PG8_SA(0, 0), a2, voffA);
      PG8_BAR; PG8_WAIT_L(0); PG8_MMA(1, 0, At, B0); PG8_BAR; PG8_SCHED;
      PG8_STAGE(PG8_SB(0, 1), b2 + hstepB, voffB);
      PG8_WAIT_V(6); PG8_BAR; PG8_MMA(1, 1, At, B1); PG8_BAR;
      PG8_LDB(B0, 1, 0); PG8_SCHED; PG8_LDA(At, 1, 0); PG8_STAGE(PG8_SA(0, 1), a2 + hstepA, voffA);
      PG8_WAIT_L(8); PG8_BAR; PG8_WAIT_L(0); PG8_MMA(0, 0, At, B0); PG8_BAR; PG8_SCHED;
      PG8_LDB(B1, 1, 1); PG8_STAGE(PG8_SB(1, 0), b3, voffB);
      PG8_BAR; PG8_WAIT_L(0); PG8_MMA(0, 1, At, B1); PG8_BAR;
      PG8_LDA(At, 1, 1); PG8_STAGE(PG8_SA(1, 0), a3, voffA);
      PG8_BAR; PG8_WAIT_L(0); PG8_MMA(1, 0, At, B0); PG8_BAR; PG8_SCHED;
      PG8_STAGE(PG8_SB(1, 1), b3 + hstepB, voffB);
      PG8_WAIT_V(6); PG8_BAR; PG8_MMA(1, 1, At, B1); PG8_BAR;
    }
    E(acc, cur, wr, wc, fr, fq);
    if (!has_next) break;
#pragma unroll
    for (int a = 0; a < 2; ++a)
#pragma unroll
      for (int b = 0; b < 2; ++b)
#pragma unroll
        for (int m = 0; m < 4; ++m)
#pragma unroll
          for (int n = 0; n < 2; ++n) acc[a][b][m][n] = f32x4{0.f, 0.f, 0.f, 0.f};
    cur = nxt; cA = nA; cB = nB; ++ui;
  }
  PG8_WAIT_V(0);
  if (wr == 0) PG8_BAR;
  PG8_BAR;
#undef PG8_SA
#undef PG8_SB
#undef PG8_STAGE
#undef PG8_LDA
#undef PG8_LDB
#undef PG8_MMA
#undef PG8_WAIT_V
#undef PG8_WAIT_L
#undef PG8_BAR
#undef PG8_SCHED
}
}

DEV u32x4 pack8(const f32x4& v0, const f32x4& v1) { return u32x4_mk(pack2(v0[0], v0[1]), pack2(v0[2], v0[3]), pack2(v1[0], v1[1]), pack2(v1[2], v1[3])); }
DEV float bflo(unsigned w) { return __uint_as_float(w << 16); }
DEV float bfhi(unsigned w) { return __uint_as_float(w & 0xffff0000u); }
struct EpiProj {
  const Params* Pp; int l;
  DEV void operator()(const f32x4 (&acc)[2][2][4][2], const pg8::Unit& u, int wr, int wc, int fr, int fq) const {
    const Params& P = *Pp;
    const float QS = 0.125f * 1.4426950408889634f;
#pragma unroll
    for (int ai = 0; ai < 2; ++ai)
#pragma unroll
      for (int mm = 0; mm < 4; ++mm) {
        const int m = u.pm * 256 + ai * 128 + wr * 64 + mm * 16 + fr;
#pragma unroll
        for (int bj = 0; bj < 2; ++bj) {
          const int region = (u.pn * 256 + bj * 128) >> 9;
          const int n8 = u.pn * 256 + bj * 128 + wc * 32 + 8 * fq;
          f32x4 v0 = acc[ai][bj][mm][0], v1 = acc[ai][bj][mm][1];
          if (region <= 1) {
            if (m < NLAT) {
              const int t = m & 4095;
              const int i0 = (n8 & 63) >> 1;
              const float4 c0 = *(const float4*)(P.rope + (size_t)t * 32 + i0);
              const float4 c1 = *(const float4*)(P.rope + (size_t)t * 32 + i0 + 2);
              v0 = f32x4{v0[0] * c0.x - v0[1] * c0.y, v0[0] * c0.y + v0[1] * c0.x, v0[2] * c0.z - v0[3] * c0.w, v0[2] * c0.w + v0[3] * c0.z};
              v1 = f32x4{v1[0] * c1.x - v1[1] * c1.y, v1[0] * c1.y + v1[1] * c1.x, v1[2] * c1.z - v1[3] * c1.w, v1[2] * c1.w + v1[3] * c1.z};
            }
            if (region == 0) { v0 = v0 * QS; v1 = v1 * QS; }
            *(u32x4*)(P.proj + (size_t)m * PW + n8) = pack8(v0, v1);
          } else if (region == 2) {
            int b, key;
            if (m < NLAT) { b = m >> 12; key = m & 4095; }
            else { b = (m - NLAT) >> 8; key = 4096 + ((m - NLAT) & 255); }
            bf16_t* vp = P.Vt + ((size_t)b * 512 + (n8 - 1024)) * 4352 + key;
#pragma unroll
            for (int j = 0; j < 4; ++j) { vp[(size_t)j * 4352] = f2bf(v0[j]); vp[(size_t)(4 + j) * 4352] = f2bf(v1[j]); }
          } else {
            if (region == 3 || region == 5 || region == 7) {
#pragma unroll
              for (int j = 0; j < 4; ++j) { v0[j] = siluf_(v0[j]); v1[j] = siluf_(v1[j]); }
            }
            *(u32x4*)(P.proj + (size_t)m * PW + n8) = pack8(v0, v1);
          }
        }
      }
  }
};
struct EpiGlu {
  const Params* Pp; int l;
  DEV void operator()(const f32x4 (&acc)[2][2][4][2], const pg8::Unit& u, int wr, int wc, int fr, int fq) const {
    const Params& P = *Pp;
#pragma unroll
    for (int ai = 0; ai < 2; ++ai)
#pragma unroll
      for (int mm = 0; mm < 4; ++mm) {
        const int m = u.pm * 256 + ai * 128 + wr * 64 + mm * 16 + fr;
#pragma unroll
        for (int bj = 0; bj < 2; ++bj) {
          const int n8 = u.pn * 256 + bj * 128 + wc * 32 + 8 * fq;
          const f32x4 a0 = acc[ai][bj][mm][0], a1 = acc[ai][bj][mm][1];
          const float4 b0 = *(const float4*)(P.s5_b_glu + l * 512 + n8), b1 = *(const float4*)(P.s5_b_glu + l * 512 + n8 + 4);
          const u32x4 gg = *(const u32x4*)(P.proj + (size_t)m * PW + CUS + n8);
          const u32x4 zz = *(const u32x4*)(P.proj + (size_t)m * PW + CZS + n8);
          f32x4 y0, y1;
          y0[0] = bflo(gg.x) * sigmoidf_(a0[0] + b0.x) * bflo(zz.x); y0[1] = bfhi(gg.x) * sigmoidf_(a0[1] + b0.y) * bfhi(zz.x);
          y0[2] = bflo(gg.y) * sigmoidf_(a0[2] + b0.z) * bflo(zz.y); y0[3] = bfhi(gg.y) * sigmoidf_(a0[3] + b0.w) * bfhi(zz.y);
          y1[0] = bflo(gg.z) * sigmoidf_(a1[0] + b1.x) * bflo(zz.z); y1[1] = bfhi(gg.z) * sigmoidf_(a1[1] + b1.y) * bfhi(zz.z);
          y1[2] = bflo(gg.w) * sigmoidf_(a1[2] + b1.z) * bflo(zz.w); y1[3] = bfhi(gg.w) * sigmoidf_(a1[3] + b1.w) * bfhi(zz.w);
          *(u32x4*)(P.proj + (size_t)m * PW + CZS + n8) = pack8(y0, y1);
        }
      }
  }
};
struct EpiOut {
  const Params* Pp; int l;
  DEV void operator()(const f32x4 (&acc)[2][2][4][2], const pg8::Unit& u, int wr, int wc, int fr, int fq) const {
    const Params& P = *Pp;
#pragma unroll
    for (int ai = 0; ai < 2; ++ai)
#pragma unroll
      for (int mm = 0; mm < 4; ++mm) {
        const int m = u.pm * 256 + ai * 128 + wr * 64 + mm * 16 + fr;
        const float* src;
        float* dst;
        if (m < NLAT) { src = (l == 0 ? P.x : P.out) + (size_t)m * 1024; dst = P.out + (size_t)m * 1024; }
        else { src = (l == 0 ? P.ctx : P.ctxres) + (size_t)(m - NLAT) * 1024; dst = P.ctxres + (size_t)(m - NLAT) * 1024; }
        const float* gt = P.mods + (size_t)(l * 9 + mod_row(m)) * 3072 + 2048;
#pragma unroll
        for (int bj = 0; bj < 2; ++bj) {
          const int n8 = u.pn * 256 + bj * 128 + wc * 32 + 8 * fq;
#pragma unroll
          for (int nn = 0; nn < 2; ++nn) {
            const f32x4 a = acc[ai][bj][mm][nn];
            const int n = n8 + 4 * nn;
            float4 xo = *(const float4*)(src + n);
            float4 gg = *(const float4*)(gt + n);
            float4 r;
            r.x = xo.x + gg.x * a[0];
            r.y = xo.y + gg.y * a[1];
            r.z = xo.z + gg.z * a[2];
            r.w = xo.w + gg.w * a[3];
            *(float4*)(dst + n) = r;
          }
        }
      }
  }
};
struct EpiYB {
  const Params* Pp; int l;
  DEV void operator()(const f32x4 (&acc)[2][2][4][2], const pg8::Unit& u, int wr, int wc, int fr, int fq) const {
    const Params& P = *Pp;
#pragma unroll
    for (int ai = 0; ai < 2; ++ai)
#pragma unroll
      for (int mm = 0; mm < 4; ++mm) {
        const int m = u.pm * 256 + ai * 128 + wr * 64 + mm * 16 + fr;
#pragma unroll
        for (int bj = 0; bj < 2; ++bj) {
          const int n8 = u.pn * 256 + bj * 128 + wc * 32 + 8 * fq;
          *(u32x4*)(P.proj + (size_t)m * PW + CZA + n8) = pack8(acc[ai][bj][mm][0], acc[ai][bj][mm][1]);
        }
      }
  }
};
struct EpiGate {
  const Params* Pp; int nb;
  DEV void operator()(const f32x4 (&acc)[2][2][4][2], const pg8::Unit& u, int wr, int wc, int fr, int fq) const {
    const Params& P = *Pp;
#pragma unroll
    for (int ai = 0; ai < 2; ++ai)
#pragma unroll
      for (int mm = 0; mm < 4; ++mm) {
        const int m = u.pm * 256 + ai * 128 + wr * 64 + mm * 16 + fr;
#pragma unroll
        for (int bj = 0; bj < 2; ++bj) {
          const int n8 = u.pn * 256 + bj * 128 + wc * 32 + 8 * fq;
          const f32x4 a0 = acc[ai][bj][mm][0], a1 = acc[ai][bj][mm][1];
          const u32x4 yb = *(const u32x4*)(P.proj + (size_t)m * PW + CZA + n8);
          f32x4 v0, v1;
          v0[0] = sigmoidf_(a0[0]) * bflo(yb.x); v0[1] = sigmoidf_(a0[1]) * bfhi(yb.x);
          v0[2] = sigmoidf_(a0[2]) * bflo(yb.y); v0[3] = sigmoidf_(a0[3]) * bfhi(yb.y);
          v1[0] = sigmoidf_(a1[0]) * bflo(yb.z); v1[1] = sigmoidf_(a1[1]) * bfhi(yb.z);
          v1[2] = sigmoidf_(a1[2]) * bflo(yb.w); v1[3] = sigmoidf_(a1[3]) * bfhi(yb.w);
          if (nb > 0) {
            const u32x4 pv = *(const u32x4*)(P.proj + (size_t)m * PW + CM + n8);
            v0[0] += bflo(pv.x); v0[1] += bfhi(pv.x); v0[2] += bflo(pv.y); v0[3] += bfhi(pv.y);
            v1[0] += bflo(pv.z); v1[1] += bfhi(pv.z); v1[2] += bflo(pv.w); v1[3] += bfhi(pv.w);
          }
          *(u32x4*)(P.proj + (size_t)m * PW + CM + n8) = pack8(v0, v1);
        }
      }
  }
};
template <class Epi>
DEV void engine_gemm_e(const Epi& E, char* smem, const bf16_t* A, int lda, const bf16_t* Bt, int M, int N, int K) {
  pg8::Gemm g{A, Bt, M, N, K, lda};
  pg8::StaticOrder S;
  S.init(M, N, (int)gridDim.x, (int)blockIdx.x);
  pg8::gemm_phase<Epi>((PG8_LAS unsigned char*)smem, g, S, E);
}
template <class Epi>
DEV void engine_gemm(const Params& P, int l, char* smem, const bf16_t* A, int lda, const bf16_t* Bt, int M, int N, int K) {
  Epi E{&P, l};
  engine_gemm_e<Epi>(E, smem, A, lda, Bt, M, N, K);
}
DEV void engine_merge(const Params& P, int l, char* smem, int M) {
#pragma unroll 1
  for (int nb = 0; nb < 3; ++nb) {
    const int cofs = nb == 0 ? CQ : (nb == 1 ? CZR : CZS);
    EpiYB ey{&P, l};
    engine_gemm_e<EpiYB>(ey, smem, P.proj + cofs, PW, P.WbT + (size_t)(l * 3 + nb) * 1024 * 512, M, 1024, 512);
    EpiGate eg{&P, nb};
    engine_gemm_e<EpiGate>(eg, smem, P.hbuf, 1024, P.WinT + ((size_t)l * 7168 + 4096 + nb * 1024) * 1024, M, 1024, 1024);
  }
}

#define XB_TMO      128
#define XB_XCNT(j)  (256  + 64 * (j))
#define XB_XSUB(j)  (1280 + 64 * (j))
#define XB_XGEN(j)  (2304 + 64 * (j))
#define XB_TOP      3328
#define XB_TOPGEN   3392
#define XCD_BAR_WORDS 3456
#define XB_SPIN_CAP (1u << 18)
#define LAS __attribute__((address_space(3)))

__device__ __forceinline__ unsigned xb_ld(unsigned* p)              { return __hip_atomic_load(p, __ATOMIC_RELAXED, __HIP_MEMORY_SCOPE_AGENT); }
__device__ __forceinline__ unsigned xb_add(unsigned* p, unsigned v) { return __hip_atomic_fetch_add(p, v, __ATOMIC_RELAXED, __HIP_MEMORY_SCOPE_AGENT); }
__device__ __forceinline__ unsigned xb_xcc_id() { return (unsigned)__builtin_amdgcn_s_getreg((3 << 11) | 20) & 0xFu; }
#define XB_SPIN(cond, bar) do { unsigned _sp = 0; while (cond) { __builtin_amdgcn_s_sleep(1); \
    if ((++_sp & 255u) == 0u) { if (xb_ld(&(bar)[XB_TMO])) break; if (_sp > XB_SPIN_CAP) { atomicAdd(&(bar)[XB_TMO], 1u); break; } } } } while (0)

struct XcdBarrier {
    unsigned* bar; unsigned x;
    volatile LAS unsigned* st;
};

__device__ __forceinline__ XcdBarrier xcd_barrier_post(unsigned* bar, volatile LAS unsigned* st) {
    XcdBarrier b; b.bar = bar; b.x = xb_xcc_id(); b.st = st;
    if (threadIdx.x == 0) (void)xb_add(&bar[XB_XCNT(b.x)], 1u);
    return b;
}
__device__ __forceinline__ void xcd_barrier_complete(unsigned* bar, unsigned x, unsigned& nloc, unsigned& nx) {
    const unsigned G = gridDim.x * gridDim.y * gridDim.z;
    unsigned sum, cnt, mine, sp = 0u;
    for (;;) {
        sum = 0u; cnt = 0u; mine = 0u;
#pragma unroll
        for (unsigned j = 0; j < 16; ++j) { const unsigned c = xb_ld(&bar[XB_XCNT(j)]); sum += c; cnt += (c > 0u) ? 1u : 0u; mine = (j == x) ? c : mine; }
        if (sum == G) break;
        __builtin_amdgcn_s_sleep(1);
        if ((++sp & 255u) == 0u) { if (xb_ld(&bar[XB_TMO])) break; if (sp > XB_SPIN_CAP) { atomicAdd(&bar[XB_TMO], 1u); break; } }
    }
    nloc = mine > 0u ? mine : 1u; nx = cnt > 0u ? cnt : 1u;
}

__device__ __forceinline__ void xcd_barrier(const XcdBarrier& b) {
    asm volatile("s_waitcnt vmcnt(0)" ::: "memory");
    __syncthreads();
    if (threadIdx.x == 0) {
        unsigned* bar = b.bar;
        __builtin_amdgcn_s_waitcnt(0);
        unsigned nloc = b.st[0], nx = b.st[1];
        if (nloc == 0u) { xcd_barrier_complete(bar, b.x, nloc, nx); b.st[0] = nloc; b.st[1] = nx; }
        const unsigned old = xb_add(&bar[XB_XSUB(b.x)], 1u);
        const unsigned gen = old / nloc;
        if (old + 1u == (gen + 1u) * nloc) {
            __builtin_amdgcn_fence(__ATOMIC_RELEASE, "agent");
            asm volatile("s_waitcnt vmcnt(0)" ::: "memory");
            const unsigned og = xb_add(&bar[XB_TOP], 1u);
            const unsigned tg = og / nx;
            if (og + 1u == (tg + 1u) * nx) xb_add(&bar[XB_TOPGEN], 1u);
            else XB_SPIN(xb_ld(&bar[XB_TOPGEN]) == tg, bar);
            __builtin_amdgcn_fence(__ATOMIC_ACQUIRE, "agent");
            xb_add(&bar[XB_XGEN(b.x)], 1u);
            asm volatile("s_waitcnt vmcnt(0)" ::: "memory");
        } else {
            XB_SPIN(xb_ld(&bar[XB_XGEN(b.x)]) == gen, bar);
            __builtin_amdgcn_fence(__ATOMIC_ACQUIRE, "agent");
            asm volatile("s_waitcnt vmcnt(0)" ::: "memory");
        }
    }
    __syncthreads();
}


#ifndef PROBE_PH
#define PROBE_PH -1
#endif
#define REPEAT(id, body) { int nrep_ = (PROBE_PH == (id)) ? 2 : 1; asm volatile("" : "+s"(nrep_)); _Pragma("unroll 1") for (int rep_ = 0; rep_ < nrep_; ++rep_) { body } }
__global__ void __launch_bounds__(512, 2) mega_kernel(Params P) {
  __shared__ __attribute__((aligned(16))) char smem_all[SMEM_BYTES];
  cg::grid_group grid = cg::this_grid();
  char* smem = smem_all + vhalf() * SMEM_HALF;
  __shared__ __attribute__((aligned(16))) unsigned xb_st[4];
  if (threadIdx.x < 4) xb_st[threadIdx.x] = 0u;
  __syncthreads();
  const XcdBarrier xb = xcd_barrier_post(P.bar, (volatile LAS unsigned*)xb_st);
  REPEAT(0, phase0(P, smem); grid.sync();)
#pragma unroll 1
  for (int l = 0; l < 4; ++l) {
    REPEAT(5, phase_norm(P, l); xcd_barrier(xb);)
    engine_gemm<EpiProj>(P, l, smem_all, P.hbuf, 1024, P.WinT + (size_t)l * 7168 * 1024, NR, 4096, 1024);
    if (l < 3 && gridDim.x == 256 && blockIdx.x >= 128) prep_layer_weights(P, l + 1, ((int)blockIdx.x - 128) * 2 + vhalf(), 256, smem);
    if (l < 3 && gridDim.x != 256) prep_layer_weights(P, l + 1, vb(), vg(), smem);
    xcd_barrier(xb);
#if PROBE_PH == 1
    engine_gemm<EpiProj>(P, l, smem_all, P.hbuf, 1024, P.WinT + (size_t)l * 7168 * 1024, NR, 4096, 1024);
    xcd_barrier(xb);
#endif
    REPEAT(2, phase_scan(P, l, false, smem); xcd_barrier(xb);)
    phase_attn8(P, l, smem_all);
    xcd_barrier(xb);
    phase_scan(P, l, true, smem);
    xcd_barrier(xb);
    engine_gemm<EpiGlu>(P, l, smem_all, P.proj + CUS, PW, P.WgT + (size_t)l * 512 * 512, NLAT, 512, 512);
    if (l < 3) phase_glu(P, l, smem);
    xcd_barrier(xb);
    engine_merge(P, l, smem_all, NLAT);
    if (l < 3) phase_merge(P, l, smem);
    xcd_barrier(xb);
#if PROBE_PH == 4
    engine_merge(P, l, smem_all, Mrows);
    xcd_barrier(xb);
#endif
    engine_gemm<EpiOut>(P, l, smem_all, P.proj + CM, PW, P.WoT + (size_t)l * 1024 * 1024, NLAT, 1024, 1024);
    if (l < 3) phase_out(P, l, smem);
    xcd_barrier(xb);
  }
  phase_final(P);
}

extern "C" void kernel_launch(void* const* d_in, const int* in_sizes, int n_in, void* d_out, int out_size, void* d_ws,
                              size_t ws_size, hipStream_t stream) {
  Params p{};
  const float** fp = (const float**)&p;
  for (int i = 0; i < 30; ++i) fp[i] = (const float*)d_in[i];
  p.out = (float*)d_out;
  char* ws = (char*)d_ws;
  size_t off = 0;
  auto take = [&](size_t bytes) { char* r = ws + off; off += (bytes + 255) & ~(size_t)255; return r; };
  p.proj = (bf16_t*)take((size_t)NR * PW * 2);
  p.hbuf = (bf16_t*)take((size_t)NR * 1024 * 2);
  p.WinT = (bf16_t*)take((size_t)4 * 7168 * 1024 * 2);
  p.WbT = (bf16_t*)take((size_t)12 * 1024 * 512 * 2);
  p.WoT = (bf16_t*)take((size_t)4 * 1024 * 1024 * 2);
  p.WgT = (bf16_t*)take((size_t)4 * 512 * 512 * 2);
  p.WlT = (bf16_t*)take((size_t)128 * 4096 * 2);
  p.Vt = (bf16_t*)take((size_t)32 * 128 * 4352 * 2);
  p.ctxres = (float*)take((size_t)2048 * 1024 * 4);
  p.mods = (float*)take((size_t)4 * 9 * 3072 * 4);
  p.lamv = (float*)take(256);
  p.lruP = (float*)take((size_t)2 * NCH * 512 * 4);
  p.lruS = (float*)take((size_t)2 * NCH * 512 * 4);
  p.rope = (float2*)take((size_t)4096 * 32 * 8);
  p.s5A = (float2*)take((size_t)256 * 64 * 8);
  p.s5A64 = (float2*)take((size_t)256 * 64 * 8);
  p.s5E = (float2*)take((size_t)2 * NCH * 32 * 64 * 8);
  p.s5drvB = (u32x4*)take((size_t)256 * 8 * 64 * 16);
  p.s5C = (u32x4*)take((size_t)128 * 4 * 64 * 16);
  p.bar = (unsigned*)take((size_t)XCD_BAR_WORDS * 4);
  if (off > ws_size) { fprintf(stderr, "workspace too small: need %zu have %zu\n", off, ws_size); return; }

  static int grid_blocks = 0;
  if (!grid_blocks) {
    int dev = 0, cus = 0, per_cu = 0;
    (void)hipGetDevice(&dev);
    (void)hipDeviceGetAttribute(&cus, hipDeviceAttributeMultiprocessorCount, dev);
    (void)hipOccupancyMaxActiveBlocksPerMultiprocessor(&per_cu, mega_kernel, 512, 0);
    if (per_cu < 1) per_cu = 1;
    if (per_cu > 1) per_cu = 1;
    grid_blocks = cus * per_cu;
  }
  (void)hipMemsetAsync(p.bar, 0, (size_t)XCD_BAR_WORDS * 4, stream);
  void* args[] = {&p};
  hipError_t e = hipLaunchCooperativeKernel((void*)mega_kernel, dim3(grid_blocks), dim3(512), args, 0, stream);
  if (e != hipSuccess) fprintf(stderr, "cooperative launch failed: %s (grid %d)\n", hipGetErrorString(e), grid_blocks);
}
```

```cpp
#include <hip/hip_runtime.h>
#include <hip/hip_bf16.h>
#include <hip/hip_cooperative_groups.h>
#include <cstdio>
#include <cstdint>
namespace cg = cooperative_groups;

#ifndef MULTI_LAUNCH
#define MULTI_LAUNCH 0
#endif

#define DEV __device__ __forceinline__
typedef unsigned short bf16_t;
using bf16x8 = __attribute__((ext_vector_type(8))) short;
using f32x4 = __attribute__((ext_vector_type(4))) float;
using u32x4 = __attribute__((ext_vector_type(4))) unsigned;
using u32x2 = __attribute__((ext_vector_type(2))) unsigned;

constexpr int NR = 34816;
constexpr int NLAT = 32768;
constexpr int PW = 4096;
constexpr int CQ = 0, CK = 512, CZA = 1536, CXR = 2048, CZR = 2560, CUS = 3072, CZS = 3584, CM = 512;
constexpr int NCH = 544;
constexpr int NPHASE = 34;
constexpr int SMEM_HALF = 73728;
constexpr int SMEM_BYTES = 2 * SMEM_HALF;

struct Params {
  const float *x, *c, *ctx, *c_ctx, *w_mod, *b_mod, *norm_g, *w_in, *lam_qk, *subln_g, *conv_w, *conv_b,
      *lru_wa, *lru_ba, *lru_wx, *lru_bx, *lru_lam, *s5_lam_re, *s5_lam_im, *s5_log_dt, *s5_b_re, *s5_b_im,
      *s5_c_re, *s5_c_im, *s5_d, *s5_w_glu, *s5_b_glu, *w_branch, *w_out, *final_g;
  float* out;
  bf16_t *proj, *hbuf, *WinT, *WbT, *WoT, *WgT, *WlT, *Vt;
  float *ctxres, *mods, *lamv, *lruP, *lruS;
  float2 *rope, *s5A, *s5A64, *s5E;
  u32x4 *s5drvB, *s5C;
  unsigned* bar;
};

DEV int tidx() { int t = threadIdx.x & 255; asm volatile("" : "+v"(t)); return t; }
DEV int tid512() { int t = threadIdx.x; asm volatile("" : "+v"(t)); return t; }
DEV int vhalf() { return __builtin_amdgcn_readfirstlane((int)(threadIdx.x >> 8)); }
DEV int vb() { return (int)blockIdx.x * 2 + vhalf(); }
DEV int vg() { return (int)gridDim.x * 2; }
DEV u32x4 u32x4_mk(unsigned a, unsigned b, unsigned c, unsigned d) { return u32x4{a, b, c, d}; }
DEV u32x2 u32x2_mk(unsigned a, unsigned b) { return u32x2{a, b}; }
typedef float f32x2_t __attribute__((ext_vector_type(2)));
typedef __bf16 bf16x2_t __attribute__((ext_vector_type(2)));
DEV bf16_t f2bf(float f) { return __builtin_bit_cast(unsigned short, (__bf16)f); }
DEV float bf2f(bf16_t h) { return __uint_as_float(((unsigned)h) << 16); }
DEV unsigned pack2(float a, float b) {
  f32x2_t v = {a, b};
  return __builtin_bit_cast(unsigned, __builtin_convertvector(v, bf16x2_t));
}
DEV float fexp2(float x) { return __builtin_amdgcn_exp2f(x); }
DEV float frcp(float x) { return __builtin_amdgcn_rcpf(x); }
DEV float sigmoidf_(float x) { return frcp(1.f + __expf(-x)); }
DEV float siluf_(float x) { return x * frcp(1.f + __expf(-x)); }
DEV float gelu_tanh(float x) {
  float u = 0.7978845608028654f * (x + 0.044715f * x * x * x);
  return x * frcp(1.f + __expf(-2.f * u));
}
DEV float shx(float v, int mask, int lane) { return __int_as_float(__builtin_amdgcn_ds_bpermute((lane ^ mask) << 2, __float_as_int(v))); }
DEV float shi(float v, int src) { return __int_as_float(__builtin_amdgcn_ds_bpermute(src << 2, __float_as_int(v))); }
DEV f32x4 mfma16(bf16x8 a, bf16x8 b, f32x4 c) { return __builtin_amdgcn_mfma_f32_16x16x32_bf16(a, b, c, 0, 0, 0); }
DEV bf16x8 as_bf16x8(u32x4 v) {
  return __builtin_bit_cast(bf16x8, v);
}

template <int NTW>
DEV void g_load(u32x4 (&ra)[4], u32x4 (&rw)[NTW], const bf16_t* __restrict__ A, int lda, const bf16_t* __restrict__ W,
                int ldw, int k0, int lrow, int loff) {
#pragma unroll
  for (int i = 0; i < 4; ++i) ra[i] = *(const u32x4*)(A + (size_t)(lrow + 32 * i) * lda + k0 + loff);
#pragma unroll
  for (int i = 0; i < NTW; ++i) rw[i] = *(const u32x4*)(W + (size_t)(lrow + 32 * i) * ldw + k0 + loff);
}
template <int NTW>
DEV void s_store(const u32x4 (&ra)[4], const u32x4 (&rw)[NTW], bf16_t* As, bf16_t* Ws, int lrow, int loff) {
#pragma unroll
  for (int i = 0; i < 4; ++i) *(u32x4*)(As + (lrow + 32 * i) * 72 + loff) = ra[i];
#pragma unroll
  for (int i = 0; i < NTW; ++i) *(u32x4*)(Ws + (lrow + 32 * i) * 72 + loff) = rw[i];
}
template <int BN>
DEV void g_compute(f32x4 (&acc)[4][BN / 32], const bf16_t* As, const bf16_t* Ws, int wm, int wn, int r16, int g) {
  constexpr int NTW = BN / 32;
#pragma unroll
  for (int kb = 0; kb < 2; ++kb) {
    bf16x8 af[4], wf[NTW];
#pragma unroll
    for (int mt = 0; mt < 4; ++mt) af[mt] = *(const bf16x8*)(As + (wm * 64 + mt * 16 + r16) * 72 + kb * 32 + g * 8);
#pragma unroll
    for (int nt = 0; nt < NTW; ++nt)
      wf[nt] = *(const bf16x8*)(Ws + (wn * (BN / 2) + nt * 16 + r16) * 72 + kb * 32 + g * 8);
#pragma unroll
    for (int mt = 0; mt < 4; ++mt)
#pragma unroll
      for (int nt = 0; nt < NTW; ++nt) acc[mt][nt] = mfma16(wf[nt], af[mt], acc[mt][nt]);
  }
}
template <int BN>
DEV void gemm_main(f32x4 (&acc)[4][BN / 32], const bf16_t* __restrict__ A, int lda, const bf16_t* __restrict__ W,
                   int ldw, int K, char* smem) {
  constexpr int NTW = BN / 32;
  constexpr int BUF = (128 + BN) * 72;
  bf16_t* As0 = (bf16_t*)smem;
  bf16_t* Ws0 = As0 + 128 * 72;
  bf16_t* As1 = As0 + BUF;
  bf16_t* Ws1 = As1 + 128 * 72;
  const int tid = tidx(), lane = tid & 63, w = tid >> 6;
  const int wm = w & 1, wn = w >> 1;
  const int r16 = lane & 15, g = lane >> 4;
  const int lrow = tid >> 3, loff = (tid & 7) * 8;
  u32x4 ra0[4], rw0[NTW], ra1[4], rw1[NTW];
  const int nk = K >> 6;
  g_load<NTW>(ra0, rw0, A, lda, W, ldw, 0, lrow, loff);
  g_load<NTW>(ra1, rw1, A, lda, W, ldw, 64, lrow, loff);
  __syncthreads();
  s_store<NTW>(ra0, rw0, As0, Ws0, lrow, loff);
  g_load<NTW>(ra0, rw0, A, lda, W, ldw, 128, lrow, loff);
  __syncthreads();
  for (int kt = 0; kt < nk; kt += 2) {
    s_store<NTW>(ra1, rw1, As1, Ws1, lrow, loff);
    g_load<NTW>(ra1, rw1, A, lda, W, ldw, min(kt + 3, nk - 1) << 6, lrow, loff);
    g_compute<BN>(acc, As0, Ws0, wm, wn, r16, g);
    __syncthreads();
    s_store<NTW>(ra0, rw0, As0, Ws0, lrow, loff);
    g_load<NTW>(ra0, rw0, A, lda, W, ldw, min(kt + 4, nk - 1) << 6, lrow, loff);
    g_compute<BN>(acc, As1, Ws1, wm, wn, r16, g);
    __syncthreads();
  }
}

template <int NT>
DEV void zero_acc(f32x4 (&acc)[4][NT]) {
#pragma unroll
  for (int i = 0; i < 4; ++i)
#pragma unroll
    for (int j = 0; j < NT; ++j) acc[i][j] = f32x4{0.f, 0.f, 0.f, 0.f};
}

DEV int mod_row(int m) { return m < NLAT ? (m >> 12) : 8; }

DEV void transpose_tile(const float* __restrict__ src, int N, bf16_t* __restrict__ dst, int K, int k0, int n0, char* smem) {
  float* tile = (float*)smem;
  const int tid = tidx();
  __syncthreads();
  {
    const int n = tid & 63, kk = tid >> 6;
#pragma unroll
    for (int i = 0; i < 16; ++i) {
      int k = kk + 4 * i;
      tile[k * 65 + n] = src[(size_t)(k0 + k) * N + n0 + n];
    }
  }
  __syncthreads();
  {
    const int k = tid & 63, nn = tid >> 6;
#pragma unroll
    for (int i = 0; i < 16; ++i) {
      int n = nn + 4 * i;
      dst[(size_t)(n0 + n) * K + k0 + k] = f2bf(tile[k * 65 + n]);
    }
  }
}

DEV void transpose_tile2(const float* __restrict__ src, int N, bf16_t* __restrict__ dst, int K, int k0, int n0, char* smem) {
  float* tile = (float*)smem;
  const int tid = tidx();
  __syncthreads();
  {
    const int n = tid & 63, kk = tid >> 6;
#pragma unroll
    for (int i = 0; i < 32; ++i) {
      int k = kk + 4 * i;
      tile[k * 65 + n] = src[(size_t)(k0 + k) * N + n0 + n];
    }
  }
  __syncthreads();
  {
    const int kp = tid & 63, nn = tid >> 6;
#pragma unroll
    for (int i = 0; i < 16; ++i) {
      int n = nn + 4 * i;
      unsigned v = pack2(tile[(2 * kp) * 65 + n], tile[(2 * kp + 1) * 65 + n]);
      *(unsigned*)(dst + (size_t)(n0 + n) * K + k0 + 2 * kp) = v;
    }
  }
}

struct TrJob { const float* src; bf16_t* dst; int N, K, k0, n0, rows; };
DEV TrJob prep_job(const Params& P, int l, int job) {
  TrJob t;
  int j = job;
  if (j < 896) {
    t.src = P.w_in + (size_t)l * 1024 * 7168; t.dst = P.WinT + (size_t)l * 7168 * 1024; t.N = 7168; t.K = 1024;
    t.k0 = (j / 112) * 128; t.n0 = (j % 112) * 64; t.rows = 128; return t;
  }
  j -= 896;
  if (j < 192) {
    const int mat = l * 3 + j / 64, q = j % 64;
    t.src = P.w_branch + (size_t)mat * 512 * 1024; t.dst = P.WbT + (size_t)mat * 1024 * 512; t.N = 1024; t.K = 512;
    t.k0 = (q / 16) * 128; t.n0 = (q % 16) * 64; t.rows = 128; return t;
  }
  j -= 192;
  if (j < 128) {
    t.src = P.w_out + (size_t)l * 1024 * 1024; t.dst = P.WoT + (size_t)l * 1024 * 1024; t.N = 1024; t.K = 1024;
    t.k0 = (j / 16) * 128; t.n0 = (j % 16) * 64; t.rows = 128; return t;
  }
  j -= 128;
  if (j < 32) {
    t.src = P.s5_w_glu + (size_t)l * 512 * 512; t.dst = P.WgT + (size_t)l * 512 * 512; t.N = 512; t.K = 512;
    t.k0 = (j / 8) * 128; t.n0 = (j % 8) * 64; t.rows = 128; return t;
  }
  j -= 32;
  {
    const int jj = l * 32 + j;
    const int blk = jj & 7, which = (jj >> 3) & 1, ld = jj >> 4;
    t.src = (which ? P.lru_wx : P.lru_wa) + (size_t)(ld * 8 + blk) * 4096; t.dst = P.WlT + (size_t)jj * 4096; t.N = 64; t.K = 64;
    t.k0 = 0; t.n0 = 0; t.rows = 64; return t;
  }
}
DEV void prep_load(const TrJob& t, float (&v)[32], int tid) {
  const int n = tid & 63, kk = tid >> 6;
#pragma unroll
  for (int i = 0; i < 32; ++i) {
    const int k = kk + 4 * i;
    v[i] = (k < t.rows) ? t.src[(size_t)(t.k0 + k) * t.N + t.n0 + n] : 0.f;
  }
}
DEV void prep_layer_weights(const Params& P, int l, int first, int stride, char* smem) {
  float* tile = (float*)smem;
  const int tid = tidx();
  if (first >= 1280) return;
  TrJob cur = prep_job(P, l, first);
  float v[32];
  prep_load(cur, v, tid);
  for (int job = first; job < 1280; job += stride) {
    __syncthreads();
    {
      const int n = tid & 63, kk = tid >> 6;
#pragma unroll
      for (int i = 0; i < 32; ++i) tile[(kk + 4 * i) * 65 + n] = v[i];
    }
    const bool has_next = job + stride < 1280;
    TrJob nxt = cur;
    if (has_next) { nxt = prep_job(P, l, job + stride); prep_load(nxt, v, tid); }
    __syncthreads();
    {
      const int kp = tid & 63, nn = tid >> 6;
      if (2 * kp < cur.rows) {
#pragma unroll
        for (int i = 0; i < 16; ++i) {
          const int n = nn + 4 * i;
          const unsigned pk = pack2(tile[(2 * kp) * 65 + n], tile[(2 * kp + 1) * 65 + n]);
          *(unsigned*)(cur.dst + (size_t)(cur.n0 + n) * cur.K + cur.k0 + 2 * kp) = pk;
        }
      }
    }
    cur = nxt;
  }
}

DEV void phase0(const Params& P, char* smem) {
  const int tid = tidx();
  prep_layer_weights(P, 0, vb(), vg(), smem);
  constexpr int J_MOD = 768, J_ROPE = 512, J_S5 = 256;
  constexpr int JT = J_MOD + J_ROPE + J_S5 + 1;
  for (int job = vb(); job < JT; job += vg()) {
    int j = job;
    if (j < J_MOD) {
      int l = j / 192, jt = j % 192;
      float* sc = (float*)smem;
      float* red = sc + 9216;
      __syncthreads();
      for (int idx = tid; idx < 9216; idx += 256) {
        int r = idx >> 10, k = idx & 1023;
        float v = r < 8 ? P.c[r * 1024 + k] : P.c_ctx[k];
        sc[idx] = siluf_(v);
      }
      __syncthreads();
      const int jj = tid & 15, kq = tid >> 4, col = jt * 16 + jj;
      float a[9];
#pragma unroll
      for (int r = 0; r < 9; ++r) a[r] = 0.f;
      const float* wp = P.w_mod + (size_t)l * 1024 * 3072 + col;
#pragma unroll 16
      for (int k = kq * 64; k < kq * 64 + 64; ++k) {
        float wv = wp[(size_t)k * 3072];
#pragma unroll
        for (int r = 0; r < 9; ++r) a[r] += sc[r * 1024 + k] * wv;
      }
#pragma unroll
      for (int r = 0; r < 9; ++r) red[(kq * 9 + r) * 16 + jj] = a[r];
      __syncthreads();
      if (tid < 144) {
        int r = tid >> 4, j2 = tid & 15;
        float s_ = 0.f;
#pragma unroll
        for (int q = 0; q < 16; ++q) s_ += red[(q * 9 + r) * 16 + j2];
        int cc = jt * 16 + j2;
        P.mods[(size_t)(l * 9 + r) * 3072 + cc] = s_ + P.b_mod[l * 3072 + cc];
      }
      continue;
    }
    j -= J_MOD;
    if (j < J_ROPE) {
      int e = j * 256 + tid;
      int t = e >> 5, i = e & 31, f = i & 15;
      float inv = powf(10000.f, -(float)f / 16.f);
      float pos = (float)(i < 16 ? (t >> 6) : (t & 63));
      float ang = pos * inv;
      P.rope[e] = make_float2(cosf(ang), sinf(ang));
      continue;
    }
    j -= J_ROPE;
    if (j < J_S5) {
      const int g = j & 31, ld = j >> 5, l = ld >> 1, d = ld & 1;
      float* crs = (float*)smem;
      __syncthreads();
      if (tid < 64) {
        int p = tid;
        float lr = P.s5_lam_re[(size_t)j * 64 + p], li = P.s5_lam_im[(size_t)j * 64 + p];
        float dt = expf(P.s5_log_dt[j]);
        float mag = expf(lr * dt);
        float ar = mag * cosf(li * dt), ai = mag * sinf(li * dt);
        float den = lr * lr + li * li;
        float nr = ar - 1.f;
        crs[p] = (nr * lr + ai * li) / den;
        crs[64 + p] = (ai * lr - nr * li) / den;
        P.s5A[(size_t)j * 64 + p] = make_float2(ar, ai);
        float pr = ar, pi = ai;
#pragma unroll
        for (int s = 0; s < 6; ++s) {
          float nr2 = pr * pr - pi * pi, ni2 = 2.f * pr * pi;
          pr = nr2; pi = ni2;
        }
        P.s5A64[(size_t)j * 64 + p] = make_float2(pr, pi);
      }
      __syncthreads();
      for (int e = tid; e < 512; e += 256) {
        int nt = e >> 6, ln = e & 63;
        int ri = nt >> 2, p = (nt & 3) * 16 + (ln & 15), kg = ln >> 4;
        float cr = crs[p], ci = crs[64 + p];
        unsigned v[4] = {0u, 0u, 0u, 0u};
        if (kg < 2) {
          const float* bre = P.s5_b_re + ((size_t)j * 64 + p) * 16 + kg * 8;
          const float* bim = P.s5_b_im + ((size_t)j * 64 + p) * 16 + kg * 8;
#pragma unroll
          for (int q = 0; q < 4; ++q) {
            float r0 = bre[2 * q], i0 = bim[2 * q], r1 = bre[2 * q + 1], i1 = bim[2 * q + 1];
            float v0 = ri == 0 ? cr * r0 - ci * i0 : cr * i0 + ci * r0;
            float v1 = ri == 0 ? cr * r1 - ci * i1 : cr * i1 + ci * r1;
            v[q] = pack2(v0, v1);
          }
        }
        P.s5drvB[((size_t)j * 8 + nt) * 64 + ln] = u32x4_mk(v[0], v[1], v[2], v[3]);
      }
      if (d == 0) {
        int kk = tid >> 6, ln = tid & 63;
        int h = ln & 15;
        unsigned v[4];
#pragma unroll
        for (int q = 0; q < 4; ++q) {
          float vv[2];
#pragma unroll
          for (int s = 0; s < 2; ++s) {
            int k = kk * 32 + (ln >> 4) * 8 + 2 * q + s;
            size_t base = ((size_t)(l * 32 + g) * 16 + h) * 64;
            vv[s] = (k & 1) == 0 ? P.s5_c_re[base + (k >> 1)] : -P.s5_c_im[base + (k >> 1)];
          }
          v[q] = pack2(vv[0], vv[1]);
        }
        P.s5C[((size_t)(l * 32 + g) * 4 + kk) * 64 + ln] = u32x4_mk(v[0], v[1], v[2], v[3]);
      }
      continue;
    }
    j -= J_S5;
    {
      int l = tid >> 6, lane = tid & 63;
      const float* lq = P.lam_qk + l * 256;
      float s1 = lq[lane] * lq[64 + lane], s2 = lq[128 + lane] * lq[192 + lane];
#pragma unroll
      for (int o = 32; o > 0; o >>= 1) {
        s1 += shx(s1, o, lane);
        s2 += shx(s2, o, lane);
      }
      float lam_init = 0.8f - 0.6f * expf(-0.3f * (float)l);
      if (lane == 0) P.lamv[l] = expf(s1) - expf(s2) + lam_init;
    }
  }
}

DEV void phase_norm(const Params& P, int l) {
  const int tid_ = tidx(); const int lane = tid_ & 63, w = tid_ >> 6;
  const float* ng = P.norm_g + l * 1024;
  auto rowptr = [&](int r) -> const float* {
    if (r < NLAT) return (l == 0 ? P.x : P.out) + (size_t)r * 1024;
    return (l == 0 ? P.ctx : P.ctxres) + (size_t)(r - NLAT) * 1024;
  };
  const int stride = vg() * 4;
  int r = vb() * 4 + w;
  float4 v[4], vn[4];
  if (r < NR) {
    const float* src = rowptr(r);
#pragma unroll
    for (int i = 0; i < 4; ++i) v[i] = *(const float4*)(src + i * 256 + lane * 4);
  }
  for (; r < NR; r += stride) {
    const int rn = r + stride;
    if (rn < NR) {
      const float* srcn = rowptr(rn);
#pragma unroll
      for (int i = 0; i < 4; ++i) vn[i] = *(const float4*)(srcn + i * 256 + lane * 4);
    }
    const float* md = P.mods + (size_t)(l * 9 + mod_row(r)) * 3072;
    float ss = 0.f;
#pragma unroll
    for (int i = 0; i < 4; ++i) ss += v[i].x * v[i].x + v[i].y * v[i].y + v[i].z * v[i].z + v[i].w * v[i].w;
#pragma unroll
    for (int o = 32; o > 0; o >>= 1) ss += __shfl_xor(ss, o);
    float rstd = rsqrtf(ss * (1.f / 1024.f) + 1e-6f);
#pragma unroll
    for (int i = 0; i < 4; ++i) {
      int k = i * 256 + lane * 4;
      float4 g4 = *(const float4*)(ng + k);
      float4 sh = *(const float4*)(md + k);
      float4 sc = *(const float4*)(md + 1024 + k);
      float o0 = v[i].x * rstd * g4.x * (1.f + sc.x) + sh.x;
      float o1 = v[i].y * rstd * g4.y * (1.f + sc.y) + sh.y;
      float o2 = v[i].z * rstd * g4.z * (1.f + sc.z) + sh.z;
      float o3 = v[i].w * rstd * g4.w * (1.f + sc.w) + sh.w;
      u32x2 pk = u32x2_mk(pack2(o0, o1), pack2(o2, o3));
      *(u32x2*)(P.hbuf + (size_t)r * 1024 + k) = pk;
    }
#pragma unroll
    for (int i = 0; i < 4; ++i) v[i] = vn[i];
  }
}

DEV void phase_proj(const Params& P, int l, char* smem) {
  const int tid_ = tidx(); const int lane = tid_ & 63, w = tid_ >> 6;
  const int wm = w & 1, wn = w >> 1, r16 = lane & 15, g = lane >> 4;
  const bf16_t* Wl = P.WinT + (size_t)l * 7168 * 1024;
  const float QS = 0.125f * 1.4426950408889634f;
  for (int tile = vb(); tile < 272 * 32; tile += vg()) {
    const int mtile = tile >> 5, ntile = tile & 31;
    const int m0 = mtile * 128, n0 = ntile * 128;
    f32x4 acc[4][4];
    zero_acc<4>(acc);
    gemm_main<128>(acc, P.hbuf + (size_t)m0 * 1024, 1024, Wl + (size_t)n0 * 1024, 1024, 1024, smem);
    const int region = n0 >> 9;
#pragma unroll
    for (int mt = 0; mt < 4; ++mt) {
      const int m = m0 + wm * 64 + mt * 16 + r16;
#pragma unroll
      for (int nt = 0; nt < 4; ++nt) {
        const int n = n0 + wn * 64 + nt * 16 + g * 4;
        f32x4 v = acc[mt][nt];
        if (region <= 1) {
          if (m < NLAT) {
            int t = m & 4095;
            int i0 = (n & 63) >> 1;
            float4 cs = *(const float4*)(P.rope + (size_t)t * 32 + i0);
            float a0 = v[0] * cs.x - v[1] * cs.y, a1 = v[0] * cs.y + v[1] * cs.x;
            float a2 = v[2] * cs.z - v[3] * cs.w, a3 = v[2] * cs.w + v[3] * cs.z;
            v = f32x4{a0, a1, a2, a3};
          }
          if (region == 0) v = v * QS;
          *(u32x2*)(P.proj + (size_t)m * PW + n) = u32x2_mk(pack2(v[0], v[1]), pack2(v[2], v[3]));
        } else if (region == 2) {
          int b, key;
          if (m < NLAT) { b = m >> 12; key = m & 4095; }
          else { b = (m - NLAT) >> 8; key = 4096 + ((m - NLAT) & 255); }
          int nn = n - 1024;
          bf16_t* vp = P.Vt + ((size_t)b * 512 + nn) * 4352 + key;
#pragma unroll
          for (int j = 0; j < 4; ++j) vp[(size_t)j * 4352] = f2bf(v[j]);
        } else {
          if (region == 3 || region == 5 || region == 7) {
#pragma unroll
            for (int j = 0; j < 4; ++j) v[j] = siluf_(v[j]);
          }
          *(u32x2*)(P.proj + (size_t)m * PW + n) = u32x2_mk(pack2(v[0], v[1]), pack2(v[2], v[3]));
        }
      }
    }
  }
}

struct ChunkGeo { int row0, seqrow0, seqlen, tloc0; };
DEV ChunkGeo chunk_geo(int cid) {
  ChunkGeo c;
  if (cid < 512) {
    int b = cid >> 6, lc = cid & 63;
    c.row0 = b * 4096 + lc * 64; c.seqrow0 = b * 4096; c.seqlen = 4096; c.tloc0 = lc * 64;
  } else {
    int cc = cid - 512, b = cc >> 2;
    c.row0 = NLAT + cc * 64; c.seqrow0 = NLAT + b * 256; c.seqlen = 256; c.tloc0 = (cc & 3) * 64;
  }
  return c;
}
DEV int chunk_at(int b, int d, int pos) {
  if (d == 0) return pos < 4 ? 512 + b * 4 + pos : b * 64 + (pos - 4);
  return pos < 4 ? 512 + b * 4 + (3 - pos) : b * 64 + (63 - (pos - 4));
}

DEV void lru_item(const Params& P, int l, int item, bool step3, char* smem) {
  const int tid = tidx(), lane = tid & 63, w = tid >> 6, r16 = lane & 15, g = lane >> 4;
  const int cid = item >> 3, cb = item & 7;
  const ChunkGeo cg_ = chunk_geo(cid);
  bf16_t* Us = (bf16_t*)smem;
  const int c8 = tid & 7, tr = tid >> 3;
  const int ch0 = cb * 64 + c8 * 8;
  u32x4 xin[2][4];
#pragma unroll
  for (int pass = 0; pass < 2; ++pass)
#pragma unroll
    for (int jt = 0; jt < 4; ++jt) {
      const int tt = cg_.tloc0 + tr + 32 * pass + jt - 2;
      u32x4 xv = u32x4_mk(0u, 0u, 0u, 0u);
      if (tt >= 0 && tt < cg_.seqlen) xv = *(const u32x4*)(P.proj + (size_t)(cg_.seqrow0 + tt) * PW + CXR + ch0);
      xin[pass][jt] = xv;
    }
  float wt[4][8], cbv[8];
  {
    const float4 b0 = *(const float4*)(P.conv_b + l * 512 + ch0), b1 = *(const float4*)(P.conv_b + l * 512 + ch0 + 4);
    cbv[0] = b0.x; cbv[1] = b0.y; cbv[2] = b0.z; cbv[3] = b0.w; cbv[4] = b1.x; cbv[5] = b1.y; cbv[6] = b1.z; cbv[7] = b1.w;
#pragma unroll
    for (int jt = 0; jt < 4; ++jt) {
      const float4 w0 = *(const float4*)(P.conv_w + (l * 4 + jt) * 512 + ch0), w1 = *(const float4*)(P.conv_w + (l * 4 + jt) * 512 + ch0 + 4);
      wt[jt][0] = w0.x; wt[jt][1] = w0.y; wt[jt][2] = w0.z; wt[jt][3] = w0.w; wt[jt][4] = w1.x; wt[jt][5] = w1.y; wt[jt][6] = w1.z; wt[jt][7] = w1.w;
    }
  }
  const int ch = cb * 64 + w * 16 + r16;
  bf16_t zep[4][4];
  float cin[2] = {0.f, 0.f};
  if (step3) {
    cin[0] = P.lruS[(size_t)(0 * NCH + cid) * 512 + ch];
    cin[1] = P.lruS[(size_t)(1 * NCH + cid) * 512 + ch];
#pragma unroll
    for (int tt = 0; tt < 4; ++tt)
#pragma unroll
      for (int j = 0; j < 4; ++j) zep[tt][j] = P.proj[(size_t)(cg_.row0 + tt * 16 + g * 4 + j) * PW + CZR + ch];
  }
  bf16x8 wfr[2][2][2];
  float bav[2], bxv[2], lmv[2];
#pragma unroll
  for (int d = 0; d < 2; ++d) {
#pragma unroll
    for (int wh = 0; wh < 2; ++wh)
#pragma unroll
      for (int kb = 0; kb < 2; ++kb)
        wfr[d][wh][kb] = *(const bf16x8*)(P.WlT + (size_t)(((l * 2 + d) * 2 + wh) * 8 + cb) * 4096 + (w * 16 + r16) * 64 + kb * 32 + g * 8);
    bav[d] = P.lru_ba[(l * 2 + d) * 512 + ch];
    bxv[d] = P.lru_bx[(l * 2 + d) * 512 + ch];
    lmv[d] = P.lru_lam[(l * 2 + d) * 512 + ch];
  }
  __syncthreads();
#pragma unroll
  for (int pass = 0; pass < 2; ++pass) {
    const int t = tr + 32 * pass;
    float a[8];
#pragma unroll
    for (int e = 0; e < 8; ++e) a[e] = cbv[e];
#pragma unroll
    for (int jt = 0; jt < 4; ++jt) {
      const u32x4 xv = xin[pass][jt];
      const unsigned xs[4] = {xv.x, xv.y, xv.z, xv.w};
#pragma unroll
      for (int q = 0; q < 4; ++q) {
        a[2 * q] += wt[jt][2 * q] * bf2f((bf16_t)(xs[q] & 0xffffu));
        a[2 * q + 1] += wt[jt][2 * q + 1] * bf2f((bf16_t)(xs[q] >> 16));
      }
    }
    *(u32x4*)(Us + t * 72 + c8 * 8) = u32x4_mk(pack2(a[0], a[1]), pack2(a[2], a[3]), pack2(a[4], a[5]), pack2(a[6], a[7]));
  }
  __syncthreads();
  bf16x8 uf[4][2];
#pragma unroll
  for (int tt = 0; tt < 4; ++tt)
#pragma unroll
    for (int kb = 0; kb < 2; ++kb) uf[tt][kb] = *(const bf16x8*)(Us + (tt * 16 + r16) * 72 + kb * 32 + g * 8);
  float uval[4][4];
#pragma unroll
  for (int tt = 0; tt < 4; ++tt)
#pragma unroll
    for (int j = 0; j < 4; ++j) uval[tt][j] = bf2f(Us[(tt * 16 + g * 4 + j) * 72 + w * 16 + r16]);
  float outv[4][4];
#pragma unroll
  for (int tt = 0; tt < 4; ++tt)
#pragma unroll
    for (int j = 0; j < 4; ++j) outv[tt][j] = 0.f;

#pragma unroll
  for (int d = 0; d < 2; ++d) {
    f32x4 ga[4], gx[4];
#pragma unroll
    for (int tt = 0; tt < 4; ++tt) { ga[tt] = f32x4{0.f, 0.f, 0.f, 0.f}; gx[tt] = f32x4{0.f, 0.f, 0.f, 0.f}; }
#pragma unroll
    for (int kb = 0; kb < 2; ++kb) {
#pragma unroll
      for (int tt = 0; tt < 4; ++tt) {
        ga[tt] = mfma16(uf[tt][kb], wfr[d][0][kb], ga[tt]);
        gx[tt] = mfma16(uf[tt][kb], wfr[d][1][kb], gx[tt]);
      }
    }
    const float ba = bav[d], bx = bxv[d];
    const float ex_ = __expf(-lmv[d]);
    const float sp = ex_ < 0.05f ? ex_ * (1.f - ex_ * (0.5f - ex_ * (0.33333334f - ex_ * (0.25f - 0.2f * ex_)))) : __logf(1.f + ex_);
    float av[4][4], bv[4][4];
    {
      const float L2E = 1.4426950408889634f;
      const f32x2_t ba2 = {ba, ba}, bx2 = {bx, bx};
      const float c_la = -8.f * sp * L2E, c_x2 = -16.f * sp;
#pragma unroll
      for (int tt = 0; tt < 4; ++tt)
#pragma unroll
        for (int jp = 0; jp < 2; ++jp) {
          const f32x2_t G = (f32x2_t{ga[tt][2 * jp], ga[tt][2 * jp + 1]} + ba2) * (-L2E);
          const f32x2_t X = (f32x2_t{gx[tt][2 * jp], gx[tt][2 * jp + 1]} + bx2) * (-L2E);
          const f32x2_t dg = f32x2_t{fexp2(G[0]), fexp2(G[1])} + 1.f, dx = f32x2_t{fexp2(X[0]), fexp2(X[1])} + 1.f;
          const f32x2_t r = {frcp(dg[0]), frcp(dg[1])}, ii = {frcp(dx[0]), frcp(dx[1])};
          const f32x2_t la2 = r * c_la;
          const f32x2_t a2 = {fexp2(la2[0]), fexp2(la2[1])};
          const f32x2_t x2 = r * c_x2;
          f32x2_t ser = __builtin_elementwise_fma(x2, f32x2_t{0.0013888889f, 0.0013888889f}, f32x2_t{0.0083333338f, 0.0083333338f});
          ser = __builtin_elementwise_fma(x2, ser, f32x2_t{0.041666668f, 0.041666668f});
          ser = __builtin_elementwise_fma(x2, ser, f32x2_t{0.16666667f, 0.16666667f});
          ser = __builtin_elementwise_fma(x2, ser, f32x2_t{0.5f, 0.5f});
          ser = __builtin_elementwise_fma(x2, ser, f32x2_t{1.f, 1.f});
          ser = ser * (-x2);
          const f32x2_t dir = __builtin_elementwise_fma(-a2, a2, f32x2_t{1.f, 1.f});
          const f32x2_t om = {x2[0] > -0.25f ? ser[0] : dir[0], x2[1] > -0.25f ? ser[1] : dir[1]};
          const f32x2_t sq = {__builtin_amdgcn_sqrtf(om[0]), __builtin_amdgcn_sqrtf(om[1])};
          const f32x2_t bb = sq * (ii * f32x2_t{uval[tt][2 * jp], uval[tt][2 * jp + 1]});
          av[tt][2 * jp] = a2[0]; av[tt][2 * jp + 1] = a2[1];
          bv[tt][2 * jp] = bb[0]; bv[tt][2 * jp + 1] = bb[1];
        }
    }
    float Ps[4], Ss[4];
#pragma unroll
    for (int tt = 0; tt < 4; ++tt) {
      float p_ = 1.f, s_ = 0.f;
      if (d == 0) {
#pragma unroll
        for (int j = 0; j < 4; ++j) { p_ *= av[tt][j]; s_ = s_ * av[tt][j] + bv[tt][j]; }
      } else {
#pragma unroll
        for (int j = 3; j >= 0; --j) { p_ *= av[tt][j]; s_ = s_ * av[tt][j] + bv[tt][j]; }
      }
      Ps[tt] = p_; Ss[tt] = s_;
    }
    const size_t cidx = (size_t)(d * NCH + cid) * 512 + ch;
    if (!step3) {
      float Pc = 1.f, Sc = 0.f;
#pragma unroll
      for (int q = 0; q < 4; ++q) {
        const int tt = d == 0 ? q : 3 - q;
#pragma unroll
        for (int q2 = 0; q2 < 4; ++q2) {
          const int gg = d == 0 ? q2 : 3 - q2;
          float Pg = shi(Ps[tt], gg * 16 + r16), Sg = shi(Ss[tt], gg * 16 + r16);
          Sc = Sc * Pg + Sg;
          Pc = Pc * Pg;
        }
      }
      if (g == 0) { P.lruP[cidx] = Pc; P.lruS[cidx] = Sc; }
    } else {
      float carry = cin[d];
#pragma unroll
      for (int q = 0; q < 4; ++q) {
        const int tt = d == 0 ? q : 3 - q;
        float run = carry, hstart = 0.f;
#pragma unroll
        for (int q2 = 0; q2 < 4; ++q2) {
          const int gg = d == 0 ? q2 : 3 - q2;
          float Pg = shi(Ps[tt], gg * 16 + r16), Sg = shi(Ss[tt], gg * 16 + r16);
          if (gg == g) hstart = run;
          run = run * Pg + Sg;
        }
        carry = run;
        float h = hstart;
        if (d == 0) {
#pragma unroll
          for (int j = 0; j < 4; ++j) { h = av[tt][j] * h + bv[tt][j]; outv[tt][j] += h; }
        } else {
#pragma unroll
          for (int j = 3; j >= 0; --j) { h = av[tt][j] * h + bv[tt][j]; outv[tt][j] += h; }
        }
      }
    }
  }
  if (step3) {
#pragma unroll
    for (int tt = 0; tt < 4; ++tt)
#pragma unroll
      for (int j = 0; j < 4; ++j) {
        bf16_t* zp = P.proj + (size_t)(cg_.row0 + tt * 16 + g * 4 + j) * PW + CZR + ch;
        *zp = f2bf(outv[tt][j] * bf2f(zep[tt][j]));
      }
  }
}

DEV void s5_item(const Params& P, int l, int item, bool step3, char* smem) {
  const int tid = tidx(), lane = tid & 63, w = tid >> 6, r16 = lane & 15, g = lane >> 4;
  const int cid = item >> 3, gq = item & 7;
  const int grp = gq * 4 + w;
  const ChunkGeo cg_ = chunk_geo(cid);
  bf16_t* BUh = (bf16_t*)(smem + w * 16896);
  bf16_t* Hs = (bf16_t*)(smem + w * 16896 + 8192);
  f32x4 Y[4];
#pragma unroll
  for (int s_ = 0; s_ < 4; ++s_) Y[s_] = f32x4{0.f, 0.f, 0.f, 0.f};
  bf16x8 ufr[4];
#pragma unroll
  for (int sub = 0; sub < 4; ++sub) {
    u32x4 uv = u32x4_mk(0u, 0u, 0u, 0u);
    if (g < 2) uv = *(const u32x4*)(P.proj + (size_t)(cg_.row0 + sub * 16 + r16) * PW + CUS + grp * 16 + g * 8);
    ufr[sub] = as_bf16x8(uv);
  }
  bf16x8 cf[4];
  bf16_t uep[4][4];
  if (step3) {
#pragma unroll
    for (int kk = 0; kk < 4; ++kk) cf[kk] = as_bf16x8(P.s5C[((size_t)(l * 32 + grp) * 4 + kk) * 64 + lane]);
#pragma unroll
    for (int sub = 0; sub < 4; ++sub)
#pragma unroll
      for (int j = 0; j < 4; ++j) uep[sub][j] = P.proj[(size_t)(cg_.row0 + sub * 16 + g * 4 + j) * PW + CUS + grp * 16 + r16];
  }
  const int jd0 = (l * 2 + 0) * 32 + grp, jd1 = (l * 2 + 1) * 32 + grp;
  bf16x8 bfrA[8], bfrB[8];
#pragma unroll
  for (int nt = 0; nt < 8; ++nt) {
    bfrA[nt] = as_bf16x8(P.s5drvB[((size_t)jd0 * 8 + nt) * 64 + lane]);
    bfrB[nt] = as_bf16x8(P.s5drvB[((size_t)jd1 * 8 + nt) * 64 + lane]);
  }
  const float2 A0 = P.s5A[(size_t)jd0 * 64 + lane], A1 = P.s5A[(size_t)jd1 * 64 + lane];
  const size_t eidx0 = ((size_t)(0 * NCH + cid) * 32 + grp) * 64 + lane, eidx1 = ((size_t)(1 * NCH + cid) * 32 + grp) * 64 + lane;
  float h0r = 0.f, h0i = 0.f, h1r = 0.f, h1i = 0.f;
  if (step3) { float2 a_ = P.s5E[eidx0], b_ = P.s5E[eidx1]; h0r = a_.x; h0i = a_.y; h1r = b_.x; h1i = b_.y; }
#pragma unroll
  for (int si = 0; si < 4; ++si) {
    const int sub0 = si, sub1 = 3 - si;
    __syncthreads();
#pragma unroll
    for (int nt = 0; nt < 8; ++nt) {
      f32x4 b0 = mfma16(ufr[sub0], bfrA[nt], f32x4{0.f, 0.f, 0.f, 0.f});
      f32x4 b1 = mfma16(ufr[sub1], bfrB[nt], f32x4{0.f, 0.f, 0.f, 0.f});
      *(u32x2*)(BUh + (nt * 16 + r16) * 16 + g * 4) = u32x2_mk(pack2(b0[0], b0[1]), pack2(b0[2], b0[3]));
      *(u32x2*)(BUh + 2048 + (nt * 16 + r16) * 16 + g * 4) = u32x2_mk(pack2(b1[0], b1[1]), pack2(b1[2], b1[3]));
    }
    __syncthreads();
    u32x4 r0a = *(const u32x4*)(BUh + lane * 16), r0b = *(const u32x4*)(BUh + lane * 16 + 8);
    u32x4 i0a = *(const u32x4*)(BUh + (64 + lane) * 16), i0b = *(const u32x4*)(BUh + (64 + lane) * 16 + 8);
    u32x4 r1a = *(const u32x4*)(BUh + 2048 + lane * 16), r1b = *(const u32x4*)(BUh + 2048 + lane * 16 + 8);
    u32x4 i1a = *(const u32x4*)(BUh + 2048 + (64 + lane) * 16), i1b = *(const u32x4*)(BUh + 2048 + (64 + lane) * 16 + 8);
    const unsigned re0[8] = {r0a.x, r0a.y, r0a.z, r0a.w, r0b.x, r0b.y, r0b.z, r0b.w};
    const unsigned im0[8] = {i0a.x, i0a.y, i0a.z, i0a.w, i0b.x, i0b.y, i0b.z, i0b.w};
    const unsigned re1[8] = {r1a.x, r1a.y, r1a.z, r1a.w, r1b.x, r1b.y, r1b.z, r1b.w};
    const unsigned im1[8] = {i1a.x, i1a.y, i1a.z, i1a.w, i1b.x, i1b.y, i1b.z, i1b.w};
    {
      f32x2_t HR = {h0r, h1r}, HI = {h0i, h1i};
      const f32x2_t AX = {A0.x, A1.x}, AY = {A0.y, A1.y}, NAY = {-A0.y, -A1.y};
#pragma unroll
      for (int ti = 0; ti < 16; ++ti) {
        const int tf = ti, tb = 15 - ti;
        const unsigned rwf = re0[tf >> 1], iwf = im0[tf >> 1], rwb = re1[tb >> 1], iwb = im1[tb >> 1];
        const f32x2_t RE = {(tf & 1) ? __uint_as_float(rwf & 0xffff0000u) : __uint_as_float(rwf << 16),
                            (tb & 1) ? __uint_as_float(rwb & 0xffff0000u) : __uint_as_float(rwb << 16)};
        const f32x2_t IM = {(tf & 1) ? __uint_as_float(iwf & 0xffff0000u) : __uint_as_float(iwf << 16),
                            (tb & 1) ? __uint_as_float(iwb & 0xffff0000u) : __uint_as_float(iwb << 16)};
        const f32x2_t NR = __builtin_elementwise_fma(AX, HR, __builtin_elementwise_fma(NAY, HI, RE));
        const f32x2_t NI = __builtin_elementwise_fma(AX, HI, __builtin_elementwise_fma(AY, HR, IM));
        HR = NR; HI = NI;
        if (step3) {
          *(unsigned*)(Hs + tf * 136 + 2 * lane) = pack2(HR[0], HI[0]);
          *(unsigned*)(Hs + 2176 + tb * 136 + 2 * lane) = pack2(HR[1], HI[1]);
        }
      }
      h0r = HR[0]; h1r = HR[1]; h0i = HI[0]; h1i = HI[1];
    }
    if (step3) {
      __syncthreads();
#pragma unroll
      for (int kk = 0; kk < 4; ++kk) {
        bf16x8 hf0 = *(const bf16x8*)(Hs + r16 * 136 + kk * 32 + g * 8);
        bf16x8 hf1 = *(const bf16x8*)(Hs + 2176 + r16 * 136 + kk * 32 + g * 8);
        Y[sub0] = mfma16(hf0, cf[kk], Y[sub0]);
        Y[sub1] = mfma16(hf1, cf[kk], Y[sub1]);
      }
    }
  }
  if (!step3) { P.s5E[eidx0] = make_float2(h0r, h0i); P.s5E[eidx1] = make_float2(h1r, h1i); }
  if (step3) {
    const float dsk = P.s5_d[l * 512 + grp * 16 + r16];
#pragma unroll
    for (int sub = 0; sub < 4; ++sub)
#pragma unroll
      for (int j = 0; j < 4; ++j) {
        bf16_t* up = P.proj + (size_t)(cg_.row0 + sub * 16 + g * 4 + j) * PW + CUS + grp * 16 + r16;
        float y = Y[sub][j] + dsk * bf2f(uep[sub][j]);
        *up = f2bf(gelu_tanh(y));
      }
  }
}

DEV void phase_scan(const Params& P, int l, bool step3, char* smem) {
  const int ncid = (step3 && l == 3) ? 512 : NCH;
  const int nitems = ncid * 8;
  for (int it = vb(); it < 2 * nitems; it += vg()) {
    if (it < nitems) s5_item(P, l, it, step3, smem);
    else lru_item(P, l, it - nitems, step3, smem);
  }
}

DEV void carry_job(const Params& P, int l, int job) {
  const int tid = tidx();
  if (job < 32) {
    int id = job * 256 + tid;
    int ch = id & 511, d = (id >> 9) & 1, b = id >> 10;
    float carry = 0.f;
#pragma unroll 4
    for (int pos = 0; pos < 68; ++pos) {
      size_t idx = (size_t)(d * NCH + chunk_at(b, d, pos)) * 512 + ch;
      float Pv = P.lruP[idx], Sv = P.lruS[idx];
      P.lruS[idx] = carry;
      carry = Pv * carry + Sv;
    }
  } else {
    int id = (job - 32) * 256 + tid;
    int p = id & 63, g = (id >> 6) & 31, d = (id >> 11) & 1, b = id >> 12;
    float2 A = P.s5A64[((size_t)(l * 2 + d) * 32 + g) * 64 + p];
    float cr = 0.f, ci = 0.f;
#pragma unroll 4
    for (int pos = 0; pos < 68; ++pos) {
      size_t idx = ((size_t)(d * NCH + chunk_at(b, d, pos)) * 32 + g) * 64 + p;
      float2 e = P.s5E[idx];
      P.s5E[idx] = make_float2(cr, ci);
      float nr = A.x * cr - A.y * ci + e.x;
      float ni = A.x * ci + A.y * cr + e.y;
      cr = nr; ci = ni;
    }
  }
}

DEV void attn_item(const Params& P, int l, int item, char* smem, int dowrite = 1) {
  const int tid = tidx(), lane = tid & 63, w = tid >> 6, r16 = lane & 15, g = lane >> 4;
  bf16_t* Ks = (bf16_t*)smem;
  bf16_t* Vs = Ks + 64 * 136;
  int b, h, qrow0, kt0, nkt;
  if (item < 2048) {
    b = item >> 8; h = (item >> 6) & 3;
    qrow0 = b * 4096 + (item & 63) * 64; kt0 = 0; nkt = 68;
  } else {
    int i2 = item - 2048;
    b = i2 >> 4; h = (i2 >> 2) & 3;
    qrow0 = NLAT + b * 256 + (i2 & 3) * 64; kt0 = 64; nkt = 4;
  }
  const int qrow = qrow0 + w * 16 + r16;
  bf16x8 qf[2][2];
#pragma unroll
  for (int c = 0; c < 2; ++c)
#pragma unroll
    for (int kb = 0; kb < 2; ++kb)
      qf[c][kb] = *(const bf16x8*)(P.proj + (size_t)qrow * PW + CQ + h * 128 + c * 64 + kb * 32 + g * 8);
  f32x4 o[2][8];
#pragma unroll
  for (int c = 0; c < 2; ++c)
#pragma unroll
    for (int dv = 0; dv < 8; ++dv) o[c][dv] = f32x4{0.f, 0.f, 0.f, 0.f};
  float mrun[2] = {-1e30f, -1e30f}, lsum[2] = {0.f, 0.f};
  const bf16_t* Vbase = P.Vt + (size_t)(b * 4 + h) * 128 * 4352;
  u32x4 rk[4], rv[4];
  auto gl = [&](int kt) {
    int krow0, vkey0;
    if (kt < 64) { krow0 = b * 4096 + kt * 64; vkey0 = kt * 64; }
    else { krow0 = NLAT + b * 256 + (kt - 64) * 64; vkey0 = 4096 + (kt - 64) * 64; }
#pragma unroll
    for (int i = 0; i < 4; ++i) {
      int cidx = tid + 256 * i;
      rk[i] = *(const u32x4*)(P.proj + (size_t)(krow0 + (cidx >> 4)) * PW + CK + h * 128 + (cidx & 15) * 8);
      rv[i] = *(const u32x4*)(Vbase + (size_t)(cidx >> 3) * 4352 + vkey0 + (cidx & 7) * 8);
    }
  };
  auto st = [&](int buf) {
    bf16_t* Kd = Ks + buf * (64 * 136 + 128 * 72);
    bf16_t* Vd = Vs + buf * (64 * 136 + 128 * 72);
#pragma unroll
    for (int i = 0; i < 4; ++i) {
      int cidx = tid + 256 * i;
      *(u32x4*)(Kd + (cidx >> 4) * 136 + (cidx & 15) * 8) = rk[i];
      *(u32x4*)(Vd + (cidx >> 3) * 72 + (cidx & 7) * 8) = rv[i];
    }
  };
  gl(kt0);
  __syncthreads();
  st(0);
  gl(kt0 + 1);
  __syncthreads();
  for (int it = 0; it < nkt; ++it) {
    const int cur = it & 1;
    if (it + 1 < nkt) st(cur ^ 1);
    if (it + 2 < nkt) gl(kt0 + it + 2);
    const bf16_t* Kc = Ks + cur * (64 * 136 + 128 * 72);
    const bf16_t* Vc = Vs + cur * (64 * 136 + 128 * 72);
#pragma unroll
    for (int c = 0; c < 2; ++c) {
      f32x4 s[4];
#pragma unroll
      for (int kt = 0; kt < 4; ++kt) {
        s[kt] = f32x4{0.f, 0.f, 0.f, 0.f};
#pragma unroll
        for (int kb = 0; kb < 2; ++kb) {
          bf16x8 kf = *(const bf16x8*)(Kc + (kt * 16 + r16) * 136 + c * 64 + kb * 32 + g * 8);
          s[kt] = mfma16(kf, qf[c][kb], s[kt]);
        }
      }
      float mx = fmaxf(fmaxf(s[0][0], s[0][1]), fmaxf(s[0][2], s[0][3]));
#pragma unroll
      for (int kt = 1; kt < 4; ++kt) mx = fmaxf(mx, fmaxf(fmaxf(s[kt][0], s[kt][1]), fmaxf(s[kt][2], s[kt][3])));
      mx = fmaxf(mx, shx(mx, 16, lane));
      mx = fmaxf(mx, shx(mx, 32, lane));
      const bool need = mx > mrun[c] + 8.f;
      if (__any(need)) {
        const float mnew = need ? mx : mrun[c];
        const float alpha = fexp2(mrun[c] - mnew);
        mrun[c] = mnew;
        lsum[c] *= alpha;
#pragma unroll
        for (int dv = 0; dv < 8; ++dv) o[c][dv] = o[c][dv] * alpha;
      }
      const float mref = mrun[c];
      float ps = 0.f;
#pragma unroll
      for (int kt = 0; kt < 4; ++kt) {
        s[kt] = s[kt] - mref;
#pragma unroll
        for (int j = 0; j < 4; ++j) { s[kt][j] = fexp2(s[kt][j]); ps += s[kt][j]; }
      }
      lsum[c] += ps;
      bf16x8 pf[2];
#pragma unroll
      for (int kb2 = 0; kb2 < 2; ++kb2) {
        u32x4 pk = u32x4_mk(pack2(s[2 * kb2][0], s[2 * kb2][1]), pack2(s[2 * kb2][2], s[2 * kb2][3]),
                            pack2(s[2 * kb2 + 1][0], s[2 * kb2 + 1][1]), pack2(s[2 * kb2 + 1][2], s[2 * kb2 + 1][3]));
        pf[kb2] = as_bf16x8(pk);
      }
#pragma unroll
      for (int dv = 0; dv < 8; ++dv) {
        if ((dv & 1) == 0) __builtin_amdgcn_sched_barrier(0);
#pragma unroll
        for (int kb2 = 0; kb2 < 2; ++kb2) {
          const bf16_t* vp = Vc + (dv * 16 + r16) * 72 + kb2 * 32 + g * 4;
          u32x2 v0 = *(const u32x2*)vp, v1 = *(const u32x2*)(vp + 16);
          bf16x8 vf = as_bf16x8(u32x4_mk(v0.x, v0.y, v1.x, v1.y));
          o[c][dv] = mfma16(vf, pf[kb2], o[c][dv]);
        }
      }
      __builtin_amdgcn_sched_barrier(0);
    }
    __syncthreads();
  }
  float l0 = lsum[0], l1 = lsum[1];
  l0 += shx(l0, 16, lane); l0 += shx(l0, 32, lane);
  l1 += shx(l1, 16, lane); l1 += shx(l1, 32, lane);
  const float lam = P.lamv[l];
  const float i0 = 1.f / l0, i1 = lam / l1;
  float ss = 0.f;
#pragma unroll
  for (int dv = 0; dv < 8; ++dv)
#pragma unroll
    for (int j = 0; j < 4; ++j) {
      float v = o[0][dv][j] * i0 - o[1][dv][j] * i1;
      o[0][dv][j] = v;
      ss += v * v;
    }
  ss += shx(ss, 16, lane); ss += shx(ss, 32, lane);
  const float lam_init = 0.8f - 0.6f * expf(-0.3f * (float)l);
  const float rs = rsqrtf(ss * (1.f / 128.f) + 1e-6f) * (1.f - lam_init);
#pragma unroll
  for (int dv = 0; dv < 8; ++dv) {
    const int dcol = dv * 16 + g * 4;
    float4 sg = *(const float4*)(P.subln_g + l * 128 + dcol);
    u32x2 zz = *(const u32x2*)(P.proj + (size_t)qrow * PW + CZA + h * 128 + dcol);
    float z0 = bf2f((bf16_t)(zz.x & 0xffffu)), z1 = bf2f((bf16_t)(zz.x >> 16));
    float z2 = bf2f((bf16_t)(zz.y & 0xffffu)), z3 = bf2f((bf16_t)(zz.y >> 16));
    float y0 = o[0][dv][0] * rs * sg.x * z0, y1 = o[0][dv][1] * rs * sg.y * z1;
    float y2 = o[0][dv][2] * rs * sg.z * z2, y3 = o[0][dv][3] * rs * sg.w * z3;
    if (dowrite) *(u32x2*)(P.proj + (size_t)qrow * PW + CQ + h * 128 + dcol) = u32x2_mk(pack2(y0, y1), pack2(y2, y3));
  }
}

DEV void phase_attn(const Params& P, int l, char* smem) {
  const int nattn = 2048 + (l < 3 ? 128 : 0);
  const int total = 160 + nattn;
  (void)total;
  for (int it = vb(); it < 160; it += vg()) carry_job(P, l, it);
#if PROBE_PH == 3
  { int flag = 0; asm volatile("" : "+s"(flag));
    for (int it = vg() - 1 - vb(); it < nattn; it += vg()) attn_item(P, l, it, smem, flag); }
#endif
  for (int it = vg() - 1 - vb(); it < nattn; it += vg()) attn_item(P, l, it, smem);
}


DEV void attn_item8(const Params& P, int l, int item, char* smem) {
  const int tid = tid512(), lane = tid & 63, wv = tid >> 6, r16 = lane & 15, g = lane >> 4;
  const int c = wv & 1, qg = wv >> 1;
  bf16_t* Ks = (bf16_t*)smem;
  bf16_t* Vs = Ks + 64 * 136;
  constexpr int BUFE = 64 * 136 + 128 * 72;
  float* X = (float*)(smem + SMEM_HALF);
  int b, h, qrow0, kt0, nkt;
  if (item < 1024) {
    b = item >> 7; h = (item >> 5) & 3;
    qrow0 = b * 4096 + (item & 31) * 128; kt0 = 0; nkt = 68;
  } else {
    int i2 = item - 1024;
    b = i2 >> 3; h = (i2 >> 1) & 3;
    qrow0 = NLAT + b * 256 + (i2 & 1) * 128; kt0 = 64; nkt = 4;
  }
  const int qrowb = qrow0 + qg * 32 + r16;
  bf16x8 qf[2][2];
#pragma unroll
  for (int qt = 0; qt < 2; ++qt)
#pragma unroll
    for (int kb = 0; kb < 2; ++kb)
      qf[qt][kb] = *(const bf16x8*)(P.proj + (size_t)(qrowb + qt * 16) * PW + CQ + h * 128 + c * 64 + kb * 32 + g * 8);
  f32x4 o[2][8];
#pragma unroll
  for (int qt = 0; qt < 2; ++qt)
#pragma unroll
    for (int dv = 0; dv < 8; ++dv) o[qt][dv] = f32x4{0.f, 0.f, 0.f, 0.f};
  float mrun[2] = {0.f, 0.f}, lsum[2] = {0.f, 0.f};
  const bf16_t* Vbase = P.Vt + (size_t)(b * 4 + h) * 128 * 4352;
  u32x4 rk[2], rv[2];
  auto gl = [&](int kt) {
    int krow0, vkey0;
    if (kt < 64) { krow0 = b * 4096 + kt * 64; vkey0 = kt * 64; }
    else { krow0 = NLAT + b * 256 + (kt - 64) * 64; vkey0 = 4096 + (kt - 64) * 64; }
#pragma unroll
    for (int i = 0; i < 2; ++i) {
      int cidx = tid + 512 * i;
      rk[i] = *(const u32x4*)(P.proj + (size_t)(krow0 + (cidx >> 4)) * PW + CK + h * 128 + (cidx & 15) * 8);
      rv[i] = *(const u32x4*)(Vbase + (size_t)(cidx >> 3) * 4352 + vkey0 + (cidx & 7) * 8);
    }
  };
  auto st = [&](int buf) {
    bf16_t* Kd = Ks + buf * BUFE;
    bf16_t* Vd = Vs + buf * BUFE;
#pragma unroll
    for (int i = 0; i < 2; ++i) {
      int cidx = tid + 512 * i;
      *(u32x4*)(Kd + (cidx >> 4) * 136 + (cidx & 15) * 8) = rk[i];
      *(u32x4*)(Vd + (cidx >> 3) * 72 + (cidx & 7) * 8) = rv[i];
    }
  };
  auto tile_compute = [&](const int CUR_, const bool FIRST_) {
    const bf16_t* Kc = Ks + CUR_ * BUFE;
    const bf16_t* Vc = Vs + CUR_ * BUFE;
    f32x4 s[2][4];
#pragma unroll
    for (int qt = 0; qt < 2; ++qt) {
      const float ninit = -mrun[qt];
#pragma unroll
      for (int kt = 0; kt < 4; ++kt) s[qt][kt] = f32x4{ninit, ninit, ninit, ninit};
    }
#pragma unroll
    for (int kt = 0; kt < 4; ++kt)
#pragma unroll
      for (int kb = 0; kb < 2; ++kb) {
        bf16x8 kf = *(const bf16x8*)(Kc + (kt * 16 + r16) * 136 + c * 64 + kb * 32 + g * 8);
        s[0][kt] = mfma16(kf, qf[0][kb], s[0][kt]);
        s[1][kt] = mfma16(kf, qf[1][kb], s[1][kt]);
      }
    bf16x8 pf[2][2];
#pragma unroll
    for (int qt = 0; qt < 2; ++qt) {
      float mx = fmaxf(fmaxf(s[qt][0][0], s[qt][0][1]), fmaxf(s[qt][0][2], s[qt][0][3]));
#pragma unroll
      for (int kt = 1; kt < 4; ++kt) mx = fmaxf(mx, fmaxf(fmaxf(s[qt][kt][0], s[qt][kt][1]), fmaxf(s[qt][kt][2], s[qt][kt][3])));
      const bool first = FIRST_;
      if (__any(first || mx > 8.f)) {
        mx = fmaxf(mx, shx(mx, 16, lane));
        mx = fmaxf(mx, shx(mx, 32, lane));
        const bool need = first || mx > 8.f;
        const float dm = need ? mx : 0.f;
        const float alpha = first ? 1.f : fexp2(-dm);
        mrun[qt] += dm;
        lsum[qt] *= alpha;
#pragma unroll
        for (int dv = 0; dv < 8; ++dv) o[qt][dv] = o[qt][dv] * alpha;
#pragma unroll
        for (int kt = 0; kt < 4; ++kt) s[qt][kt] = s[qt][kt] - dm;
      }
      float ps = 0.f;
#pragma unroll
      for (int kt = 0; kt < 4; ++kt)
#pragma unroll
        for (int j = 0; j < 4; ++j) { s[qt][kt][j] = fexp2(s[qt][kt][j]); ps += s[qt][kt][j]; }
      lsum[qt] += ps;
#pragma unroll
      for (int kb2 = 0; kb2 < 2; ++kb2) {
        u32x4 pk = u32x4_mk(pack2(s[qt][2 * kb2][0], s[qt][2 * kb2][1]), pack2(s[qt][2 * kb2][2], s[qt][2 * kb2][3]),
                            pack2(s[qt][2 * kb2 + 1][0], s[qt][2 * kb2 + 1][1]), pack2(s[qt][2 * kb2 + 1][2], s[qt][2 * kb2 + 1][3]));
        pf[qt][kb2] = as_bf16x8(pk);
      }
    }
    bf16x8 vfr[2][2][2];
    auto ldv = [&](int slot, int dvp) {
#pragma unroll
      for (int e = 0; e < 2; ++e)
#pragma unroll
        for (int kb2 = 0; kb2 < 2; ++kb2) {
          const bf16_t* vp = Vc + ((dvp * 2 + e) * 16 + r16) * 72 + kb2 * 32 + g * 4;
          u32x2 v0 = *(const u32x2*)vp, v1 = *(const u32x2*)(vp + 16);
          vfr[slot][e][kb2] = as_bf16x8(u32x4_mk(v0.x, v0.y, v1.x, v1.y));
        }
    };
    ldv(0, 0);
#pragma unroll
    for (int dvp = 0; dvp < 4; ++dvp) {
      if (dvp < 3) ldv((dvp + 1) & 1, dvp + 1);
      __builtin_amdgcn_sched_barrier(0);
#pragma unroll
      for (int e = 0; e < 2; ++e)
#pragma unroll
        for (int kb2 = 0; kb2 < 2; ++kb2) {
          o[0][dvp * 2 + e] = mfma16(vfr[dvp & 1][e][kb2], pf[0][kb2], o[0][dvp * 2 + e]);
          o[1][dvp * 2 + e] = mfma16(vfr[dvp & 1][e][kb2], pf[1][kb2], o[1][dvp * 2 + e]);
        }
      __builtin_amdgcn_sched_barrier(0);
    }
  };
  const int ktl = kt0 + nkt - 1;
  gl(kt0);
  __syncthreads();
  st(0);
  gl(kt0 + 1);
  st(1);
  gl(min(kt0 + 2, ktl));
  __syncthreads();
  for (int T = 0; 2 * T < nkt; ++T) {
    const int base = (T & 1) * 2, nbase = 2 - base;
    if (2 * T + 2 < nkt) st(nbase);
    gl(min(kt0 + 2 * T + 3, ktl));
    tile_compute(base, T == 0);
    if (2 * T + 3 < nkt) st(nbase + 1);
    gl(min(kt0 + 2 * T + 4, ktl));
    tile_compute(base + 1, false);
    __syncthreads();
  }
  const float lam = P.lamv[l];
#pragma unroll
  for (int qt = 0; qt < 2; ++qt) {
    float lq = lsum[qt];
    lq += shx(lq, 16, lane); lq += shx(lq, 32, lane);
    const float sc = (c == 0 ? 1.f : lam) / lq;
#pragma unroll
    for (int dv = 0; dv < 8; ++dv) o[qt][dv] = o[qt][dv] * sc;
  }
  if (c == 1) {
#pragma unroll
    for (int qt = 0; qt < 2; ++qt)
#pragma unroll
      for (int dv = 0; dv < 8; ++dv)
        *(f32x4*)(X + (size_t)((qg * 2 + qt) * 16 + r16) * 128 + dv * 16 + g * 4) = o[qt][dv];
  }
  __syncthreads();
  if (c == 0) {
    const float lam_init = 0.8f - 0.6f * expf(-0.3f * (float)l);
#pragma unroll
    for (int qt = 0; qt < 2; ++qt) {
      float ss = 0.f;
#pragma unroll
      for (int dv = 0; dv < 8; ++dv) {
        f32x4 o1 = *(const f32x4*)(X + (size_t)((qg * 2 + qt) * 16 + r16) * 128 + dv * 16 + g * 4);
        f32x4 v = o[qt][dv] - o1;
        o[qt][dv] = v;
        ss += v[0] * v[0] + v[1] * v[1] + v[2] * v[2] + v[3] * v[3];
      }
      ss += shx(ss, 16, lane); ss += shx(ss, 32, lane);
      const float rs = rsqrtf(ss * (1.f / 128.f) + 1e-6f) * (1.f - lam_init);
      const int qrow = qrowb + qt * 16;
#pragma unroll
      for (int dv = 0; dv < 8; ++dv) {
        const int dcol = dv * 16 + g * 4;
        float4 sg = *(const float4*)(P.subln_g + l * 128 + dcol);
        u32x2 zz = *(const u32x2*)(P.proj + (size_t)qrow * PW + CZA + h * 128 + dcol);
        float z0 = bf2f((bf16_t)(zz.x & 0xffffu)), z1 = bf2f((bf16_t)(zz.x >> 16));
        float z2 = bf2f((bf16_t)(zz.y & 0xffffu)), z3 = bf2f((bf16_t)(zz.y >> 16));
        float y0 = o[qt][dv][0] * rs * sg.x * z0, y1 = o[qt][dv][1] * rs * sg.y * z1;
        float y2 = o[qt][dv][2] * rs * sg.z * z2, y3 = o[qt][dv][3] * rs * sg.w * z3;
        *(u32x2*)(P.proj + (size_t)qrow * PW + CQ + h * 128 + dcol) = u32x2_mk(pack2(y0, y1), pack2(y2, y3));
      }
    }
  }
  __syncthreads();
}

DEV void phase_attn8(const Params& P, int l, char* smem_all) {
  const int nattn = 1024 + (l < 3 ? 64 : 0);
  for (int it = vb(); it < 160; it += vg()) carry_job(P, l, it);
  if (gridDim.x == 256) {
    const int xcd = (int)blockIdx.x & 7, slot = (int)blockIdx.x >> 3;
#pragma unroll 1
    for (int k = 0; k < 4; ++k) attn_item8(P, l, (k * 8 + xcd) * 32 + slot, smem_all);
    if (nattn > 1024 && (int)blockIdx.x >= 192) attn_item8(P, l, 1024 + 255 - (int)blockIdx.x, smem_all);
  } else {
    for (int it = (int)gridDim.x - 1 - (int)blockIdx.x; it < nattn; it += (int)gridDim.x) attn_item8(P, l, it, smem_all);
  }
}

DEV void phase_glu(const Params& P, int l, char* smem) {
  const int tid_ = tidx(); const int lane = tid_ & 63, w = tid_ >> 6;
  const int wm = w & 1, wn = w >> 1, r16 = lane & 15, g = lane >> 4;
  const bf16_t* Wl = P.WgT + (size_t)l * 512 * 512;
  for (int tile = vb(); tile < 16 * 16; tile += vg()) {
    const int m0 = (256 + (tile >> 4)) * 128, n0 = (tile & 15) * 32;
    f32x4 acc[4][1];
    zero_acc<1>(acc);
    gemm_main<32>(acc, P.proj + (size_t)m0 * PW + CUS, PW, Wl + (size_t)n0 * 512, 512, 512, smem);
#pragma unroll
    for (int mt = 0; mt < 4; ++mt) {
      const int m = m0 + wm * 64 + mt * 16 + r16;
#pragma unroll
      for (int nt = 0; nt < 1; ++nt) {
        const int n = n0 + wn * 16 + nt * 16 + g * 4;
        float4 bg = *(const float4*)(P.s5_b_glu + l * 512 + n);
        u32x2 gg = *(const u32x2*)(P.proj + (size_t)m * PW + CUS + n);
        u32x2 zz = *(const u32x2*)(P.proj + (size_t)m * PW + CZS + n);
        float y0 = bf2f((bf16_t)(gg.x & 0xffffu)) * sigmoidf_(acc[mt][nt][0] + bg.x) * bf2f((bf16_t)(zz.x & 0xffffu));
        float y1 = bf2f((bf16_t)(gg.x >> 16)) * sigmoidf_(acc[mt][nt][1] + bg.y) * bf2f((bf16_t)(zz.x >> 16));
        float y2 = bf2f((bf16_t)(gg.y & 0xffffu)) * sigmoidf_(acc[mt][nt][2] + bg.z) * bf2f((bf16_t)(zz.y & 0xffffu));
        float y3 = bf2f((bf16_t)(gg.y >> 16)) * sigmoidf_(acc[mt][nt][3] + bg.w) * bf2f((bf16_t)(zz.y >> 16));
        *(u32x2*)(P.proj + (size_t)m * PW + CZS + n) = u32x2_mk(pack2(y0, y1), pack2(y2, y3));
      }
    }
  }
}

DEV void phase_merge(const Params& P, int l, char* smem) {
  const int tid_ = tidx(); const int lane = tid_ & 63, w = tid_ >> 6;
  const int wm = w & 1, wn = w >> 1, r16 = lane & 15, g = lane >> 4;
  const bf16_t* Wl = P.WinT + (size_t)l * 7168 * 1024;
  for (int tile = vb(); tile < 16 * 32; tile += vg()) {
    const int m0 = (256 + (tile >> 5)) * 128, n0 = (tile & 31) * 32;
    f32x4 accM[4][1];
    zero_acc<1>(accM);
#pragma unroll 1
    for (int nb = 0; nb < 3; ++nb) {
      f32x4 accG[4][1], accY[4][1];
      zero_acc<1>(accG);
      zero_acc<1>(accY);
      gemm_main<32>(accG, P.hbuf + (size_t)m0 * 1024, 1024, Wl + (size_t)(4096 + nb * 1024 + n0) * 1024, 1024, 1024, smem);
      const int cofs = nb == 0 ? CQ : (nb == 1 ? CZR : CZS);
      gemm_main<32>(accY, P.proj + (size_t)m0 * PW + cofs, PW, P.WbT + ((size_t)(l * 3 + nb) * 1024 + n0) * 512, 512, 512, smem);
#pragma unroll
      for (int mt = 0; mt < 4; ++mt)
#pragma unroll
        for (int nt = 0; nt < 1; ++nt)
#pragma unroll
          for (int j = 0; j < 4; ++j) accM[mt][nt][j] += sigmoidf_(accG[mt][nt][j]) * accY[mt][nt][j];
    }
#pragma unroll
    for (int mt = 0; mt < 4; ++mt) {
      const int m = m0 + wm * 64 + mt * 16 + r16;
#pragma unroll
      for (int nt = 0; nt < 1; ++nt) {
        const int n = n0 + wn * 16 + nt * 16 + g * 4;
        f32x4 v = accM[mt][nt];
        *(u32x2*)(P.proj + (size_t)m * PW + CM + n) = u32x2_mk(pack2(v[0], v[1]), pack2(v[2], v[3]));
      }
    }
  }
}

DEV void phase_out(const Params& P, int l, char* smem) {
  const int tid_ = tidx(); const int lane = tid_ & 63, w = tid_ >> 6;
  const int wm = w & 1, wn = w >> 1, r16 = lane & 15, g = lane >> 4;
  const bf16_t* Wl = P.WoT + (size_t)l * 1024 * 1024;
  for (int tile = vb(); tile < 16 * 32; tile += vg()) {
    const int m0 = (256 + (tile >> 5)) * 128, n0 = (tile & 31) * 32;
    f32x4 acc[4][1];
    zero_acc<1>(acc);
    gemm_main<32>(acc, P.proj + (size_t)m0 * PW + CM, PW, Wl + (size_t)n0 * 1024, 1024, 1024, smem);
#pragma unroll
    for (int mt = 0; mt < 4; ++mt) {
      const int m = m0 + wm * 64 + mt * 16 + r16;
      const float* src;
      float* dst;
      if (m < NLAT) { src = (l == 0 ? P.x : P.out) + (size_t)m * 1024; dst = P.out + (size_t)m * 1024; }
      else { src = (l == 0 ? P.ctx : P.ctxres) + (size_t)(m - NLAT) * 1024; dst = P.ctxres + (size_t)(m - NLAT) * 1024; }
      const float* gt = P.mods + (size_t)(l * 9 + mod_row(m)) * 3072 + 2048;
#pragma unroll
      for (int nt = 0; nt < 1; ++nt) {
        const int n = n0 + wn * 16 + nt * 16 + g * 4;
        float4 xo = *(const float4*)(src + n);
        float4 gg = *(const float4*)(gt + n);
        float4 r;
        r.x = xo.x + gg.x * acc[mt][nt][0];
        r.y = xo.y + gg.y * acc[mt][nt][1];
        r.z = xo.z + gg.z * acc[mt][nt][2];
        r.w = xo.w + gg.w * acc[mt][nt][3];
        *(float4*)(dst + n) = r;
      }
    }
  }
}

DEV void phase_final(const Params& P) {
  const int tid_ = tidx(); const int lane = tid_ & 63, w = tid_ >> 6;
  const int stride = vg() * 4;
  int r = vb() * 4 + w;
  float4 v[4], vn[4];
  if (r < NLAT) {
#pragma unroll
    for (int i = 0; i < 4; ++i) v[i] = *(const float4*)(P.out + (size_t)r * 1024 + i * 256 + lane * 4);
  }
  for (; r < NLAT; r += stride) {
    const int rn = r + stride;
    if (rn < NLAT) {
#pragma unroll
      for (int i = 0; i < 4; ++i) vn[i] = *(const float4*)(P.out + (size_t)rn * 1024 + i * 256 + lane * 4);
    }
    float* src = P.out + (size_t)r * 1024;
    float ss = 0.f;
#pragma unroll
    for (int i = 0; i < 4; ++i) ss += v[i].x * v[i].x + v[i].y * v[i].y + v[i].z * v[i].z + v[i].w * v[i].w;
#pragma unroll
    for (int o = 32; o > 0; o >>= 1) ss += __shfl_xor(ss, o);
    float rstd = rsqrtf(ss * (1.f / 1024.f) + 1e-6f);
#pragma unroll
    for (int i = 0; i < 4; ++i) {
      int k = i * 256 + lane * 4;
      float4 g4 = *(const float4*)(P.final_g + k);
      float4 r4;
      r4.x = v[i].x * rstd * g4.x; r4.y = v[i].y * rstd * g4.y; r4.z = v[i].z * rstd * g4.z; r4.w = v[i].w * rstd * g4.w;
      *(float4*)(src + k) = r4;
    }
#pragma unroll
    for (int i = 0; i < 4; ++i) v[i] = vn[i];
  }
}

namespace pg8 {
#define PG8_LAS __attribute__((address_space(3)))
constexpr int BM = 256, BK = 64, HALF = 128, HTB = HALF * BK * 2, NXCD = 8, WGM = 8;
DEV int lds_byte(int r, int c) { const int st = (r >> 4) * 2 + (c >> 5), rr = r & 15, cc = c & 31, ob = rr * 64 + cc * 2; return st * 1024 + (ob ^ (((ob >> 9) & 1) << 5)); }
DEV void stage_rc(int b, int& R, int& C) { const int st = b / 1024, sb = b % 1024, swz = sb ^ (((sb >> 9) & 1) << 5); R = (st >> 1) * 16 + swz / 64; C = (st & 1) * 32 + (swz % 64) / 2; }
DEV int perm32(int rho) { const int n = rho >> 4, i = rho & 15; return 8 * (i >> 2) + 4 * n + (i & 3); }
struct Unit { int pm, pn; };
struct Gemm { const bf16_t* A; const bf16_t* Bt; int M, N, K, lda; };
struct StaticOrder {
  int nM, nN, nwg, G, c;
  DEV void init(int M, int N, int G_, int c_) { nM = M / BM; nN = N / BM; nwg = nM * nN; G = G_; c = c_; }
  DEV bool next(int i, Unit& u) const {
    const long L = (long)i * G + c; if (L >= nwg) return false;
    int wgid = (int)L; { const int q = nwg / NXCD, r = nwg % NXCD, xcd = wgid % NXCD, off = wgid / NXCD; wgid = (xcd < r ? xcd * (q + 1) : r * (q + 1) + (xcd - r) * q) + off; }
    const int nig = WGM * nN, gid = wgid / nig, fm = gid * WGM, gsz = (nM - fm) < WGM ? (nM - fm) : WGM;
    u.pm = fm + ((wgid % nig) % gsz); u.pn = (wgid % nig) / gsz; return true;
  }
};
template <class Epi>
DEV void gemm_phase(PG8_LAS unsigned char* lds, const Gemm g, const StaticOrder& S, const Epi& E) {
  const int tid = tid512(), wid = __builtin_amdgcn_readfirstlane(tid >> 6), lane = tid & 63, wr = wid >> 2, wc = wid & 3, fr = lane & 15, fq = lane >> 4;
  const int K = g.K, nt = K / BK, lda = g.lda;
  unsigned voffA[2], voffB[2];
#pragma unroll
  for (int i = 0; i < 2; ++i) { int R, C; stage_rc(tid * 16 + i * 8192, R, C);
    const int Rb = (R & ~31) + perm32(R & 31);
    voffA[i] = (unsigned)(R * lda + C) * 2u; voffB[i] = (unsigned)(Rb * K + C) * 2u; }
  const size_t kstep = (size_t)(BK * 2);
  const size_t hstepA = (size_t)HALF * lda * 2, hstepB = (size_t)HALF * K * 2;
  const size_t tstepA = 2 * hstepA, tstepB = 2 * hstepB;
  const unsigned ldsw = (unsigned)wid * 1024u;
  const int aoff = lds_byte(wr * 64 + fr, fq * 8), boff = lds_byte(wc * 32 + fr, fq * 8);
#define PG8_SA(b, h) (((b) * 2 + (h)) * HTB)
#define PG8_SB(b, h) ((4 + (b) * 2 + (h)) * HTB)
#define PG8_STAGE(bufoff, gbase, voff) do { _Pragma("unroll") for (int _i = 0; _i < 2; ++_i) \
    __builtin_amdgcn_global_load_lds((const unsigned*)((const char*)(gbase) + (voff)[_i]), (PG8_LAS unsigned*)(lds + (bufoff) + ldsw + _i * 8192), 16, 0, 0); } while (0)
#define PG8_LDA(dst, b, h) do { _Pragma("unroll") for (int m = 0; m < 4; ++m) _Pragma("unroll") for (int k = 0; k < 2; ++k) dst[m][k] = *(const PG8_LAS bf16x8*)(lds + PG8_SA(b, h) + aoff + m * 2048 + k * 1024); } while (0)
#define PG8_LDB(dst, b, h) do { _Pragma("unroll") for (int n = 0; n < 2; ++n) _Pragma("unroll") for (int k = 0; k < 2; ++k) dst[n][k] = *(const PG8_LAS bf16x8*)(lds + PG8_SB(b, h) + boff + n * 2048 + k * 1024); } while (0)
#define PG8_MMA(ai, bj, At, Bt) do { __builtin_amdgcn_s_setprio(1); _Pragma("unroll") for (int m = 0; m < 4; ++m) _Pragma("unroll") for (int n = 0; n < 2; ++n) _Pragma("unroll") for (int k = 0; k < 2; ++k) \
    acc[ai][bj][m][n] = __builtin_amdgcn_mfma_f32_16x16x32_bf16(Bt[n][k], At[m][k], acc[ai][bj][m][n], 0, 0, 0); __builtin_amdgcn_s_setprio(0); } while (0)
#define PG8_WAIT_V(n) asm volatile("s_waitcnt vmcnt(" #n ")" ::: "memory")
#define PG8_WAIT_L(n) asm volatile("s_waitcnt lgkmcnt(" #n ")" ::: "memory")
#define PG8_BAR __builtin_amdgcn_s_barrier()
#define PG8_SCHED __builtin_amdgcn_sched_barrier(0)
  Unit cur, nxt; int ui = 0;
  if (!S.next(0, cur)) return;
  f32x4 acc[2][2][4][2];
#pragma unroll
  for (int a = 0; a < 2; ++a)
#pragma unroll
    for (int b = 0; b < 2; ++b)
#pragma unroll
      for (int m = 0; m < 4; ++m)
#pragma unroll
        for (int n = 0; n < 2; ++n) acc[a][b][m][n] = f32x4{0.f, 0.f, 0.f, 0.f};
  bf16x8 At[4][2], B0[2][2], B1[2][2];
  const char* cA = (const char*)g.A + (size_t)cur.pm * tstepA; const char* cB = (const char*)g.Bt + (size_t)cur.pn * tstepB;
  PG8_STAGE(PG8_SB(0, 0), cB, voffB); PG8_STAGE(PG8_SA(0, 0), cA, voffA); PG8_STAGE(PG8_SB(0, 1), cB + hstepB, voffB); PG8_STAGE(PG8_SA(0, 1), cA + hstepA, voffA);
  if (wr == 1) PG8_BAR;
  PG8_WAIT_V(4); PG8_BAR;
  PG8_STAGE(PG8_SB(1, 0), cB + kstep, voffB); PG8_STAGE(PG8_SA(1, 0), cA + kstep, voffA); PG8_STAGE(PG8_SB(1, 1), cB + hstepB + kstep, voffB);
  PG8_WAIT_V(6); PG8_BAR;
  for (;;) {
    const bool has_next = S.next(ui + 1, nxt);
    const char* nA = has_next ? (const char*)g.A + (size_t)nxt.pm * tstepA : cA; const char* nB = has_next ? (const char*)g.Bt + (size_t)nxt.pn * tstepB : cB;
    for (int t = 0; t < nt; t += 2) {
      const bool last = (t == nt - 2);
      const char* a1 = cA + (size_t)(t + 1) * kstep;
      const char* a2 = last ? nA : cA + (size_t)(t + 2) * kstep; const char* b2 = last ? nB : cB + (size_t)(t + 2) * kstep;
      const char* a3 = a2 + kstep; const char* b3 = b2 + kstep;
      PG8_LDB(B0, 0, 0); PG8_SCHED; PG8_LDA(At, 0, 0); PG8_STAGE(PG8_SA(1, 1), a1 + hstepA, voffA);
      PG8_WAIT_L(8); PG8_BAR; PG8_WAIT_L(0); PG8_MMA(0, 0, At, B0); PG8_BAR; PG8_SCHED;
      PG8_LDB(B1, 0, 1); PG8_STAGE(PG8_SB(0, 0), b2, voffB);
      PG8_BAR; PG8_WAIT_L(0); PG8_MMA(0, 1, At, B1); PG8_BAR;
      PG8_LDA(At, 0, 1); PG8_STAGE(PG8_SA(0, 0), a2, voffA);
      PG8_BAR; PG8_WAIT_L(0); PG8_MMA(1, 0, At, B0); PG8_BAR; PG8_SCHED;
      PG8_STAGE(PG8_SB(0, 1), b2 + hstepB, voffB);
      PG8_WAIT_V(6); PG8_BAR; PG8_MMA(1, 1, At, B1); PG8_BAR;
      PG8_LDB(B0, 1, 0); PG8_SCHED; PG8_LDA(At, 1, 0); PG8_STAGE(PG8_SA(0, 1), a2 + hstepA, voffA);
      PG8_WAIT_L(8); PG8_BAR; PG8_WAIT_L(0); PG8_MMA(0, 0, At, B0); PG8_BAR; PG8_SCHED;
      PG8_LDB(B1, 1, 1); PG8_STAGE(PG8_SB(1, 0), b3, voffB);
      PG8_BAR; PG8_WAIT_L(0); PG8_MMA(0, 1, At, B1); PG8_BAR;
      PG8_LDA(At, 1, 1); PG8_STAGE(PG8_SA(1, 0), a3, voffA);
      PG8_BAR; PG8_WAIT_L(0); PG8_MMA(1, 0, At, B0); PG8_BAR; PG8_SCHED;
      PG8_STAGE(PG8_SB(1, 1), b3 + hstepB, voffB);
      PG8_WAIT_V(6); PG8_BAR; PG8_MMA(1, 1, At, B1); PG8_BAR;
    }
    E(acc, cur, wr, wc, fr, fq);
    if (!has_next) break;
#pragma unroll
    for (int a = 0; a < 2; ++a)
#pragma unroll
      for (int b = 0; b < 2; ++b)
#pragma unroll
        for (int m = 0; m < 4; ++m)
#pragma unroll
          for (int n = 0; n < 2; ++n) acc[a][b][m][n] = f32x4{0.f, 0.f, 0.f, 0.f};
    cur = nxt; cA = nA; cB = nB; ++ui;
  }
  PG8_WAIT_V(0);
  if (wr == 0) PG8_BAR;
  PG8_BAR;
#undef PG8_SA
#undef PG8_SB
#undef PG8_STAGE
#undef PG8_LDA
#undef PG8_LDB
#undef PG8_MMA
#undef PG8_WAIT_V
#undef PG8_WAIT_L
#undef PG8_BAR
#undef PG8_SCHED
}
}

DEV u32x4 pack8(const f32x4& v0, const f32x4& v1) { return u32x4_mk(pack2(v0[0], v0[1]), pack2(v0[2], v0[3]), pack2(v1[0], v1[1]), pack2(v1[2], v1[3])); }
DEV float bflo(unsigned w) { return __uint_as_float(w << 16); }
DEV float bfhi(unsigned w) { return __uint_as_float(w & 0xffff0000u); }
struct EpiProj {
  const Params* Pp; int l;
  DEV void operator()(const f32x4 (&acc)[2][2][4][2], const pg8::Unit& u, int wr, int wc, int fr, int fq) const {
    const Params& P = *Pp;
    const float QS = 0.125f * 1.4426950408889634f;
#pragma unroll
    for (int ai = 0; ai < 2; ++ai)
#pragma unroll
      for (int mm = 0; mm < 4; ++mm) {
        const int m = u.pm * 256 + ai * 128 + wr * 64 + mm * 16 + fr;
#pragma unroll
        for (int bj = 0; bj < 2; ++bj) {
          const int region = (u.pn * 256 + bj * 128) >> 9;
          const int n8 = u.pn * 256 + bj * 128 + wc * 32 + 8 * fq;
          f32x4 v0 = acc[ai][bj][mm][0], v1 = acc[ai][bj][mm][1];
          if (region <= 1) {
            if (m < NLAT) {
              const int t = m & 4095;
              const int i0 = (n8 & 63) >> 1;
              const float4 c0 = *(const float4*)(P.rope + (size_t)t * 32 + i0);
              const float4 c1 = *(const float4*)(P.rope + (size_t)t * 32 + i0 + 2);
              v0 = f32x4{v0[0] * c0.x - v0[1] * c0.y, v0[0] * c0.y + v0[1] * c0.x, v0[2] * c0.z - v0[3] * c0.w, v0[2] * c0.w + v0[3] * c0.z};
              v1 = f32x4{v1[0] * c1.x - v1[1] * c1.y, v1[0] * c1.y + v1[1] * c1.x, v1[2] * c1.z - v1[3] * c1.w, v1[2] * c1.w + v1[3] * c1.z};
            }
            if (region == 0) { v0 = v0 * QS; v1 = v1 * QS; }
            *(u32x4*)(P.proj + (size_t)m * PW + n8) = pack8(v0, v1);
          } else if (region == 2) {
            int b, key;
            if (m < NLAT) { b = m >> 12; key = m & 4095; }
            else { b = (m - NLAT) >> 8; key = 4096 + ((m - NLAT) & 255); }
            bf16_t* vp = P.Vt + ((size_t)b * 512 + (n8 - 1024)) * 4352 + key;
#pragma unroll
            for (int j = 0; j < 4; ++j) { vp[(size_t)j * 4352] = f2bf(v0[j]); vp[(size_t)(4 + j) * 4352] = f2bf(v1[j]); }
          } else {
            if (region == 3 || region == 5 || region == 7) {
#pragma unroll
              for (int j = 0; j < 4; ++j) { v0[j] = siluf_(v0[j]); v1[j] = siluf_(v1[j]); }
            }
            *(u32x4*)(P.proj + (size_t)m * PW + n8) = pack8(v0, v1);
          }
        }
      }
  }
};
struct EpiGlu {
  const Params* Pp; int l;
  DEV void operator()(const f32x4 (&acc)[2][2][4][2], const pg8::Unit& u, int wr, int wc, int fr, int fq) const {
    const Params& P = *Pp;
#pragma unroll
    for (int ai = 0; ai < 2; ++ai)
#pragma unroll
      for (int mm = 0; mm < 4; ++mm) {
        const int m = u.pm * 256 + ai * 128 + wr * 64 + mm * 16 + fr;
#pragma unroll
        for (int bj = 0; bj < 2; ++bj) {
          const int n8 = u.pn * 256 + bj * 128 + wc * 32 + 8 * fq;
          const f32x4 a0 = acc[ai][bj][mm][0], a1 = acc[ai][bj][mm][1];
          const float4 b0 = *(const float4*)(P.s5_b_glu + l * 512 + n8), b1 = *(const float4*)(P.s5_b_glu + l * 512 + n8 + 4);
          const u32x4 gg = *(const u32x4*)(P.proj + (size_t)m * PW + CUS + n8);
          const u32x4 zz = *(const u32x4*)(P.proj + (size_t)m * PW + CZS + n8);
          f32x4 y0, y1;
          y0[0] = bflo(gg.x) * sigmoidf_(a0[0] + b0.x) * bflo(zz.x); y0[1] = bfhi(gg.x) * sigmoidf_(a0[1] + b0.y) * bfhi(zz.x);
          y0[2] = bflo(gg.y) * sigmoidf_(a0[2] + b0.z) * bflo(zz.y); y0[3] = bfhi(gg.y) * sigmoidf_(a0[3] + b0.w) * bfhi(zz.y);
          y1[0] = bflo(gg.z) * sigmoidf_(a1[0] + b1.x) * bflo(zz.z); y1[1] = bfhi(gg.z) * sigmoidf_(a1[1] + b1.y) * bfhi(zz.z);
          y1[2] = bflo(gg.w) * sigmoidf_(a1[2] + b1.z) * bflo(zz.w); y1[3] = bfhi(gg.w) * sigmoidf_(a1[3] + b1.w) * bfhi(zz.w);
          *(u32x4*)(P.proj + (size_t)m * PW + CZS + n8) = pack8(y0, y1);
        }
      }
  }
};
struct EpiOut {
  const Params* Pp; int l;
  DEV void operator()(const f32x4 (&acc)[2][2][4][2], const pg8::Unit& u, int wr, int wc, int fr, int fq) const {
    const Params& P = *Pp;
#pragma unroll
    for (int ai = 0; ai < 2; ++ai)
#pragma unroll
      for (int mm = 0; mm < 4; ++mm) {
        const int m = u.pm * 256 + ai * 128 + wr * 64 + mm * 16 + fr;
        const float* src;
        float* dst;
        if (m < NLAT) { src = (l == 0 ? P.x : P.out) + (size_t)m * 1024; dst = P.out + (size_t)m * 1024; }
        else { src = (l == 0 ? P.ctx : P.ctxres) + (size_t)(m - NLAT) * 1024; dst = P.ctxres + (size_t)(m - NLAT) * 1024; }
        const float* gt = P.mods + (size_t)(l * 9 + mod_row(m)) * 3072 + 2048;
#pragma unroll
        for (int bj = 0; bj < 2; ++bj) {
          const int n8 = u.pn * 256 + bj * 128 + wc * 32 + 8 * fq;
#pragma unroll
          for (int nn = 0; nn < 2; ++nn) {
            const f32x4 a = acc[ai][bj][mm][nn];
            const int n = n8 + 4 * nn;
            float4 xo = *(const float4*)(src + n);
            float4 gg = *(const float4*)(gt + n);
            float4 r;
            r.x = xo.x + gg.x * a[0];
            r.y = xo.y + gg.y * a[1];
            r.z = xo.z + gg.z * a[2];
            r.w = xo.w + gg.w * a[3];
            *(float4*)(dst + n) = r;
          }
        }
      }
  }
};
struct EpiYB {
  const Params* Pp; int l;
  DEV void operator()(const f32x4 (&acc)[2][2][4][2], const pg8::Unit& u, int wr, int wc, int fr, int fq) const {
    const Params& P = *Pp;
#pragma unroll
    for (int ai = 0; ai < 2; ++ai)
#pragma unroll
      for (int mm = 0; mm < 4; ++mm) {
        const int m = u.pm * 256 + ai * 128 + wr * 64 + mm * 16 + fr;
#pragma unroll
        for (int bj = 0; bj < 2; ++bj) {
          const int n8 = u.pn * 256 + bj * 128 + wc * 32 + 8 * fq;
          *(u32x4*)(P.proj + (size_t)m * PW + CZA + n8) = pack8(acc[ai][bj][mm][0], acc[ai][bj][mm][1]);
        }
      }
  }
};
struct EpiGate {
  const Params* Pp; int nb;
  DEV void operator()(const f32x4 (&acc)[2][2][4][2], const pg8::Unit& u, int wr, int wc, int fr, int fq) const {
    const Params& P = *Pp;
#pragma unroll
    for (int ai = 0; ai < 2; ++ai)
#pragma unroll
      for (int mm = 0; mm < 4; ++mm) {
        const int m = u.pm * 256 + ai * 128 + wr * 64 + mm * 16 + fr;
#pragma unroll
        for (int bj = 0; bj < 2; ++bj) {
          const int n8 = u.pn * 256 + bj * 128 + wc * 32 + 8 * fq;
          const f32x4 a0 = acc[ai][bj][mm][0], a1 = acc[ai][bj][mm][1];
          const u32x4 yb = *(const u32x4*)(P.proj + (size_t)m * PW + CZA + n8);
          f32x4 v0, v1;
          v0[0] = sigmoidf_(a0[0]) * bflo(yb.x); v0[1] = sigmoidf_(a0[1]) * bfhi(yb.x);
          v0[2] = sigmoidf_(a0[2]) * bflo(yb.y); v0[3] = sigmoidf_(a0[3]) * bfhi(yb.y);
          v1[0] = sigmoidf_(a1[0]) * bflo(yb.z); v1[1] = sigmoidf_(a1[1]) * bfhi(yb.z);
          v1[2] = sigmoidf_(a1[2]) * bflo(yb.w); v1[3] = sigmoidf_(a1[3]) * bfhi(yb.w);
          if (nb > 0) {
            const u32x4 pv = *(const u32x4*)(P.proj + (size_t)m * PW + CM + n8);
            v0[0] += bflo(pv.x); v0[1] += bfhi(pv.x); v0[2] += bflo(pv.y); v0[3] += bfhi(pv.y);
            v1[0] += bflo(pv.z); v1[1] += bfhi(pv.z); v1[2] += bflo(pv.w); v1[3] += bfhi(pv.w);
          }
          *(u32x4*)(P.proj + (size_t)m * PW + CM + n8) = pack8(v0, v1);
        }
      }
  }
};
template <class Epi>
DEV void engine_gemm_e(const Epi& E, char* smem, const bf16_t* A, int lda, const bf16_t* Bt, int M, int N, int K) {
  pg8::Gemm g{A, Bt, M, N, K, lda};
  pg8::StaticOrder S;
  S.init(M, N, (int)gridDim.x, (int)blockIdx.x);
  pg8::gemm_phase<Epi>((PG8_LAS unsigned char*)smem, g, S, E);
}
template <class Epi>
DEV void engine_gemm(const Params& P, int l, char* smem, const bf16_t* A, int lda, const bf16_t* Bt, int M, int N, int K) {
  Epi E{&P, l};
  engine_gemm_e<Epi>(E, smem, A, lda, Bt, M, N, K);
}
DEV void engine_merge(const Params& P, int l, char* smem, int M) {
#pragma unroll 1
  for (int nb = 0; nb < 3; ++nb) {
    const int cofs = nb == 0 ? CQ : (nb == 1 ? CZR : CZS);
    EpiYB ey{&P, l};
    engine_gemm_e<EpiYB>(ey, smem, P.proj + cofs, PW, P.WbT + (size_t)(l * 3 + nb) * 1024 * 512, M, 1024, 512);
    EpiGate eg{&P, nb};
    engine_gemm_e<EpiGate>(eg, smem, P.hbuf, 1024, P.WinT + ((size_t)l * 7168 + 4096 + nb * 1024) * 1024, M, 1024, 1024);
  }
}

#define XB_TMO      128
#define XB_XCNT(j)  (256  + 64 * (j))
#define XB_XSUB(j)  (1280 + 64 * (j))
#define XB_XGEN(j)  (2304 + 64 * (j))
#define XB_TOP      3328
#define XB_TOPGEN   3392
#define XCD_BAR_WORDS 3456
#define XB_SPIN_CAP (1u << 18)
#define LAS __attribute__((address_space(3)))

__device__ __forceinline__ unsigned xb_ld(unsigned* p)              { return __hip_atomic_load(p, __ATOMIC_RELAXED, __HIP_MEMORY_SCOPE_AGENT); }
__device__ __forceinline__ unsigned xb_add(unsigned* p, unsigned v) { return __hip_atomic_fetch_add(p, v, __ATOMIC_RELAXED, __HIP_MEMORY_SCOPE_AGENT); }
__device__ __forceinline__ unsigned xb_xcc_id() { return (unsigned)__builtin_amdgcn_s_getreg((3 << 11) | 20) & 0xFu; }
#define XB_SPIN(cond, bar) do { unsigned _sp = 0; while (cond) { __builtin_amdgcn_s_sleep(1); \
    if ((++_sp & 255u) == 0u) { if (xb_ld(&(bar)[XB_TMO])) break; if (_sp > XB_SPIN_CAP) { atomicAdd(&(bar)[XB_TMO], 1u); break; } } } } while (0)

struct XcdBarrier {
    unsigned* bar; unsigned x;
    volatile LAS unsigned* st;
};

__device__ __forceinline__ XcdBarrier xcd_barrier_post(unsigned* bar, volatile LAS unsigned* st) {
    XcdBarrier b; b.bar = bar; b.x = xb_xcc_id(); b.st = st;
    if (threadIdx.x == 0) (void)xb_add(&bar[XB_XCNT(b.x)], 1u);
    return b;
}
__device__ __forceinline__ void xcd_barrier_complete(unsigned* bar, unsigned x, unsigned& nloc, unsigned& nx) {
    const unsigned G = gridDim.x * gridDim.y * gridDim.z;
    unsigned sum, cnt, mine, sp = 0u;
    for (;;) {
        sum = 0u; cnt = 0u; mine = 0u;
#pragma unroll
        for (unsigned j = 0; j < 16; ++j) { const unsigned c = xb_ld(&bar[XB_XCNT(j)]); sum += c; cnt += (c > 0u) ? 1u : 0u; mine = (j == x) ? c : mine; }
        if (sum == G) break;
        __builtin_amdgcn_s_sleep(1);
        if ((++sp & 255u) == 0u) { if (xb_ld(&bar[XB_TMO])) break; if (sp > XB_SPIN_CAP) { atomicAdd(&bar[XB_TMO], 1u); break; } }
    }
    nloc = mine > 0u ? mine : 1u; nx = cnt > 0u ? cnt : 1u;
}

__device__ __forceinline__ void xcd_barrier(const XcdBarrier& b) {
    asm volatile("s_waitcnt vmcnt(0)" ::: "memory");
    __syncthreads();
    if (threadIdx.x == 0) {
        unsigned* bar = b.bar;
        __builtin_amdgcn_s_waitcnt(0);
        unsigned nloc = b.st[0], nx = b.st[1];
        if (nloc == 0u) { xcd_barrier_complete(bar, b.x, nloc, nx); b.st[0] = nloc; b.st[1] = nx; }
        const unsigned old = xb_add(&bar[XB_XSUB(b.x)], 1u);
        const unsigned gen = old / nloc;
        if (old + 1u == (gen + 1u) * nloc) {
            __builtin_amdgcn_fence(__ATOMIC_RELEASE, "agent");
            asm volatile("s_waitcnt vmcnt(0)" ::: "memory");
            const unsigned og = xb_add(&bar[XB_TOP], 1u);
            const unsigned tg = og / nx;
            if (og + 1u == (tg + 1u) * nx) xb_add(&bar[XB_TOPGEN], 1u);
            else XB_SPIN(xb_ld(&bar[XB_TOPGEN]) == tg, bar);
            __builtin_amdgcn_fence(__ATOMIC_ACQUIRE, "agent");
            xb_add(&bar[XB_XGEN(b.x)], 1u);
            asm volatile("s_waitcnt vmcnt(0)" ::: "memory");
        } else {
            XB_SPIN(xb_ld(&bar[XB_XGEN(b.x)]) == gen, bar);
            __builtin_amdgcn_fence(__ATOMIC_ACQUIRE, "agent");
            asm volatile("s_waitcnt vmcnt(0)" ::: "memory");
        }
    }
    __syncthreads();
}


#ifndef PROBE_PH
#define PROBE_PH -1
#endif
#define REPEAT(id, body) { int nrep_ = (PROBE_PH == (id)) ? 2 : 1; asm volatile("" : "+s"(nrep_)); _Pragma("unroll 1") for (int rep_ = 0; rep_ < nrep_; ++rep_) { body } }
__global__ void __launch_bounds__(512, 2) mega_kernel(Params P) {
  __shared__ __attribute__((aligned(16))) char smem_all[SMEM_BYTES];
  cg::grid_group grid = cg::this_grid();
  char* smem = smem_all + vhalf() * SMEM_HALF;
  __shared__ __attribute__((aligned(16))) unsigned xb_st[4];
  if (threadIdx.x < 4) xb_st[threadIdx.x] = 0u;
  __syncthreads();
  const XcdBarrier xb = xcd_barrier_post(P.bar, (volatile LAS unsigned*)xb_st);
  REPEAT(0, phase0(P, smem); grid.sync();)
#pragma unroll 1
  for (int l = 0; l < 4; ++l) {
    REPEAT(5, phase_norm(P, l); xcd_barrier(xb);)
    engine_gemm<EpiProj>(P, l, smem_all, P.hbuf, 1024, P.WinT + (size_t)l * 7168 * 1024, NR, 4096, 1024);
    if (l < 3 && gridDim.x == 256 && blockIdx.x >= 128) prep_layer_weights(P, l + 1, ((int)blockIdx.x - 128) * 2 + vhalf(), 256, smem);
    if (l < 3 && gridDim.x != 256) prep_layer_weights(P, l + 1, vb(), vg(), smem);
    xcd_barrier(xb);
#if PROBE_PH == 1
    engine_gemm<EpiProj>(P, l, smem_all, P.hbuf, 1024, P.WinT + (size_t)l * 7168 * 1024, NR, 4096, 1024);
    xcd_barrier(xb);
#endif
    REPEAT(2, phase_scan(P, l, false, smem); xcd_barrier(xb);)
    phase_attn8(P, l, smem_all);
    xcd_barrier(xb);
    phase_scan(P, l, true, smem);
    xcd_barrier(xb);
    engine_gemm<EpiGlu>(P, l, smem_all, P.proj + CUS, PW, P.WgT + (size_t)l * 512 * 512, NLAT, 512, 512);
    if (l < 3) phase_glu(P, l, smem);
    xcd_barrier(xb);
    engine_merge(P, l, smem_all, NLAT);
    if (l < 3) phase_merge(P, l, smem);
    xcd_barrier(xb);
#if PROBE_PH == 4
    engine_merge(P, l, smem_all, Mrows);
    xcd_barrier(xb);
#endif
    engine_gemm<EpiOut>(P, l, smem_all, P.proj + CM, PW, P.WoT + (size_t)l * 1024 * 1024, NLAT, 1024, 1024);
    if (l < 3) phase_out(P, l, smem);
    xcd_barrier(xb);
  }
  phase_final(P);
}

extern "C" void kernel_launch(void* const* d_in, const int* in_sizes, int n_in, void* d_out, int out_size, void* d_ws,
                              size_t ws_size, hipStream_t stream) {
  Params p{};
  const float** fp = (const float**)&p;
  for (int i = 0; i < 30; ++i) fp[i] = (const float*)d_in[i];
  p.out = (float*)d_out;
  char* ws = (char*)d_ws;
  size_t off = 0;
  auto take = [&](size_t bytes) { char* r = ws + off; off += (bytes + 255) & ~(size_t)255; return r; };
  p.proj = (bf16_t*)take((size_t)NR * PW * 2);
  p.hbuf = (bf16_t*)take((size_t)NR * 1024 * 2);
  p.WinT = (bf16_t*)take((size_t)4 * 7168 * 1024 * 2);
  p.WbT = (bf16_t*)take((size_t)12 * 1024 * 512 * 2);
  p.WoT = (bf16_t*)take((size_t)4 * 1024 * 1024 * 2);
  p.WgT = (bf16_t*)take((size_t)4 * 512 * 512 * 2);
  p.WlT = (bf16_t*)take((size_t)128 * 4096 * 2);
  p.Vt = (bf16_t*)take((size_t)32 * 128 * 4352 * 2);
  p.ctxres = (float*)take((size_t)2048 * 1024 * 4);
  p.mods = (float*)take((size_t)4 * 9 * 3072 * 4);
  p.lamv = (float*)take(256);
  p.lruP = (float*)take((size_t)2 * NCH * 512 * 4);
  p.lruS = (float*)take((size_t)2 * NCH * 512 * 4);
  p.rope = (float2*)take((size_t)4096 * 32 * 8);
  p.s5A = (float2*)take((size_t)256 * 64 * 8);
  p.s5A64 = (float2*)take((size_t)256 * 64 * 8);
  p.s5E = (float2*)take((size_t)2 * NCH * 32 * 64 * 8);
  p.s5drvB = (u32x4*)take((size_t)256 * 8 * 64 * 16);
  p.s5C = (u32x4*)take((size_t)128 * 4 * 64 * 16);
  p.bar = (unsigned*)take((size_t)XCD_BAR_WORDS * 4);
  if (off > ws_size) { fprintf(stderr, "workspace too small: need %zu have %zu\n", off, ws_size); return; }

  static int grid_blocks = 0;
  if (!grid_blocks) {
    int dev = 0, cus = 0, per_cu = 0;
    (void)hipGetDevice(&dev);
    (void)hipDeviceGetAttribute(&cus, hipDeviceAttributeMultiprocessorCount, dev);
    (void)hipOccupancyMaxActiveBlocksPerMultiprocessor(&per_cu, mega_kernel, 512, 0);
    if (per_cu < 1) per_cu = 1;
    if (per_cu > 1) per_cu = 1;
    grid_blocks = cus * per_cu;
  }
  (void)hipMemsetAsync(p.bar, 0, (size_t)XCD_BAR_WORDS * 4, stream);
  void* args[] = {&p};
  hipError_t e = hipLaunchCooperativeKernel((void*)mega_kernel, dim3(grid_blocks), dim3(512), args, 0, stream);
  if (e != hipSuccess) fprintf(stderr, "cooperative launch failed: %s (grid %d)\n", hipGetErrorString(e), grid_blocks);
}
```

```cpp
#include <hip/hip_runtime.h>
#include <hip/hip_bf16.h>
#include <hip/hip_cooperative_groups.h>
#include <cstdio>
#include <cstdint>
namespace cg = cooperative_groups;

#ifndef MULTI_LAUNCH
#define MULTI_LAUNCH 0
#endif

#define DEV __device__ __forceinline__
typedef unsigned short bf16_t;
using bf16x8 = __attribute__((ext_vector_type(8))) short;
using f32x4 = __attribute__((ext_vector_type(4))) float;
using u32x4 = __attribute__((ext_vector_type(4))) unsigned;
using u32x2 = __attribute__((ext_vector_type(2))) unsigned;

constexpr int NR = 34816;
constexpr int NLAT = 32768;
constexpr int PW = 4096;
constexpr int CQ = 0, CK = 512, CZA = 1536, CXR = 2048, CZR = 2560, CUS = 3072, CZS = 3584, CM = 512;
constexpr int NCH = 544;
constexpr int NPHASE = 34;
constexpr int SMEM_HALF = 73728;
constexpr int SMEM_BYTES = 2 * SMEM_HALF;

struct Params {
  const float *x, *c, *ctx, *c_ctx, *w_mod, *b_mod, *norm_g, *w_in, *lam_qk, *subln_g, *conv_w, *conv_b,
      *lru_wa, *lru_ba, *lru_wx, *lru_bx, *lru_lam, *s5_lam_re, *s5_lam_im, *s5_log_dt, *s5_b_re, *s5_b_im,
      *s5_c_re, *s5_c_im, *s5_d, *s5_w_glu, *s5_b_glu, *w_branch, *w_out, *final_g;
  float* out;
  bf16_t *proj, *hbuf, *WinT, *WbT, *WoT, *WgT, *WlT, *Vt;
  float *ctxres, *mods, *lamv, *lruP, *lruS;
  float2 *rope, *s5A, *s5A64, *s5E;
  u32x4 *s5drvB, *s5C;
  unsigned* bar;
};

DEV int tidx() { int t = threadIdx.x & 255; asm volatile("" : "+v"(t)); return t; }
DEV int tid512() { int t = threadIdx.x; asm volatile("" : "+v"(t)); return t; }
DEV int vhalf() { return __builtin_amdgcn_readfirstlane((int)(threadIdx.x >> 8)); }
DEV int vb() { return (int)blockIdx.x * 2 + vhalf(); }
DEV int vg() { return (int)gridDim.x * 2; }
DEV u32x4 u32x4_mk(unsigned a, unsigned b, unsigned c, unsigned d) { return u32x4{a, b, c, d}; }
DEV u32x2 u32x2_mk(unsigned a, unsigned b) { return u32x2{a, b}; }
typedef float f32x2_t __attribute__((ext_vector_type(2)));
typedef __bf16 bf16x2_t __attribute__((ext_vector_type(2)));
DEV bf16_t f2bf(float f) { return __builtin_bit_cast(unsigned short, (__bf16)f); }
DEV float bf2f(bf16_t h) { return __uint_as_float(((unsigned)h) << 16); }
DEV unsigned pack2(float a, float b) {
  f32x2_t v = {a, b};
  return __builtin_bit_cast(unsigned, __builtin_convertvector(v, bf16x2_t));
}
DEV float fexp2(float x) { return __builtin_amdgcn_exp2f(x); }
DEV float frcp(float x) { return __builtin_amdgcn_rcpf(x); }
DEV float sigmoidf_(float x) { return frcp(1.f + __expf(-x)); }
DEV float siluf_(float x) { return x * frcp(1.f + __expf(-x)); }
DEV float gelu_tanh(float x) {
  float u = 0.7978845608028654f * (x + 0.044715f * x * x * x);
  return x * frcp(1.f + __expf(-2.f * u));
}
DEV float shx(float v, int mask, int lane) { return __int_as_float(__builtin_amdgcn_ds_bpermute((lane ^ mask) << 2, __float_as_int(v))); }
DEV float shi(float v, int src) { return __int_as_float(__builtin_amdgcn_ds_bpermute(src << 2, __float_as_int(v))); }
DEV f32x4 mfma16(bf16x8 a, bf16x8 b, f32x4 c) { return __builtin_amdgcn_mfma_f32_16x16x32_bf16(a, b, c, 0, 0, 0); }
DEV bf16x8 as_bf16x8(u32x4 v) {
  return __builtin_bit_cast(bf16x8, v);
}

template <int NTW>
DEV void g_load(u32x4 (&ra)[4], u32x4 (&rw)[NTW], const bf16_t* __restrict__ A, int lda, const bf16_t* __restrict__ W,
                int ldw, int k0, int lrow, int loff) {
#pragma unroll
  for (int i = 0; i < 4; ++i) ra[i] = *(const u32x4*)(A + (size_t)(lrow + 32 * i) * lda + k0 + loff);
#pragma unroll
  for (int i = 0; i < NTW; ++i) rw[i] = *(const u32x4*)(W + (size_t)(lrow + 32 * i) * ldw + k0 + loff);
}
template <int NTW>
DEV void s_store(const u32x4 (&ra)[4], const u32x4 (&rw)[NTW], bf16_t* As, bf16_t* Ws, int lrow, int loff) {
#pragma unroll
  for (int i = 0; i < 4; ++i) *(u32x4*)(As + (lrow + 32 * i) * 72 + loff) = ra[i];
#pragma unroll
  for (int i = 0; i < NTW; ++i) *(u32x4*)(Ws + (lrow + 32 * i) * 72 + loff) = rw[i];
}
template <int BN>
DEV void g_compute(f32x4 (&acc)[4][BN / 32], const bf16_t* As, const bf16_t* Ws, int wm, int wn, int r16, int g) {
  constexpr int NTW = BN / 32;
#pragma unroll
  for (int kb = 0; kb < 2; ++kb) {
    bf16x8 af[4], wf[NTW];
#pragma unroll
    for (int mt = 0; mt < 4; ++mt) af[mt] = *(const bf16x8*)(As + (wm * 64 + mt * 16 + r16) * 72 + kb * 32 + g * 8);
#pragma unroll
    for (int nt = 0; nt < NTW; ++nt)
      wf[nt] = *(const bf16x8*)(Ws + (wn * (BN / 2) + nt * 16 + r16) * 72 + kb * 32 + g * 8);
#pragma unroll
    for (int mt = 0; mt < 4; ++mt)
#pragma unroll
      for (int nt = 0; nt < NTW; ++nt) acc[mt][nt] = mfma16(wf[nt], af[mt], acc[mt][nt]);
  }
}
template <int BN>
DEV void gemm_main(f32x4 (&acc)[4][BN / 32], const bf16_t* __restrict__ A, int lda, const bf16_t* __restrict__ W,
                   int ldw, int K, char* smem) {
  constexpr int NTW = BN / 32;
  constexpr int BUF = (128 + BN) * 72;
  bf16_t* As0 = (bf16_t*)smem;
  bf16_t* Ws0 = As0 + 128 * 72;
  bf16_t* As1 = As0 + BUF;
  bf16_t* Ws1 = As1 + 128 * 72;
  const int tid = tidx(), lane = tid & 63, w = tid >> 6;
  const int wm = w & 1, wn = w >> 1;
  const int r16 = lane & 15, g = lane >> 4;
  const int lrow = tid >> 3, loff = (tid & 7) * 8;
  u32x4 ra0[4], rw0[NTW], ra1[4], rw1[NTW];
  const int nk = K >> 6;
  g_load<NTW>(ra0, rw0, A, lda, W, ldw, 0, lrow, loff);
  g_load<NTW>(ra1, rw1, A, lda, W, ldw, 64, lrow, loff);
  __syncthreads();
  s_store<NTW>(ra0, rw0, As0, Ws0, lrow, loff);
  g_load<NTW>(ra0, rw0, A, lda, W, ldw, 128, lrow, loff);
  __syncthreads();
  for (int kt = 0; kt < nk; kt += 2) {
    s_store<NTW>(ra1, rw1, As1, Ws1, lrow, loff);
    g_load<NTW>(ra1, rw1, A, lda, W, ldw, min(kt + 3, nk - 1) << 6, lrow, loff);
    g_compute<BN>(acc, As0, Ws0, wm, wn, r16, g);
    __syncthreads();
    s_store<NTW>(ra0, rw0, As0, Ws0, lrow, loff);
    g_load<NTW>(ra0, rw0, A, lda, W, ldw, min(kt + 4, nk - 1) << 6, lrow, loff);
    g_compute<BN>(acc, As1, Ws1, wm, wn, r16, g);
    __syncthreads();
  }
}

template <int NT>
DEV void zero_acc(f32x4 (&acc)[4][NT]) {
#pragma unroll
  for (int i = 0; i < 4; ++i)
#pragma unroll
    for (int j = 0; j < NT; ++j) acc[i][j] = f32x4{0.f, 0.f, 0.f, 0.f};
}

DEV int mod_row(int m) { return m < NLAT ? (m >> 12) : 8; }

DEV void transpose_tile(const float* __restrict__ src, int N, bf16_t* __restrict__ dst, int K, int k0, int n0, char* smem) {
  float* tile = (float*)smem;
  const int tid = tidx();
  __syncthreads();
  {
    const int n = tid & 63, kk = tid >> 6;
#pragma unroll
    for (int i = 0; i < 16; ++i) {
      int k = kk + 4 * i;
      tile[k * 65 + n] = src[(size_t)(k0 + k) * N + n0 + n];
    }
  }
  __syncthreads();
  {
    const int k = tid & 63, nn = tid >> 6;
#pragma unroll
    for (int i = 0; i < 16; ++i) {
      int n = nn + 4 * i;
      dst[(size_t)(n0 + n) * K + k0 + k] = f2bf(tile[k * 65 + n]);
    }
  }
}

DEV void transpose_tile2(const float* __restrict__ src, int N, bf16_t* __restrict__ dst, int K, int k0, int n0, char* smem) {
  float* tile = (float*)smem;
  const int tid = tidx();
  __syncthreads();
  {
    const int n = tid & 63, kk = tid >> 6;
#pragma unroll
    for (int i = 0; i < 32; ++i) {
      int k = kk + 4 * i;
      tile[k * 65 + n] = src[(size_t)(k0 + k) * N + n0 + n];
    }
  }
  __syncthreads();
  {
    const int kp = tid & 63, nn = tid >> 6;
#pragma unroll
    for (int i = 0; i < 16; ++i) {
      int n = nn + 4 * i;
      unsigned v = pack2(tile[(2 * kp) * 65 + n], tile[(2 * kp + 1) * 65 + n]);
      *(unsigned*)(dst + (size_t)(n0 + n) * K + k0 + 2 * kp) = v;
    }
  }
}

struct TrJob { const float* src; bf16_t* dst; int N, K, k0, n0, rows; };
DEV TrJob prep_job(const Params& P, int l, int job) {
  TrJob t;
  int j = job;
  if (j < 896) {
    t.src = P.w_in + (size_t)l * 1024 * 7168; t.dst = P.WinT + (size_t)l * 7168 * 1024; t.N = 7168; t.K = 1024;
    t.k0 = (j / 112) * 128; t.n0 = (j % 112) * 64; t.rows = 128; return t;
  }
  j -= 896;
  if (j < 192) {
    const int mat = l * 3 + j / 64, q = j % 64;
    t.src = P.w_branch + (size_t)mat * 512 * 1024; t.dst = P.WbT + (size_t)mat * 1024 * 512; t.N = 1024; t.K = 512;
    t.k0 = (q / 16) * 128; t.n0 = (q % 16) * 64; t.rows = 128; return t;
  }
  j -= 192;
  if (j < 128) {
    t.src = P.w_out + (size_t)l * 1024 * 1024; t.dst = P.WoT + (size_t)l * 1024 * 1024; t.N = 1024; t.K = 1024;
    t.k0 = (j / 16) * 128; t.n0 = (j % 16) * 64; t.rows = 128; return t;
  }
  j -= 128;
  if (j < 32) {
    t.src = P.s5_w_glu + (size_t)l * 512 * 512; t.dst = P.WgT + (size_t)l * 512 * 512; t.N = 512; t.K = 512;
    t.k0 = (j / 8) * 128; t.n0 = (j % 8) * 64; t.rows = 128; return t;
  }
  j -= 32;
  {
    const int jj = l * 32 + j;
    const int blk = jj & 7, which = (jj >> 3) & 1, ld = jj >> 4;
    t.src = (which ? P.lru_wx : P.lru_wa) + (size_t)(ld * 8 + blk) * 4096; t.dst = P.WlT + (size_t)jj * 4096; t.N = 64; t.K = 64;
    t.k0 = 0; t.n0 = 0; t.rows = 64; return t;
  }
}
DEV void prep_load(const TrJob& t, float (&v)[32], int tid) {
  const int n = tid & 63, kk = tid >> 6;
#pragma unroll
  for (int i = 0; i < 32; ++i) {
    const int k = kk + 4 * i;
    v[i] = (k < t.rows) ? t.src[(size_t)(t.k0 + k) * t.N + t.n0 + n] : 0.f;
  }
}
DEV void prep_layer_weights(const Params& P, int l, int first, int stride, char* smem) {
  float* tile = (float*)smem;
  const int tid = tidx();
  if (first >= 1280) return;
  TrJob cur = prep_job(P, l, first);
  float v[32];
  prep_load(cur, v, tid);
  for (int job = first; job < 1280; job += stride) {
    __syncthreads();
    {
      const int n = tid & 63, kk = tid >> 6;
#pragma unroll
      for (int i = 0; i < 32; ++i) tile[(kk + 4 * i) * 65 + n] = v[i];
    }
    const bool has_next = job + stride < 1280;
    TrJob nxt = cur;
    if (has_next) { nxt = prep_job(P, l, job + stride); prep_load(nxt, v, tid); }
    __syncthreads();
    {
      const int kp = tid & 63, nn = tid >> 6;
      if (2 * kp < cur.rows) {
#pragma unroll
        for (int i = 0; i < 16; ++i) {
          const int n = nn + 4 * i;
          const unsigned pk = pack2(tile[(2 * kp) * 65 + n], tile[(2 * kp + 1) * 65 + n]);
          *(unsigned*)(cur.dst + (size_t)(cur.n0 + n) * cur.K + cur.k0 + 2 * kp) = pk;
        }
      }
    }
    cur = nxt;
  }
}

DEV void phase0(const Params& P, char* smem) {
  const int tid = tidx();
  prep_layer_weights(P, 0, vb(), vg(), smem);
  constexpr int J_MOD = 768, J_ROPE = 512, J_S5 = 256;
  constexpr int JT = J_MOD + J_ROPE + J_S5 + 1;
  for (int job = vb(); job < JT; job += vg()) {
    int j = job;
    if (j < J_MOD) {
      int l = j / 192, jt = j % 192;
      float* sc = (float*)smem;
      float* red = sc + 9216;
      __syncthreads();
      for (int idx = tid; idx < 9216; idx += 256) {
        int r = idx >> 10, k = idx & 1023;
        float v = r < 8 ? P.c[r * 1024 + k] : P.c_ctx[k];
        sc[idx] = siluf_(v);
      }
      __syncthreads();
      const int jj = tid & 15, kq = tid >> 4, col = jt * 16 + jj;
      float a[9];
#pragma unroll
      for (int r = 0; r < 9; ++r) a[r] = 0.f;
      const float* wp = P.w_mod + (size_t)l * 1024 * 3072 + col;
#pragma unroll 16
      for (int k = kq * 64; k < kq * 64 + 64; ++k) {
        float wv = wp[(size_t)k * 3072];
#pragma unroll
        for (int r = 0; r < 9; ++r) a[r] += sc[r * 1024 + k] * wv;
      }
#pragma unroll
      for (int r = 0; r < 9; ++r) red[(kq * 9 + r) * 16 + jj] = a[r];
      __syncthreads();
      if (tid < 144) {
        int r = tid >> 4, j2 = tid & 15;
        float s_ = 0.f;
#pragma unroll
        for (int q = 0; q < 16; ++q) s_ += red[(q * 9 + r) * 16 + j2];
        int cc = jt * 16 + j2;
        P.mods[(size_t)(l * 9 + r) * 3072 + cc] = s_ + P.b_mod[l * 3072 + cc];
      }
      continue;
    }
    j -= J_MOD;
    if (j < J_ROPE) {
      int e = j * 256 + tid;
      int t = e >> 5, i = e & 31, f = i & 15;
      float inv = powf(10000.f, -(float)f / 16.f);
      float pos = (float)(i < 16 ? (t >> 6) : (t & 63));
      float ang = pos * inv;
      P.rope[e] = make_float2(cosf(ang), sinf(ang));
      continue;
    }
    j -= J_ROPE;
    if (j < J_S5) {
      const int g = j & 31, ld = j >> 5, l = ld >> 1, d = ld & 1;
      float* crs = (float*)smem;
      __syncthreads();
      if (tid < 64) {
        int p = tid;
        float lr = P.s5_lam_re[(size_t)j * 64 + p], li = P.s5_lam_im[(size_t)j * 64 + p];
        float dt = expf(P.s5_log_dt[j]);
        float mag = expf(lr * dt);
        float ar = mag * cosf(li * dt), ai = mag * sinf(li * dt);
        float den = lr * lr + li * li;
        float nr = ar - 1.f;
        crs[p] = (nr * lr + ai * li) / den;
        crs[64 + p] = (ai * lr - nr * li) / den;
        P.s5A[(size_t)j * 64 + p] = make_float2(ar, ai);
        float pr = ar, pi = ai;
#pragma unroll
        for (int s = 0; s < 6; ++s) {
          float nr2 = pr * pr - pi * pi, ni2 = 2.f * pr * pi;
          pr = nr2; pi = ni2;
        }
        P.s5A64[(size_t)j * 64 + p] = make_float2(pr, pi);
      }
      __syncthreads();
      for (int e = tid; e < 512; e += 256) {
        int nt = e >> 6, ln = e & 63;
        int ri = nt >> 2, p = (nt & 3) * 16 + (ln & 15), kg = ln >> 4;
        float cr = crs[p], ci = crs[64 + p];
        unsigned v[4] = {0u, 0u, 0u, 0u};
        if (kg < 2) {
          const float* bre = P.s5_b_re + ((size_t)j * 64 + p) * 16 + kg * 8;
          const float* bim = P.s5_b_im + ((size_t)j * 64 + p) * 16 + kg * 8;
#pragma unroll
          for (int q = 0; q < 4; ++q) {
            float r0 = bre[2 * q], i0 = bim[2 * q], r1 = bre[2 * q + 1], i1 = bim[2 * q + 1];
            float v0 = ri == 0 ? cr * r0 - ci * i0 : cr * i0 + ci * r0;
            float v1 = ri == 0 ? cr * r1 - ci * i1 : cr * i1 + ci * r1;
            v[q] = pack2(v0, v1);
          }
        }
        P.s5drvB[((size_t)j * 8 + nt) * 64 + ln] = u32x4_mk(v[0], v[1], v[2], v[3]);
      }
      if (d == 0) {
        int kk = tid >> 6, ln = tid & 63;
        int h = ln & 15;
        unsigned v[4];
#pragma unroll
        for (int q = 0; q < 4; ++q) {
          float vv[2];
#pragma unroll
          for (int s = 0; s < 2; ++s) {
            int k = kk * 32 + (ln >> 4) * 8 + 2 * q + s;
            size_t base = ((size_t)(l * 32 + g) * 16 + h) * 64;
            vv[s] = (k & 1) == 0 ? P.s5_c_re[base + (k >> 1)] : -P.s5_c_im[base + (k >> 1)];
          }
          v[q] = pack2(vv[0], vv[1]);
        }
        P.s5C[((size_t)(l * 32 + g) * 4 + kk) * 64 + ln] = u32x4_mk(v[0], v[1], v[2], v[3]);
      }
      continue;
    }
    j -= J_S5;
    {
      int l = tid >> 6, lane = tid & 63;
      const float* lq = P.lam_qk + l * 256;
      float s1 = lq[lane] * lq[64 + lane], s2 = lq[128 + lane] * lq[192 + lane];
#pragma unroll
      for (int o = 32; o > 0; o >>= 1) {
        s1 += shx(s1, o, lane);
        s2 += shx(s2, o, lane);
      }
      float lam_init = 0.8f - 0.6f * expf(-0.3f * (float)l);
      if (lane == 0) P.lamv[l] = expf(s1) - expf(s2) + lam_init;
    }
  }
}

DEV void phase_norm(const Params& P, int l) {
  const int tid_ = tidx(); const int lane = tid_ & 63, w = tid_ >> 6;
  const float* ng = P.norm_g + l * 1024;
  auto rowptr = [&](int r) -> const float* {
    if (r < NLAT) return (l == 0 ? P.x : P.out) + (size_t)r * 1024;
    return (l == 0 ? P.ctx : P.ctxres) + (size_t)(r - NLAT) * 1024;
  };
  const int stride = vg() * 4;
  int r = vb() * 4 + w;
  float4 v[4], vn[4];
  if (r < NR) {
    const float* src = rowptr(r);
#pragma unroll
    for (int i = 0; i < 4; ++i) v[i] = *(const float4*)(src + i * 256 + lane * 4);
  }
  for (; r < NR; r += stride) {
    const int rn = r + stride;
    if (rn < NR) {
      const float* srcn = rowptr(rn);
#pragma unroll
      for (int i = 0; i < 4; ++i) vn[i] = *(const float4*)(srcn + i * 256 + lane * 4);
    }
    const float* md = P.mods + (size_t)(l * 9 + mod_row(r)) * 3072;
    float ss = 0.f;
#pragma unroll
    for (int i = 0; i < 4; ++i) ss += v[i].x * v[i].x + v[i].y * v[i].y + v[i].z * v[i].z + v[i].w * v[i].w;
#pragma unroll
    for (int o = 32; o > 0; o >>= 1) ss += __shfl_xor(ss, o);
    float rstd = rsqrtf(ss * (1.f / 1024.f) + 1e-6f);
#pragma unroll
    for (int i = 0; i < 4; ++i) {
      int k = i * 256 + lane * 4;
      float4 g4 = *(const float4*)(ng + k);
      float4 sh = *(const float4*)(md + k);
      float4 sc = *(const float4*)(md + 1024 + k);
      float o0 = v[i].x * rstd * g4.x * (1.f + sc.x) + sh.x;
      float o1 = v[i].y * rstd * g4.y * (1.f + sc.y) + sh.y;
      float o2 = v[i].z * rstd * g4.z * (1.f + sc.z) + sh.z;
      float o3 = v[i].w * rstd * g4.w * (1.f + sc.w) + sh.w;
      u32x2 pk = u32x2_mk(pack2(o0, o1), pack2(o2, o3));
      *(u32x2*)(P.hbuf + (size_t)r * 1024 + k) = pk;
    }
#pragma unroll
    for (int i = 0; i < 4; ++i) v[i] = vn[i];
  }
}

DEV void phase_proj(const Params& P, int l, char* smem) {
  const int tid_ = tidx(); const int lane = tid_ & 63, w = tid_ >> 6;
  const int wm = w & 1, wn = w >> 1, r16 = lane & 15, g = lane >> 4;
  const bf16_t* Wl = P.WinT + (size_t)l * 7168 * 1024;
  const float QS = 0.125f * 1.4426950408889634f;
  for (int tile = vb(); tile < 272 * 32; tile += vg()) {
    const int mtile = tile >> 5, ntile = tile & 31;
    const int m0 = mtile * 128, n0 = ntile * 128;
    f32x4 acc[4][4];
    zero_acc<4>(acc);
    gemm_main<128>(acc, P.hbuf + (size_t)m0 * 1024, 1024, Wl + (size_t)n0 * 1024, 1024, 1024, smem);
    const int region = n0 >> 9;
#pragma unroll
    for (int mt = 0; mt < 4; ++mt) {
      const int m = m0 + wm * 64 + mt * 16 + r16;
#pragma unroll
      for (int nt = 0; nt < 4; ++nt) {
        const int n = n0 + wn * 64 + nt * 16 + g * 4;
        f32x4 v = acc[mt][nt];
        if (region <= 1) {
          if (m < NLAT) {
            int t = m & 4095;
            int i0 = (n & 63) >> 1;
            float4 cs = *(const float4*)(P.rope + (size_t)t * 32 + i0);
            float a0 = v[0] * cs.x - v[1] * cs.y, a1 = v[0] * cs.y + v[1] * cs.x;
            float a2 = v[2] * cs.z - v[3] * cs.w, a3 = v[2] * cs.w + v[3] * cs.z;
            v = f32x4{a0, a1, a2, a3};
          }
          if (region == 0) v = v * QS;
          *(u32x2*)(P.proj + (size_t)m * PW + n) = u32x2_mk(pack2(v[0], v[1]), pack2(v[2], v[3]));
        } else if (region == 2) {
          int b, key;
          if (m < NLAT) { b = m >> 12; key = m & 4095; }
          else { b = (m - NLAT) >> 8; key = 4096 + ((m - NLAT) & 255); }
          int nn = n - 1024;
          bf16_t* vp = P.Vt + ((size_t)b * 512 + nn) * 4352 + key;
#pragma unroll
          for (int j = 0; j < 4; ++j) vp[(size_t)j * 4352] = f2bf(v[j]);
        } else {
          if (region == 3 || region == 5 || region == 7) {
#pragma unroll
            for (int j = 0; j < 4; ++j) v[j] = siluf_(v[j]);
          }
          *(u32x2*)(P.proj + (size_t)m * PW + n) = u32x2_mk(pack2(v[0], v[1]), pack2(v[2], v[3]));
        }
      }
    }
  }
}

struct ChunkGeo { int row0, seqrow0, seqlen, tloc0; };
DEV ChunkGeo chunk_geo(int cid) {
  ChunkGeo c;
  if (cid < 512) {
    int b = cid >> 6, lc = cid & 63;
    c.row0 = b * 4096 + lc * 64; c.seqrow0 = b * 4096; c.seqlen = 4096; c.tloc0 = lc * 64;
  } else {
    int cc = cid - 512, b = cc >> 2;
    c.row0 = NLAT + cc * 64; c.seqrow0 = NLAT + b * 256; c.seqlen = 256; c.tloc0 = (cc & 3) * 64;
  }
  return c;
}
DEV int chunk_at(int b, int d, int pos) {
  if (d == 0) return pos < 4 ? 512 + b * 4 + pos : b * 64 + (pos - 4);
  return pos < 4 ? 512 + b * 4 + (3 - pos) : b * 64 + (63 - (pos - 4));
}

DEV void lru_item(const Params& P, int l, int item, bool step3, char* smem) {
  const int tid = tidx(), lane = tid & 63, w = tid >> 6, r16 = lane & 15, g = lane >> 4;
  const int cid = item >> 3, cb = item & 7;
  const ChunkGeo cg_ = chunk_geo(cid);
  bf16_t* Us = (bf16_t*)smem;
  const int c8 = tid & 7, tr = tid >> 3;
  const int ch0 = cb * 64 + c8 * 8;
  u32x4 xin[2][4];
#pragma unroll
  for (int pass = 0; pass < 2; ++pass)
#pragma unroll
    for (int jt = 0; jt < 4; ++jt) {
      const int tt = cg_.tloc0 + tr + 32 * pass + jt - 2;
      u32x4 xv = u32x4_mk(0u, 0u, 0u, 0u);
      if (tt >= 0 && tt < cg_.seqlen) xv = *(const u32x4*)(P.proj + (size_t)(cg_.seqrow0 + tt) * PW + CXR + ch0);
      xin[pass][jt] = xv;
    }
  float wt[4][8], cbv[8];
  {
    const float4 b0 = *(const float4*)(P.conv_b + l * 512 + ch0), b1 = *(const float4*)(P.conv_b + l * 512 + ch0 + 4);
    cbv[0] = b0.x; cbv[1] = b0.y; cbv[2] = b0.z; cbv[3] = b0.w; cbv[4] = b1.x; cbv[5] = b1.y; cbv[6] = b1.z; cbv[7] = b1.w;
#pragma unroll
    for (int jt = 0; jt < 4; ++jt) {
      const float4 w0 = *(const float4*)(P.conv_w + (l * 4 + jt) * 512 + ch0), w1 = *(const float4*)(P.conv_w + (l * 4 + jt) * 512 + ch0 + 4);
      wt[jt][0] = w0.x; wt[jt][1] = w0.y; wt[jt][2] = w0.z; wt[jt][3] = w0.w; wt[jt][4] = w1.x; wt[jt][5] = w1.y; wt[jt][6] = w1.z; wt[jt][7] = w1.w;
    }
  }
  const int ch = cb * 64 + w * 16 + r16;
  bf16_t zep[4][4];
  float cin[2] = {0.f, 0.f};
  if (step3) {
    cin[0] = P.lruS[(size_t)(0 * NCH + cid) * 512 + ch];
    cin[1] = P.lruS[(size_t)(1 * NCH + cid) * 512 + ch];
#pragma unroll
    for (int tt = 0; tt < 4; ++tt)
#pragma unroll
      for (int j = 0; j < 4; ++j) zep[tt][j] = P.proj[(size_t)(cg_.row0 + tt * 16 + g * 4 + j) * PW + CZR + ch];
  }
  bf16x8 wfr[2][2][2];
  float bav[2], bxv[2], lmv[2];
#pragma unroll
  for (int d = 0; d < 2; ++d) {
#pragma unroll
    for (int wh = 0; wh < 2; ++wh)
#pragma unroll
      for (int kb = 0; kb < 2; ++kb)
        wfr[d][wh][kb] = *(const bf16x8*)(P.WlT + (size_t)(((l * 2 + d) * 2 + wh) * 8 + cb) * 4096 + (w * 16 + r16) * 64 + kb * 32 + g * 8);
    bav[d] = P.lru_ba[(l * 2 + d) * 512 + ch];
    bxv[d] = P.lru_bx[(l * 2 + d) * 512 + ch];
    lmv[d] = P.lru_lam[(l * 2 + d) * 512 + ch];
  }
  __syncthreads();
#pragma unroll
  for (int pass = 0; pass < 2; ++pass) {
    const int t = tr + 32 * pass;
    f32x2_t a2[4];
#pragma unroll
    for (int q = 0; q < 4; ++q) a2[q] = f32x2_t{cbv[2 * q], cbv[2 * q + 1]};
#pragma unroll
    for (int jt = 0; jt < 4; ++jt) {
      const u32x4 xv = xin[pass][jt];
      const unsigned xs[4] = {xv.x, xv.y, xv.z, xv.w};
#pragma unroll
      for (int q = 0; q < 4; ++q)
        a2[q] = __builtin_elementwise_fma(f32x2_t{wt[jt][2 * q], wt[jt][2 * q + 1]},
                                          f32x2_t{__uint_as_float(xs[q] << 16), __uint_as_float(xs[q] & 0xffff0000u)}, a2[q]);
    }
    *(u32x4*)(Us + t * 72 + c8 * 8) = u32x4_mk(pack2(a2[0][0], a2[0][1]), pack2(a2[1][0], a2[1][1]), pack2(a2[2][0], a2[2][1]), pack2(a2[3][0], a2[3][1]));
  }
  __syncthreads();
  bf16x8 uf[4][2];
#pragma unroll
  for (int tt = 0; tt < 4; ++tt)
#pragma unroll
    for (int kb = 0; kb < 2; ++kb) uf[tt][kb] = *(const bf16x8*)(Us + (tt * 16 + r16) * 72 + kb * 32 + g * 8);
  float uval[4][4];
#pragma unroll
  for (int tt = 0; tt < 4; ++tt)
#pragma unroll
    for (int j = 0; j < 4; ++j) uval[tt][j] = bf2f(Us[(tt * 16 + g * 4 + j) * 72 + w * 16 + r16]);
  float outv[4][4];
#pragma unroll
  for (int tt = 0; tt < 4; ++tt)
#pragma unroll
    for (int j = 0; j < 4; ++j) outv[tt][j] = 0.f;

#pragma unroll
  for (int d = 0; d < 2; ++d) {
    f32x4 ga[4], gx[4];
#pragma unroll
    for (int tt = 0; tt < 4; ++tt) { ga[tt] = f32x4{0.f, 0.f, 0.f, 0.f}; gx[tt] = f32x4{0.f, 0.f, 0.f, 0.f}; }
#pragma unroll
    for (int kb = 0; kb < 2; ++kb) {
#pragma unroll
      for (int tt = 0; tt < 4; ++tt) {
        ga[tt] = mfma16(uf[tt][kb], wfr[d][0][kb], ga[tt]);
        gx[tt] = mfma16(uf[tt][kb], wfr[d][1][kb], gx[tt]);
      }
    }
    const float ba = bav[d], bx = bxv[d];
    const float ex_ = __expf(-lmv[d]);
    const float sp = ex_ < 0.05f ? ex_ * (1.f - ex_ * (0.5f - ex_ * (0.33333334f - ex_ * (0.25f - 0.2f * ex_)))) : __logf(1.f + ex_);
    float av[4][4], bv[4][4];
    {
      const float L2E = 1.4426950408889634f;
      const f32x2_t ba2 = {ba, ba}, bx2 = {bx, bx};
      const float c_la = -8.f * sp * L2E, c_x2 = -16.f * sp;
#pragma unroll
      for (int tt = 0; tt < 4; ++tt)
#pragma unroll
        for (int jp = 0; jp < 2; ++jp) {
          const f32x2_t G = (f32x2_t{ga[tt][2 * jp], ga[tt][2 * jp + 1]} + ba2) * (-L2E);
          const f32x2_t X = (f32x2_t{gx[tt][2 * jp], gx[tt][2 * jp + 1]} + bx2) * (-L2E);
          const f32x2_t dg = f32x2_t{fexp2(G[0]), fexp2(G[1])} + 1.f, dx = f32x2_t{fexp2(X[0]), fexp2(X[1])} + 1.f;
          const f32x2_t r = {frcp(dg[0]), frcp(dg[1])}, ii = {frcp(dx[0]), frcp(dx[1])};
          const f32x2_t la2 = r * c_la;
          const f32x2_t a2 = {fexp2(la2[0]), fexp2(la2[1])};
          const f32x2_t x2 = r * c_x2;
          f32x2_t ser = __builtin_elementwise_fma(x2, f32x2_t{0.0013888889f, 0.0013888889f}, f32x2_t{0.0083333338f, 0.0083333338f});
          ser = __builtin_elementwise_fma(x2, ser, f32x2_t{0.041666668f, 0.041666668f});
          ser = __builtin_elementwise_fma(x2, ser, f32x2_t{0.16666667f, 0.16666667f});
          ser = __builtin_elementwise_fma(x2, ser, f32x2_t{0.5f, 0.5f});
          ser = __builtin_elementwise_fma(x2, ser, f32x2_t{1.f, 1.f});
          ser = ser * (-x2);
          const f32x2_t dir = __builtin_elementwise_fma(-a2, a2, f32x2_t{1.f, 1.f});
          const f32x2_t om = {x2[0] > -0.25f ? ser[0] : dir[0], x2[1] > -0.25f ? ser[1] : dir[1]};
          const f32x2_t sq = {__builtin_amdgcn_sqrtf(om[0]), __builtin_amdgcn_sqrtf(om[1])};
          const f32x2_t bb = sq * (ii * f32x2_t{uval[tt][2 * jp], uval[tt][2 * jp + 1]});
          av[tt][2 * jp] = a2[0]; av[tt][2 * jp + 1] = a2[1];
          bv[tt][2 * jp] = bb[0]; bv[tt][2 * jp + 1] = bb[1];
        }
    }
    float Ps[4], Ss[4];
#pragma unroll
    for (int tt = 0; tt < 4; ++tt) {
      float p_ = 1.f, s_ = 0.f;
      if (d == 0) {
#pragma unroll
        for (int j = 0; j < 4; ++j) { p_ *= av[tt][j]; s_ = s_ * av[tt][j] + bv[tt][j]; }
      } else {
#pragma unroll
        for (int j = 3; j >= 0; --j) { p_ *= av[tt][j]; s_ = s_ * av[tt][j] + bv[tt][j]; }
      }
      Ps[tt] = p_; Ss[tt] = s_;
    }
    const size_t cidx = (size_t)(d * NCH + cid) * 512 + ch;
    if (!step3) {
      float Pc = 1.f, Sc = 0.f;
#pragma unroll
      for (int q = 0; q < 4; ++q) {
        const int tt = d == 0 ? q : 3 - q;
#pragma unroll
        for (int q2 = 0; q2 < 4; ++q2) {
          const int gg = d == 0 ? q2 : 3 - q2;
          float Pg = shi(Ps[tt], gg * 16 + r16), Sg = shi(Ss[tt], gg * 16 + r16);
          Sc = Sc * Pg + Sg;
          Pc = Pc * Pg;
        }
      }
      if (g == 0) { P.lruP[cidx] = Pc; P.lruS[cidx] = Sc; }
    } else {
      float carry = cin[d];
#pragma unroll
      for (int q = 0; q < 4; ++q) {
        const int tt = d == 0 ? q : 3 - q;
        float run = carry, hstart = 0.f;
#pragma unroll
        for (int q2 = 0; q2 < 4; ++q2) {
          const int gg = d == 0 ? q2 : 3 - q2;
          float Pg = shi(Ps[tt], gg * 16 + r16), Sg = shi(Ss[tt], gg * 16 + r16);
          if (gg == g) hstart = run;
          run = run * Pg + Sg;
        }
        carry = run;
        float h = hstart;
        if (d == 0) {
#pragma unroll
          for (int j = 0; j < 4; ++j) { h = av[tt][j] * h + bv[tt][j]; outv[tt][j] += h; }
        } else {
#pragma unroll
          for (int j = 3; j >= 0; --j) { h = av[tt][j] * h + bv[tt][j]; outv[tt][j] += h; }
        }
      }
    }
  }
  if (step3) {
#pragma unroll
    for (int tt = 0; tt < 4; ++tt)
#pragma unroll
      for (int j = 0; j < 4; ++j) {
        bf16_t* zp = P.proj + (size_t)(cg_.row0 + tt * 16 + g * 4 + j) * PW + CZR + ch;
        *zp = f2bf(outv[tt][j] * bf2f(zep[tt][j]));
      }
  }
}

DEV void s5_item(const Params& P, int l, int item, bool step3, char* smem) {
  const int tid = tidx(), lane = tid & 63, w = tid >> 6, r16 = lane & 15, g = lane >> 4;
  const int cid = item >> 3, gq = item & 7;
  const int grp = gq * 4 + w;
  const ChunkGeo cg_ = chunk_geo(cid);
  bf16_t* BUh = (bf16_t*)(smem + w * 16896);
  bf16_t* Hs = (bf16_t*)(smem + w * 16896 + 8192);
  f32x4 Y[4];
#pragma unroll
  for (int s_ = 0; s_ < 4; ++s_) Y[s_] = f32x4{0.f, 0.f, 0.f, 0.f};
  bf16x8 ufr[4];
#pragma unroll
  for (int sub = 0; sub < 4; ++sub) {
    u32x4 uv = u32x4_mk(0u, 0u, 0u, 0u);
    if (g < 2) uv = *(const u32x4*)(P.proj + (size_t)(cg_.row0 + sub * 16 + r16) * PW + CUS + grp * 16 + g * 8);
    ufr[sub] = as_bf16x8(uv);
  }
  bf16x8 cf[4];
  bf16_t uep[4][4];
  if (step3) {
#pragma unroll
    for (int kk = 0; kk < 4; ++kk) cf[kk] = as_bf16x8(P.s5C[((size_t)(l * 32 + grp) * 4 + kk) * 64 + lane]);
#pragma unroll
    for (int sub = 0; sub < 4; ++sub)
#pragma unroll
      for (int j = 0; j < 4; ++j) uep[sub][j] = P.proj[(size_t)(cg_.row0 + sub * 16 + g * 4 + j) * PW + CUS + grp * 16 + r16];
  }
  const int jd0 = (l * 2 + 0) * 32 + grp, jd1 = (l * 2 + 1) * 32 + grp;
  bf16x8 bfrA[8], bfrB[8];
#pragma unroll
  for (int nt = 0; nt < 8; ++nt) {
    bfrA[nt] = as_bf16x8(P.s5drvB[((size_t)jd0 * 8 + nt) * 64 + lane]);
    bfrB[nt] = as_bf16x8(P.s5drvB[((size_t)jd1 * 8 + nt) * 64 + lane]);
  }
  const float2 A0 = P.s5A[(size_t)jd0 * 64 + lane], A1 = P.s5A[(size_t)jd1 * 64 + lane];
  const size_t eidx0 = ((size_t)(0 * NCH + cid) * 32 + grp) * 64 + lane, eidx1 = ((size_t)(1 * NCH + cid) * 32 + grp) * 64 + lane;
  float h0r = 0.f, h0i = 0.f, h1r = 0.f, h1i = 0.f;
  if (step3) { float2 a_ = P.s5E[eidx0], b_ = P.s5E[eidx1]; h0r = a_.x; h0i = a_.y; h1r = b_.x; h1i = b_.y; }
#pragma unroll
  for (int si = 0; si < 4; ++si) {
    const int sub0 = si, sub1 = 3 - si;
    __syncthreads();
#pragma unroll
    for (int nt = 0; nt < 8; ++nt) {
      f32x4 b0 = mfma16(ufr[sub0], bfrA[nt], f32x4{0.f, 0.f, 0.f, 0.f});
      f32x4 b1 = mfma16(ufr[sub1], bfrB[nt], f32x4{0.f, 0.f, 0.f, 0.f});
      *(u32x2*)(BUh + (nt * 16 + r16) * 16 + g * 4) = u32x2_mk(pack2(b0[0], b0[1]), pack2(b0[2], b0[3]));
      *(u32x2*)(BUh + 2048 + (nt * 16 + r16) * 16 + g * 4) = u32x2_mk(pack2(b1[0], b1[1]), pack2(b1[2], b1[3]));
    }
    __syncthreads();
    u32x4 r0a = *(const u32x4*)(BUh + lane * 16), r0b = *(const u32x4*)(BUh + lane * 16 + 8);
    u32x4 i0a = *(const u32x4*)(BUh + (64 + lane) * 16), i0b = *(const u32x4*)(BUh + (64 + lane) * 16 + 8);
    u32x4 r1a = *(const u32x4*)(BUh + 2048 + lane * 16), r1b = *(const u32x4*)(BUh + 2048 + lane * 16 + 8);
    u32x4 i1a = *(const u32x4*)(BUh + 2048 + (64 + lane) * 16), i1b = *(const u32x4*)(BUh + 2048 + (64 + lane) * 16 + 8);
    const unsigned re0[8] = {r0a.x, r0a.y, r0a.z, r0a.w, r0b.x, r0b.y, r0b.z, r0b.w};
    const unsigned im0[8] = {i0a.x, i0a.y, i0a.z, i0a.w, i0b.x, i0b.y, i0b.z, i0b.w};
    const unsigned re1[8] = {r1a.x, r1a.y, r1a.z, r1a.w, r1b.x, r1b.y, r1b.z, r1b.w};
    const unsigned im1[8] = {i1a.x, i1a.y, i1a.z, i1a.w, i1b.x, i1b.y, i1b.z, i1b.w};
    {
      f32x2_t HR = {h0r, h1r}, HI = {h0i, h1i};
      const f32x2_t AX = {A0.x, A1.x}, AY = {A0.y, A1.y}, NAY = {-A0.y, -A1.y};
#pragma unroll
      for (int ti = 0; ti < 16; ++ti) {
        const int tf = ti, tb = 15 - ti;
        const unsigned rwf = re0[tf >> 1], iwf = im0[tf >> 1], rwb = re1[tb >> 1], iwb = im1[tb >> 1];
        const f32x2_t RE = {(tf & 1) ? __uint_as_float(rwf & 0xffff0000u) : __uint_as_float(rwf << 16),
                            (tb & 1) ? __uint_as_float(rwb & 0xffff0000u) : __uint_as_float(rwb << 16)};
        const f32x2_t IM = {(tf & 1) ? __uint_as_float(iwf & 0xffff0000u) : __uint_as_float(iwf << 16),
                            (tb & 1) ? __uint_as_float(iwb & 0xffff0000u) : __uint_as_float(iwb << 16)};
        const f32x2_t NR = __builtin_elementwise_fma(AX, HR, __builtin_elementwise_fma(NAY, HI, RE));
        const f32x2_t NI = __builtin_elementwise_fma(AX, HI, __builtin_elementwise_fma(AY, HR, IM));
        HR = NR; HI = NI;
        if (step3) {
          *(unsigned*)(Hs + tf * 136 + 2 * lane) = pack2(HR[0], HI[0]);
          *(unsigned*)(Hs + 2176 + tb * 136 + 2 * lane) = pack2(HR[1], HI[1]);
        }
      }
      h0r = HR[0]; h1r = HR[1]; h0i = HI[0]; h1i = HI[1];
    }
    if (step3) {
      __syncthreads();
#pragma unroll
      for (int kk = 0; kk < 4; ++kk) {
        bf16x8 hf0 = *(const bf16x8*)(Hs + r16 * 136 + kk * 32 + g * 8);
        bf16x8 hf1 = *(const bf16x8*)(Hs + 2176 + r16 * 136 + kk * 32 + g * 8);
        Y[sub0] = mfma16(hf0, cf[kk], Y[sub0]);
        Y[sub1] = mfma16(hf1, cf[kk], Y[sub1]);
      }
    }
  }
  if (!step3) { P.s5E[eidx0] = make_float2(h0r, h0i); P.s5E[eidx1] = make_float2(h1r, h1i); }
  if (step3) {
    const float dsk = P.s5_d[l * 512 + grp * 16 + r16];
#pragma unroll
    for (int sub = 0; sub < 4; ++sub)
#pragma unroll
      for (int j = 0; j < 4; ++j) {
        bf16_t* up = P.proj + (size_t)(cg_.row0 + sub * 16 + g * 4 + j) * PW + CUS + grp * 16 + r16;
        float y = Y[sub][j] + dsk * bf2f(uep[sub][j]);
        *up = f2bf(gelu_tanh(y));
      }
  }
}

DEV void phase_scan(const Params& P, int l, bool step3, char* smem) {
  const int ncid = (step3 && l == 3) ? 512 : NCH;
  const int nitems = ncid * 8;
  for (int it = vb(); it < 2 * nitems; it += vg()) {
    if (it < nitems) s5_item(P, l, it, step3, smem);
    else lru_item(P, l, it - nitems, step3, smem);
  }
}

DEV void carry_job(const Params& P, int l, int job) {
  const int tid = tidx();
  if (job < 32) {
    int id = job * 256 + tid;
    int ch = id & 511, d = (id >> 9) & 1, b = id >> 10;
    float carry = 0.f;
#pragma unroll 4
    for (int pos = 0; pos < 68; ++pos) {
      size_t idx = (size_t)(d * NCH + chunk_at(b, d, pos)) * 512 + ch;
      float Pv = P.lruP[idx], Sv = P.lruS[idx];
      P.lruS[idx] = carry;
      carry = Pv * carry + Sv;
    }
  } else {
    int id = (job - 32) * 256 + tid;
    int p = id & 63, g = (id >> 6) & 31, d = (id >> 11) & 1, b = id >> 12;
    float2 A = P.s5A64[((size_t)(l * 2 + d) * 32 + g) * 64 + p];
    float cr = 0.f, ci = 0.f;
#pragma unroll 4
    for (int pos = 0; pos < 68; ++pos) {
      size_t idx = ((size_t)(d * NCH + chunk_at(b, d, pos)) * 32 + g) * 64 + p;
      float2 e = P.s5E[idx];
      P.s5E[idx] = make_float2(cr, ci);
      float nr = A.x * cr - A.y * ci + e.x;
      float ni = A.x * ci + A.y * cr + e.y;
      cr = nr; ci = ni;
    }
  }
}

DEV void attn_item(const Params& P, int l, int item, char* smem, int dowrite = 1) {
  const int tid = tidx(), lane = tid & 63, w = tid >> 6, r16 = lane & 15, g = lane >> 4;
  bf16_t* Ks = (bf16_t*)smem;
  bf16_t* Vs = Ks + 64 * 136;
  int b, h, qrow0, kt0, nkt;
  if (item < 2048) {
    b = item >> 8; h = (item >> 6) & 3;
    qrow0 = b * 4096 + (item & 63) * 64; kt0 = 0; nkt = 68;
  } else {
    int i2 = item - 2048;
    b = i2 >> 4; h = (i2 >> 2) & 3;
    qrow0 = NLAT + b * 256 + (i2 & 3) * 64; kt0 = 64; nkt = 4;
  }
  const int qrow = qrow0 + w * 16 + r16;
  bf16x8 qf[2][2];
#pragma unroll
  for (int c = 0; c < 2; ++c)
#pragma unroll
    for (int kb = 0; kb < 2; ++kb)
      qf[c][kb] = *(const bf16x8*)(P.proj + (size_t)qrow * PW + CQ + h * 128 + c * 64 + kb * 32 + g * 8);
  f32x4 o[2][8];
#pragma unroll
  for (int c = 0; c < 2; ++c)
#pragma unroll
    for (int dv = 0; dv < 8; ++dv) o[c][dv] = f32x4{0.f, 0.f, 0.f, 0.f};
  float mrun[2] = {-1e30f, -1e30f}, lsum[2] = {0.f, 0.f};
  const bf16_t* Vbase = P.Vt + (size_t)(b * 4 + h) * 128 * 4352;
  u32x4 rk[4], rv[4];
  auto gl = [&](int kt) {
    int krow0, vkey0;
    if (kt < 64) { krow0 = b * 4096 + kt * 64; vkey0 = kt * 64; }
    else { krow0 = NLAT + b * 256 + (kt - 64) * 64; vkey0 = 4096 + (kt - 64) * 64; }
#pragma unroll
    for (int i = 0; i < 4; ++i) {
      int cidx = tid + 256 * i;
      rk[i] = *(const u32x4*)(P.proj + (size_t)(krow0 + (cidx >> 4)) * PW + CK + h * 128 + (cidx & 15) * 8);
      rv[i] = *(const u32x4*)(Vbase + (size_t)(cidx >> 3) * 4352 + vkey0 + (cidx & 7) * 8);
    }
  };
  auto st = [&](int buf) {
    bf16_t* Kd = Ks + buf * (64 * 136 + 128 * 72);
    bf16_t* Vd = Vs + buf * (64 * 136 + 128 * 72);
#pragma unroll
    for (int i = 0; i < 4; ++i) {
      int cidx = tid + 256 * i;
      *(u32x4*)(Kd + (cidx >> 4) * 136 + (cidx & 15) * 8) = rk[i];
      *(u32x4*)(Vd + (cidx >> 3) * 72 + (cidx & 7) * 8) = rv[i];
    }
  };
  gl(kt0);
  __syncthreads();
  st(0);
  gl(kt0 + 1);
  __syncthreads();
  for (int it = 0; it < nkt; ++it) {
    const int cur = it & 1;
    if (it + 1 < nkt) st(cur ^ 1);
    if (it + 2 < nkt) gl(kt0 + it + 2);
    const bf16_t* Kc = Ks + cur * (64 * 136 + 128 * 72);
    const bf16_t* Vc = Vs + cur * (64 * 136 + 128 * 72);
#pragma unroll
    for (int c = 0; c < 2; ++c) {
      f32x4 s[4];
#pragma unroll
      for (int kt = 0; kt < 4; ++kt) {
        s[kt] = f32x4{0.f, 0.f, 0.f, 0.f};
#pragma unroll
        for (int kb = 0; kb < 2; ++kb) {
          bf16x8 kf = *(const bf16x8*)(Kc + (kt * 16 + r16) * 136 + c * 64 + kb * 32 + g * 8);
          s[kt] = mfma16(kf, qf[c][kb], s[kt]);
        }
      }
      float mx = fmaxf(fmaxf(s[0][0], s[0][1]), fmaxf(s[0][2], s[0][3]));
#pragma unroll
      for (int kt = 1; kt < 4; ++kt) mx = fmaxf(mx, fmaxf(fmaxf(s[kt][0], s[kt][1]), fmaxf(s[kt][2], s[kt][3])));
      mx = fmaxf(mx, shx(mx, 16, lane));
      mx = fmaxf(mx, shx(mx, 32, lane));
      const bool need = mx > mrun[c] + 8.f;
      if (__any(need)) {
        const float mnew = need ? mx : mrun[c];
        const float alpha = fexp2(mrun[c] - mnew);
        mrun[c] = mnew;
        lsum[c] *= alpha;
#pragma unroll
        for (int dv = 0; dv < 8; ++dv) o[c][dv] = o[c][dv] * alpha;
      }
      const float mref = mrun[c];
      float ps = 0.f;
#pragma unroll
      for (int kt = 0; kt < 4; ++kt) {
        s[kt] = s[kt] - mref;
#pragma unroll
        for (int j = 0; j < 4; ++j) { s[kt][j] = fexp2(s[kt][j]); ps += s[kt][j]; }
      }
      lsum[c] += ps;
      bf16x8 pf[2];
#pragma unroll
      for (int kb2 = 0; kb2 < 2; ++kb2) {
        u32x4 pk = u32x4_mk(pack2(s[2 * kb2][0], s[2 * kb2][1]), pack2(s[2 * kb2][2], s[2 * kb2][3]),
                            pack2(s[2 * kb2 + 1][0], s[2 * kb2 + 1][1]), pack2(s[2 * kb2 + 1][2], s[2 * kb2 + 1][3]));
        pf[kb2] = as_bf16x8(pk);
      }
#pragma unroll
      for (int dv = 0; dv < 8; ++dv) {
        if ((dv & 1) == 0) __builtin_amdgcn_sched_barrier(0);
#pragma unroll
        for (int kb2 = 0; kb2 < 2; ++kb2) {
          const bf16_t* vp = Vc + (dv * 16 + r16) * 72 + kb2 * 32 + g * 4;
          u32x2 v0 = *(const u32x2*)vp, v1 = *(const u32x2*)(vp + 16);
          bf16x8 vf = as_bf16x8(u32x4_mk(v0.x, v0.y, v1.x, v1.y));
          o[c][dv] = mfma16(vf, pf[kb2], o[c][dv]);
        }
      }
      __builtin_amdgcn_sched_barrier(0);
    }
    __syncthreads();
  }
  float l0 = lsum[0], l1 = lsum[1];
  l0 += shx(l0, 16, lane); l0 += shx(l0, 32, lane);
  l1 += shx(l1, 16, lane); l1 += shx(l1, 32, lane);
  const float lam = P.lamv[l];
  const float i0 = 1.f / l0, i1 = lam / l1;
  float ss = 0.f;
#pragma unroll
  for (int dv = 0; dv < 8; ++dv)
#pragma unroll
    for (int j = 0; j < 4; ++j) {
      float v = o[0][dv][j] * i0 - o[1][dv][j] * i1;
      o[0][dv][j] = v;
      ss += v * v;
    }
  ss += shx(ss, 16, lane); ss += shx(ss, 32, lane);
  const float lam_init = 0.8f - 0.6f * expf(-0.3f * (float)l);
  const float rs = rsqrtf(ss * (1.f / 128.f) + 1e-6f) * (1.f - lam_init);
#pragma unroll
  for (int dv = 0; dv < 8; ++dv) {
    const int dcol = dv * 16 + g * 4;
    float4 sg = *(const float4*)(P.subln_g + l * 128 + dcol);
    u32x2 zz = *(const u32x2*)(P.proj + (size_t)qrow * PW + CZA + h * 128 + dcol);
    float z0 = bf2f((bf16_t)(zz.x & 0xffffu)), z1 = bf2f((bf16_t)(zz.x >> 16));
    float z2 = bf2f((bf16_t)(zz.y & 0xffffu)), z3 = bf2f((bf16_t)(zz.y >> 16));
    float y0 = o[0][dv][0] * rs * sg.x * z0, y1 = o[0][dv][1] * rs * sg.y * z1;
    float y2 = o[0][dv][2] * rs * sg.z * z2, y3 = o[0][dv][3] * rs * sg.w * z3;
    if (dowrite) *(u32x2*)(P.proj + (size_t)qrow * PW + CQ + h * 128 + dcol) = u32x2_mk(pack2(y0, y1), pack2(y2, y3));
  }
}

DEV void phase_attn(const Params& P, int l, char* smem) {
  const int nattn = 2048 + (l < 3 ? 128 : 0);
  const int total = 160 + nattn;
  (void)total;
  for (int it = vb(); it < 160; it += vg()) carry_job(P, l, it);
#if PROBE_PH == 3
  { int flag = 0; asm volatile("" : "+s"(flag));
    for (int it = vg() - 1 - vb(); it < nattn; it += vg()) attn_item(P, l, it, smem, flag); }
#endif
  for (int it = vg() - 1 - vb(); it < nattn; it += vg()) attn_item(P, l, it, smem);
}


DEV void attn_item8(const Params& P, int l, int item, char* smem) {
  const int tid = tid512(), lane = tid & 63, wv = tid >> 6, r16 = lane & 15, g = lane >> 4;
  const int c = wv & 1, qg = wv >> 1;
  bf16_t* Ks = (bf16_t*)smem;
  bf16_t* Vs = Ks + 64 * 136;
  constexpr int BUFE = 64 * 136 + 128 * 72;
  float* X = (float*)(smem + SMEM_HALF);
  int b, h, qrow0, kt0, nkt;
  if (item < 1024) {
    b = item >> 7; h = (item >> 5) & 3;
    qrow0 = b * 4096 + (item & 31) * 128; kt0 = 0; nkt = 68;
  } else {
    int i2 = item - 1024;
    b = i2 >> 3; h = (i2 >> 1) & 3;
    qrow0 = NLAT + b * 256 + (i2 & 1) * 128; kt0 = 64; nkt = 4;
  }
  const int qrowb = qrow0 + qg * 32 + r16;
  bf16x8 qf[2][2];
#pragma unroll
  for (int qt = 0; qt < 2; ++qt)
#pragma unroll
    for (int kb = 0; kb < 2; ++kb)
      qf[qt][kb] = *(const bf16x8*)(P.proj + (size_t)(qrowb + qt * 16) * PW + CQ + h * 128 + c * 64 + kb * 32 + g * 8);
  f32x4 o[2][8];
#pragma unroll
  for (int qt = 0; qt < 2; ++qt)
#pragma unroll
    for (int dv = 0; dv < 8; ++dv) o[qt][dv] = f32x4{0.f, 0.f, 0.f, 0.f};
  float mrun[2] = {0.f, 0.f}, lsum[2] = {0.f, 0.f};
  const bf16_t* Vbase = P.Vt + (size_t)(b * 4 + h) * 128 * 4352;
  u32x4 rk[2], rv[2];
  auto gl = [&](int kt) {
    int krow0, vkey0;
    if (kt < 64) { krow0 = b * 4096 + kt * 64; vkey0 = kt * 64; }
    else { krow0 = NLAT + b * 256 + (kt - 64) * 64; vkey0 = 4096 + (kt - 64) * 64; }
#pragma unroll
    for (int i = 0; i < 2; ++i) {
      int cidx = tid + 512 * i;
      rk[i] = *(const u32x4*)(P.proj + (size_t)(krow0 + (cidx >> 4)) * PW + CK + h * 128 + (cidx & 15) * 8);
      rv[i] = *(const u32x4*)(Vbase + (size_t)(cidx >> 3) * 4352 + vkey0 + (cidx & 7) * 8);
    }
  };
  auto st = [&](int buf) {
    bf16_t* Kd = Ks + buf * BUFE;
    bf16_t* Vd = Vs + buf * BUFE;
#pragma unroll
    for (int i = 0; i < 2; ++i) {
      int cidx = tid + 512 * i;
      *(u32x4*)(Kd + (cidx >> 4) * 136 + (cidx & 15) * 8) = rk[i];
      *(u32x4*)(Vd + (cidx >> 3) * 72 + (cidx & 7) * 8) = rv[i];
    }
  };
  auto tile_compute = [&](const int CUR_, const bool FIRST_) {
    const bf16_t* Kc = Ks + CUR_ * BUFE;
    const bf16_t* Vc = Vs + CUR_ * BUFE;
    f32x4 s[2][4];
#pragma unroll
    for (int qt = 0; qt < 2; ++qt) {
      const float ninit = -mrun[qt];
#pragma unroll
      for (int kt = 0; kt < 4; ++kt) s[qt][kt] = f32x4{ninit, ninit, ninit, ninit};
    }
#pragma unroll
    for (int kt = 0; kt < 4; ++kt)
#pragma unroll
      for (int kb = 0; kb < 2; ++kb) {
        bf16x8 kf = *(const bf16x8*)(Kc + (kt * 16 + r16) * 136 + c * 64 + kb * 32 + g * 8);
        s[0][kt] = mfma16(kf, qf[0][kb], s[0][kt]);
        s[1][kt] = mfma16(kf, qf[1][kb], s[1][kt]);
      }
    bf16x8 pf[2][2];
#pragma unroll
    for (int qt = 0; qt < 2; ++qt) {
      float mx = fmaxf(fmaxf(s[qt][0][0], s[qt][0][1]), fmaxf(s[qt][0][2], s[qt][0][3]));
#pragma unroll
      for (int kt = 1; kt < 4; ++kt) mx = fmaxf(mx, fmaxf(fmaxf(s[qt][kt][0], s[qt][kt][1]), fmaxf(s[qt][kt][2], s[qt][kt][3])));
      const bool first = FIRST_;
      if (__any(first || mx > 8.f)) {
        mx = fmaxf(mx, shx(mx, 16, lane));
        mx = fmaxf(mx, shx(mx, 32, lane));
        const bool need = first || mx > 8.f;
        const float dm = need ? mx : 0.f;
        const float alpha = first ? 1.f : fexp2(-dm);
        mrun[qt] += dm;
        lsum[qt] *= alpha;
#pragma unroll
        for (int dv = 0; dv < 8; ++dv) o[qt][dv] = o[qt][dv] * alpha;
#pragma unroll
        for (int kt = 0; kt < 4; ++kt) s[qt][kt] = s[qt][kt] - dm;
      }
      float ps = 0.f;
#pragma unroll
      for (int kt = 0; kt < 4; ++kt)
#pragma unroll
        for (int j = 0; j < 4; ++j) { s[qt][kt][j] = fexp2(s[qt][kt][j]); ps += s[qt][kt][j]; }
      lsum[qt] += ps;
#pragma unroll
      for (int kb2 = 0; kb2 < 2; ++kb2) {
        u32x4 pk = u32x4_mk(pack2(s[qt][2 * kb2][0], s[qt][2 * kb2][1]), pack2(s[qt][2 * kb2][2], s[qt][2 * kb2][3]),
                            pack2(s[qt][2 * kb2 + 1][0], s[qt][2 * kb2 + 1][1]), pack2(s[qt][2 * kb2 + 1][2], s[qt][2 * kb2 + 1][3]));
        pf[qt][kb2] = as_bf16x8(pk);
      }
    }
    bf16x8 vfr[2][2][2];
    auto ldv = [&](int slot, int dvp) {
#pragma unroll
      for (int e = 0; e < 2; ++e)
#pragma unroll
        for (int kb2 = 0; kb2 < 2; ++kb2) {
          const bf16_t* vp = Vc + ((dvp * 2 + e) * 16 + r16) * 72 + kb2 * 32 + g * 4;
          u32x2 v0 = *(const u32x2*)vp, v1 = *(const u32x2*)(vp + 16);
          vfr[slot][e][kb2] = as_bf16x8(u32x4_mk(v0.x, v0.y, v1.x, v1.y));
        }
    };
    ldv(0, 0);
#pragma unroll
    for (int dvp = 0; dvp < 4; ++dvp) {
      if (dvp < 3) ldv((dvp + 1) & 1, dvp + 1);
      __builtin_amdgcn_sched_barrier(0);
#pragma unroll
      for (int e = 0; e < 2; ++e)
#pragma unroll
        for (int kb2 = 0; kb2 < 2; ++kb2) {
          o[0][dvp * 2 + e] = mfma16(vfr[dvp & 1][e][kb2], pf[0][kb2], o[0][dvp * 2 + e]);
          o[1][dvp * 2 + e] = mfma16(vfr[dvp & 1][e][kb2], pf[1][kb2], o[1][dvp * 2 + e]);
        }
      __builtin_amdgcn_sched_barrier(0);
    }
  };
  const int ktl = kt0 + nkt - 1;
  gl(kt0);
  __syncthreads();
  st(0);
  gl(kt0 + 1);
  st(1);
  gl(min(kt0 + 2, ktl));
  __syncthreads();
  for (int T = 0; 2 * T < nkt; ++T) {
    const int base = (T & 1) * 2, nbase = 2 - base;
    if (2 * T + 2 < nkt) st(nbase);
    gl(min(kt0 + 2 * T + 3, ktl));
    tile_compute(base, T == 0);
    if (2 * T + 3 < nkt) st(nbase + 1);
    gl(min(kt0 + 2 * T + 4, ktl));
    tile_compute(base + 1, false);
    __syncthreads();
  }
  const float lam = P.lamv[l];
#pragma unroll
  for (int qt = 0; qt < 2; ++qt) {
    float lq = lsum[qt];
    lq += shx(lq, 16, lane); lq += shx(lq, 32, lane);
    const float sc = (c == 0 ? 1.f : lam) / lq;
#pragma unroll
    for (int dv = 0; dv < 8; ++dv) o[qt][dv] = o[qt][dv] * sc;
  }
  if (c == 1) {
#pragma unroll
    for (int qt = 0; qt < 2; ++qt)
#pragma unroll
      for (int dv = 0; dv < 8; ++dv)
        *(f32x4*)(X + (size_t)((qg * 2 + qt) * 16 + r16) * 128 + dv * 16 + g * 4) = o[qt][dv];
  }
  __syncthreads();
  if (c == 0) {
    const float lam_init = 0.8f - 0.6f * expf(-0.3f * (float)l);
#pragma unroll
    for (int qt = 0; qt < 2; ++qt) {
      float ss = 0.f;
#pragma unroll
      for (int dv = 0; dv < 8; ++dv) {
        f32x4 o1 = *(const f32x4*)(X + (size_t)((qg * 2 + qt) * 16 + r16) * 128 + dv * 16 + g * 4);
        f32x4 v = o[qt][dv] - o1;
        o[qt][dv] = v;
        ss += v[0] * v[0] + v[1] * v[1] + v[2] * v[2] + v[3] * v[3];
      }
      ss += shx(ss, 16, lane); ss += shx(ss, 32, lane);
      const float rs = rsqrtf(ss * (1.f / 128.f) + 1e-6f) * (1.f - lam_init);
      const int qrow = qrowb + qt * 16;
#pragma unroll
      for (int dv = 0; dv < 8; ++dv) {
        const int dcol = dv * 16 + g * 4;
        float4 sg = *(const float4*)(P.subln_g + l * 128 + dcol);
        u32x2 zz = *(const u32x2*)(P.proj + (size_t)qrow * PW + CZA + h * 128 + dcol);
        float z0 = bf2f((bf16_t)(zz.x & 0xffffu)), z1 = bf2f((bf16_t)(zz.x >> 16));
        float z2 = bf2f((bf16_t)(zz.y & 0xffffu)), z3 = bf2f((bf16_t)(zz.y >> 16));
        float y0 = o[qt][dv][0] * rs * sg.x * z0, y1 = o[qt][dv][1] * rs * sg.y * z1;
        float y2 = o[qt][dv][2] * rs * sg.z * z2, y3 = o[qt][dv][3] * rs * sg.w * z3;
        *(u32x2*)(P.proj + (size_t)qrow * PW + CQ + h * 128 + dcol) = u32x2_mk(pack2(y0, y1), pack2(y2, y3));
      }
    }
  }
  __syncthreads();
}

DEV void phase_attn8(const Params& P, int l, char* smem_all) {
  const int nattn = 1024 + (l < 3 ? 64 : 0);
  for (int it = vb(); it < 160; it += vg()) carry_job(P, l, it);
  if (gridDim.x == 256) {
    const int xcd = (int)blockIdx.x & 7, slot = (int)blockIdx.x >> 3;
#pragma unroll 1
    for (int k = 0; k < 4; ++k) attn_item8(P, l, (k * 8 + xcd) * 32 + slot, smem_all);
    if (nattn > 1024 && (int)blockIdx.x >= 192) attn_item8(P, l, 1024 + 255 - (int)blockIdx.x, smem_all);
  } else {
    for (int it = (int)gridDim.x - 1 - (int)blockIdx.x; it < nattn; it += (int)gridDim.x) attn_item8(P, l, it, smem_all);
  }
}

DEV void phase_glu(const Params& P, int l, char* smem) {
  const int tid_ = tidx(); const int lane = tid_ & 63, w = tid_ >> 6;
  const int wm = w & 1, wn = w >> 1, r16 = lane & 15, g = lane >> 4;
  const bf16_t* Wl = P.WgT + (size_t)l * 512 * 512;
  for (int tile = vb(); tile < 16 * 16; tile += vg()) {
    const int m0 = (256 + (tile >> 4)) * 128, n0 = (tile & 15) * 32;
    f32x4 acc[4][1];
    zero_acc<1>(acc);
    gemm_main<32>(acc, P.proj + (size_t)m0 * PW + CUS, PW, Wl + (size_t)n0 * 512, 512, 512, smem);
#pragma unroll
    for (int mt = 0; mt < 4; ++mt) {
      const int m = m0 + wm * 64 + mt * 16 + r16;
#pragma unroll
      for (int nt = 0; nt < 1; ++nt) {
        const int n = n0 + wn * 16 + nt * 16 + g * 4;
        float4 bg = *(const float4*)(P.s5_b_glu + l * 512 + n);
        u32x2 gg = *(const u32x2*)(P.proj + (size_t)m * PW + CUS + n);
        u32x2 zz = *(const u32x2*)(P.proj + (size_t)m * PW + CZS + n);
        float y0 = bf2f((bf16_t)(gg.x & 0xffffu)) * sigmoidf_(acc[mt][nt][0] + bg.x) * bf2f((bf16_t)(zz.x & 0xffffu));
        float y1 = bf2f((bf16_t)(gg.x >> 16)) * sigmoidf_(acc[mt][nt][1] + bg.y) * bf2f((bf16_t)(zz.x >> 16));
        float y2 = bf2f((bf16_t)(gg.y & 0xffffu)) * sigmoidf_(acc[mt][nt][2] + bg.z) * bf2f((bf16_t)(zz.y & 0xffffu));
        float y3 = bf2f((bf16_t)(gg.y >> 16)) * sigmoidf_(acc[mt][nt][3] + bg.w) * bf2f((bf16_t)(zz.y >> 16));
        *(u32x2*)(P.proj + (size_t)m * PW + CZS + n) = u32x2_mk(pack2(y0, y1), pack2(y2, y3));
      }
    }
  }
}

DEV void phase_merge(const Params& P, int l, char* smem) {
  const int tid_ = tidx(); const int lane = tid_ & 63, w = tid_ >> 6;
  const int wm = w & 1, wn = w >> 1, r16 = lane & 15, g = lane >> 4;
  const bf16_t* Wl = P.WinT + (size_t)l * 7168 * 1024;
  for (int tile = vb(); tile < 16 * 32; tile += vg()) {
    const int m0 = (256 + (tile >> 5)) * 128, n0 = (tile & 31) * 32;
    f32x4 accM[4][1];
    zero_acc<1>(accM);
#pragma unroll 1
    for (int nb = 0; nb < 3; ++nb) {
      f32x4 accG[4][1], accY[4][1];
      zero_acc<1>(accG);
      zero_acc<1>(accY);
      gemm_main<32>(accG, P.hbuf + (size_t)m0 * 1024, 1024, Wl + (size_t)(4096 + nb * 1024 + n0) * 1024, 1024, 1024, smem);
      const int cofs = nb == 0 ? CQ : (nb == 1 ? CZR : CZS);
      gemm_main<32>(accY, P.proj + (size_t)m0 * PW + cofs, PW, P.WbT + ((size_t)(l * 3 + nb) * 1024 + n0) * 512, 512, 512, smem);
#pragma unroll
      for (int mt = 0; mt < 4; ++mt)
#pragma unroll
        for (int nt = 0; nt < 1; ++nt)
#pragma unroll
          for (int j = 0; j < 4; ++j) accM[mt][nt][j] += sigmoidf_(accG[mt][nt][j]) * accY[mt][nt][j];
    }
#pragma unroll
    for (int mt = 0; mt < 4; ++mt) {
      const int m = m0 + wm * 64 + mt * 16 + r16;
#pragma unroll
      for (int nt = 0; nt < 1; ++nt) {
        const int n = n0 + wn * 16 + nt * 16 + g * 4;
        f32x4 v = accM[mt][nt];
        *(u32x2*)(P.proj + (size_t)m * PW + CM + n) = u32x2_mk(pack2(v[0], v[1]), pack2(v[2], v[3]));
      }
    }
  }
}

DEV void phase_out(const Params& P, int l, char* smem) {
  const int tid_ = tidx(); const int lane = tid_ & 63, w = tid_ >> 6;
  const int wm = w & 1, wn = w >> 1, r16 = lane & 15, g = lane >> 4;
  const bf16_t* Wl = P.WoT + (size_t)l * 1024 * 1024;
  for (int tile = vb(); tile < 16 * 32; tile += vg()) {
    const int m0 = (256 + (tile >> 5)) * 128, n0 = (tile & 31) * 32;
    f32x4 acc[4][1];
    zero_acc<1>(acc);
    gemm_main<32>(acc, P.proj + (size_t)m0 * PW + CM, PW, Wl + (size_t)n0 * 1024, 1024, 1024, smem);
#pragma unroll
    for (int mt = 0; mt < 4; ++mt) {
      const int m = m0 + wm * 64 + mt * 16 + r16;
      const float* src;
      float* dst;
      if (m < NLAT) { src = (l == 0 ? P.x : P.out) + (size_t)m * 1024; dst = P.out + (size_t)m * 1024; }
      else { src = (l == 0 ? P.ctx : P.ctxres) + (size_t)(m - NLAT) * 1024; dst = P.ctxres + (size_t)(m - NLAT) * 1024; }
      const float* gt = P.mods + (size_t)(l * 9 + mod_row(m)) * 3072 + 2048;
#pragma unroll
      for (int nt = 0; nt < 1; ++nt) {
        const int n = n0 + wn * 16 + nt * 16 + g * 4;
        float4 xo = *(const float4*)(src + n);
        float4 gg = *(const float4*)(gt + n);
        float4 r;
        r.x = xo.x + gg.x * acc[mt][nt][0];
        r.y = xo.y + gg.y * acc[mt][nt][1];
        r.z = xo.z + gg.z * acc[mt][nt][2];
        r.w = xo.w + gg.w * acc[mt][nt][3];
        *(float4*)(dst + n) = r;
      }
    }
  }
}

DEV void phase_final(const Params& P) {
  const int tid_ = tidx(); const int lane = tid_ & 63, w = tid_ >> 6;
  const int stride = vg() * 4;
  int r = vb() * 4 + w;
  float4 v[4], vn[4];
  if (r < NLAT) {
#pragma unroll
    for (int i = 0; i < 4; ++i) v[i] = *(const float4*)(P.out + (size_t)r * 1024 + i * 256 + lane * 4);
  }
  for (; r < NLAT; r += stride) {
    const int rn = r + stride;
    if (rn < NLAT) {
#pragma unroll
      for (int i = 0; i < 4; ++i) vn[i] = *(const float4*)(P.out + (size_t)rn * 1024 + i * 256 + lane * 4);
    }
    float* src = P.out + (size_t)r * 1024;
    float ss = 0.f;
#pragma unroll
    for (int i = 0; i < 4; ++i) ss += v[i].x * v[i].x + v[i].y * v[i].y + v[i].z * v[i].z + v[i].w * v[i].w;
#pragma unroll
    for (int o = 32; o > 0; o >>= 1) ss += __shfl_xor(ss, o);
    float rstd = rsqrtf(ss * (1.f / 1024.f) + 1e-6f);
#pragma unroll
    for (int i = 0; i < 4; ++i) {
      int k = i * 256 + lane * 4;
      float4 g4 = *(const float4*)(P.final_g + k);
      float4 r4;
      r4.x = v[i].x * rstd * g4.x; r4.y = v[i].y * rstd * g4.y; r4.z = v[i].z * rstd * g4.z; r4.w = v[i].w * rstd * g4.w;
      *(float4*)(src + k) = r4;
    }
#pragma unroll
    for (int i = 0; i < 4; ++i) v[i] = vn[i];
  }
}

namespace pg8 {
#define PG8_LAS __attribute__((address_space(3)))
constexpr int BM = 256, BK = 64, HALF = 128, HTB = HALF * BK * 2, NXCD = 8, WGM = 8;
DEV int lds_byte(int r, int c) { const int st = (r >> 4) * 2 + (c >> 5), rr = r & 15, cc = c & 31, ob = rr * 64 + cc * 2; return st * 1024 + (ob ^ (((ob >> 9) & 1) << 5)); }
DEV void stage_rc(int b, int& R, int& C) { const int st = b / 1024, sb = b % 1024, swz = sb ^ (((sb >> 9) & 1) << 5); R = (st >> 1) * 16 + swz / 64; C = (st & 1) * 32 + (swz % 64) / 2; }
DEV int perm32(int rho) { const int n = rho >> 4, i = rho & 15; return 8 * (i >> 2) + 4 * n + (i & 3); }
struct Unit { int pm, pn; };
struct Gemm { const bf16_t* A; const bf16_t* Bt; int M, N, K, lda; };
struct StaticOrder {
  int nM, nN, nwg, G, c;
  DEV void init(int M, int N, int G_, int c_) { nM = M / BM; nN = N / BM; nwg = nM * nN; G = G_; c = c_; }
  DEV bool next(int i, Unit& u) const {
    const long L = (long)i * G + c; if (L >= nwg) return false;
    int wgid = (int)L; { const int q = nwg / NXCD, r = nwg % NXCD, xcd = wgid % NXCD, off = wgid / NXCD; wgid = (xcd < r ? xcd * (q + 1) : r * (q + 1) + (xcd - r) * q) + off; }
    const int nig = WGM * nN, gid = wgid / nig, fm = gid * WGM, gsz = (nM - fm) < WGM ? (nM - fm) : WGM;
    u.pm = fm + ((wgid % nig) % gsz); u.pn = (wgid % nig) / gsz; return true;
  }
};
template <class Epi>
DEV void gemm_phase(PG8_LAS unsigned char* lds, const Gemm g, const StaticOrder& S, const Epi& E) {
  const int tid = tid512(), wid = __builtin_amdgcn_readfirstlane(tid >> 6), lane = tid & 63, wr = wid >> 2, wc = wid & 3, fr = lane & 15, fq = lane >> 4;
  const int K = g.K, nt = K / BK, lda = g.lda;
  unsigned voffA[2], voffB[2];
#pragma unroll
  for (int i = 0; i < 2; ++i) { int R, C; stage_rc(tid * 16 + i * 8192, R, C);
    const int Rb = (R & ~31) + perm32(R & 31);
    voffA[i] = (unsigned)(R * lda + C) * 2u; voffB[i] = (unsigned)(Rb * K + C) * 2u; }
  const size_t kstep = (size_t)(BK * 2);
  const size_t hstepA = (size_t)HALF * lda * 2, hstepB = (size_t)HALF * K * 2;
  const size_t tstepA = 2 * hstepA, tstepB = 2 * hstepB;
  const unsigned ldsw = (unsigned)wid * 1024u;
  const int aoff = lds_byte(wr * 64 + fr, fq * 8), boff = lds_byte(wc * 32 + fr, fq * 8);
#define PG8_SA(b, h) (((b) * 2 + (h)) * HTB)
#define PG8_SB(b, h) ((4 + (b) * 2 + (h)) * HTB)
#define PG8_STAGE(bufoff, gbase, voff) do { _Pragma("unroll") for (int _i = 0; _i < 2; ++_i) \
    __builtin_amdgcn_global_load_lds((const unsigned*)((const char*)(gbase) + (voff)[_i]), (PG8_LAS unsigned*)(lds + (bufoff) + ldsw + _i * 8192), 16, 0, 0); } while (0)
#define PG8_LDA(dst, b, h) do { _Pragma("unroll") for (int m = 0; m < 4; ++m) _Pragma("unroll") for (int k = 0; k < 2; ++k) dst[m][k] = *(const PG8_LAS bf16x8*)(lds + PG8_SA(b, h) + aoff + m * 2048 + k * 1024); } while (0)
#define PG8_LDB(dst, b, h) do { _Pragma("unroll") for (int n = 0; n < 2; ++n) _Pragma("unroll") for (int k = 0; k < 2; ++k) dst[n][k] = *(const PG8_LAS bf16x8*)(lds + PG8_SB(b, h) + boff + n * 2048 + k * 1024); } while (0)
#define PG8_MMA(ai, bj, At, Bt) do { __builtin_amdgcn_s_setprio(1); _Pragma("unroll") for (int m = 0; m < 4; ++m) _Pragma("unroll") for (int n = 0; n < 2; ++n) _Pragma("unroll") for (int k = 0; k < 2; ++k) \
    acc[ai][bj][m][n] = __builtin_amdgcn_mfma_f32_16x16x32_bf16(Bt[n][k], At[m][k], acc[ai][bj][m][n], 0, 0, 0); __builtin_amdgcn_s_setprio(0); } while (0)
#define PG8_WAIT_V(n) asm volatile("s_waitcnt vmcnt(" #n ")" ::: "memory")
#define PG8_WAIT_L(n) asm volatile("s_waitcnt lgkmcnt(" #n ")" ::: "memory")
#define PG8_BAR __builtin_amdgcn_s_barrier()
#define PG8_SCHED __builtin_amdgcn_sched_barrier(0)
  Unit cur, nxt; int ui = 0;
  if (!S.next(0, cur)) return;
  f32x4 acc[2][2][4][2];
#pragma unroll
  for (int a = 0; a < 2; ++a)
#pragma unroll
    for (int b = 0; b < 2; ++b)
#pragma unroll
      for (int m = 0; m < 4; ++m)
#pragma unroll
        for (int n = 0; n < 2; ++n) acc[a][b][m][n] = f32x4{0.f, 0.f, 0.f, 0.f};
  bf16x8 At[4][2], B0[2][2], B1[2][2];
  const char* cA = (const char*)g.A + (size_t)cur.pm * tstepA; const char* cB = (const char*)g.Bt + (size_t)cur.pn * tstepB;
  PG8_STAGE(PG8_SB(0, 0), cB, voffB); PG8_STAGE(PG8_SA(0, 0), cA, voffA); PG8_STAGE(PG8_SB(0, 1), cB + hstepB, voffB); PG8_STAGE(PG8_SA(0, 1), cA + hstepA, voffA);
  if (wr == 1) PG8_BAR;
  PG8_WAIT_V(4); PG8_BAR;
  PG8_STAGE(PG8_SB(1, 0), cB + kstep, voffB); PG8_STAGE(PG8_SA(1, 0), cA + kstep, voffA); PG8_STAGE(PG8_SB(1, 1), cB + hstepB + kstep, voffB);
  PG8_WAIT_V(6); PG8_BAR;
  for (;;) {
    const bool has_next = S.next(ui + 1, nxt);
    const char* nA = has_next ? (const char*)g.A + (size_t)nxt.pm * tstepA : cA; const char* nB = has_next ? (const char*)g.Bt + (size_t)nxt.pn * tstepB : cB;
    for (int t = 0; t < nt; t += 2) {
      const bool last = (t == nt - 2);
      const char* a1 = cA + (size_t)(t + 1) * kstep;
      const char* a2 = last ? nA : cA + (size_t)(t + 2) * kstep; const char* b2 = last ? nB : cB + (size_t)(t + 2) * kstep;
      const char* a3 = a2 + kstep; const char* b3 = b2 + kstep;
      PG8_LDB(B0, 0, 0); PG8_SCHED; PG8_LDA(At, 0, 0); PG8_STAGE(PG8_SA(1, 1), a1 + hstepA, voffA);
      PG8_WAIT_L(8); PG8_BAR; PG8_WAIT_L(0); PG8_MMA(0, 0, At, B0); PG8_BAR; PG8_SCHED;
      PG8_LDB(B1, 0, 1); PG8_STAGE(PG8_SB(0, 0), b2, voffB);
      PG8_BAR; PG8_WAIT_L(0); PG8_MMA(0, 1, At, B1); PG8_BAR;
      PG8_LDA(At, 0, 1); PG8_STAGE(PG8_SA(0, 0), a2, voffA);
      PG8_BAR; PG8_WAIT_L(0); PG8_MMA(1, 0, At, B0); PG8_BAR; PG8_SCHED;
      PG8_STAGE(PG8_SB(0, 1), b2 + hstepB, voffB);
      PG8_WAIT_V(6); PG8_BAR; PG8_MMA(1, 1, At, B1); PG8_BAR;
      PG8_LDB(B0, 1, 0); PG8_SCHED; PG8_LDA(At, 1, 0); PG8_STAGE(PG8_SA(0, 1), a2 + hstepA, voffA);
      PG8_WAIT_L(8); PG8_BAR; PG8_WAIT_L(0); PG8_MMA(0, 0, At, B0); PG8_BAR; PG8_SCHED;
      PG8_LDB(B1, 1, 1); PG8_STAGE(PG8_SB(1, 0), b3, voffB);
      PG8_BAR; PG8_WAIT_L(0); PG8_MMA(0, 1, At, B1); PG8_BAR;
      PG8_LDA(At, 1, 1); PG8_STAGE(PG8_SA(1, 0), a3, voffA);
      PG8_BAR; PG8_WAIT_L(0); PG8_MMA(1, 0, At, B0); PG8_BAR; PG8_SCHED;
      PG8_STAGE(PG8_SB(1, 1), b3 + hstepB, voffB);
      PG8_WAIT_V(6); PG8_BAR; PG8_MMA(1, 1, At, B1); PG8_BAR;
    }
    E(acc, cur, wr, wc, fr, fq);
    if (!has_next) break;
#pragma unroll
    for (int a = 0; a < 2; ++a)
#pragma unroll
      for (int b = 0; b < 2; ++b)
#pragma unroll
        for (int m = 0; m < 4; ++m)
#pragma unroll
          for (int n = 0; n < 2; ++n) acc[a][b][m][n] = f32x4{0.f, 0.f, 0.f, 0.f};
    cur = nxt; cA = nA; cB = nB; ++ui;
  }
  PG8_WAIT_V(0);
  if (wr == 0) PG8_BAR;
  PG8_BAR;
#undef PG8_SA
#undef PG8_SB
#undef PG8_STAGE
#undef PG8_LDA
#undef PG8_LDB
#undef PG8_MMA
#undef PG8_WAIT_V
#undef PG8_WAIT_L
#undef PG8_BAR
#undef PG8_SCHED
}
}

DEV u32x4 pack8(const f32x4& v0, const f32x4& v1) { return u32x4_mk(pack2(v0[0], v0[1]), pack2(v0[2], v0[3]), pack2(v1[0], v1[1]), pack2(v1[2], v1[3])); }
DEV float bflo(unsigned w) { return __uint_as_float(w << 16); }
DEV float bfhi(unsigned w) { return __uint_as_float(w & 0xffff0000u); }
struct EpiProj {
  const Params* Pp; int l;
  DEV void operator()(const f32x4 (&acc)[2][2][4][2], const pg8::Unit& u, int wr, int wc, int fr, int fq) const {
    const Params& P = *Pp;
    const float QS = 0.125f * 1.4426950408889634f;
#pragma unroll
    for (int ai = 0; ai < 2; ++ai)
#pragma unroll
      for (int mm = 0; mm < 4; ++mm) {
        const int m = u.pm * 256 + ai * 128 + wr * 64 + mm * 16 + fr;
#pragma unroll
        for (int bj = 0; bj < 2; ++bj) {
          const int region = (u.pn * 256 + bj * 128) >> 9;
          const int n8 = u.pn * 256 + bj * 128 + wc * 32 + 8 * fq;
          f32x4 v0 = acc[ai][bj][mm][0], v1 = acc[ai][bj][mm][1];
          if (region <= 1) {
            if (m < NLAT) {
              const int t = m & 4095;
              const int i0 = (n8 & 63) >> 1;
              const float4 c0 = *(const float4*)(P.rope + (size_t)t * 32 + i0);
              const float4 c1 = *(const float4*)(P.rope + (size_t)t * 32 + i0 + 2);
              v0 = f32x4{v0[0] * c0.x - v0[1] * c0.y, v0[0] * c0.y + v0[1] * c0.x, v0[2] * c0.z - v0[3] * c0.w, v0[2] * c0.w + v0[3] * c0.z};
              v1 = f32x4{v1[0] * c1.x - v1[1] * c1.y, v1[0] * c1.y + v1[1] * c1.x, v1[2] * c1.z - v1[3] * c1.w, v1[2] * c1.w + v1[3] * c1.z};
            }
            if (region == 0) { v0 = v0 * QS; v1 = v1 * QS; }
            *(u32x4*)(P.proj + (size_t)m * PW + n8) = pack8(v0, v1);
          } else if (region == 2) {
            int b, key;
            if (m < NLAT) { b = m >> 12; key = m & 4095; }
            else { b = (m - NLAT) >> 8; key = 4096 + ((m - NLAT) & 255); }
            bf16_t* vp = P.Vt + ((size_t)b * 512 + (n8 - 1024)) * 4352 + key;
#pragma unroll
            for (int j = 0; j < 4; ++j) { vp[(size_t)j * 4352] = f2bf(v0[j]); vp[(size_t)(4 + j) * 4352] = f2bf(v1[j]); }
          } else {
            if (region == 3 || region == 5 || region == 7) {
#pragma unroll
              for (int j = 0; j < 4; ++j) { v0[j] = siluf_(v0[j]); v1[j] = siluf_(v1[j]); }
            }
            *(u32x4*)(P.proj + (size_t)m * PW + n8) = pack8(v0, v1);
          }
        }
      }
  }
};
struct EpiGlu {
  const Params* Pp; int l;
  DEV void operator()(const f32x4 (&acc)[2][2][4][2], const pg8::Unit& u, int wr, int wc, int fr, int fq) const {
    const Params& P = *Pp;
#pragma unroll
    for (int ai = 0; ai < 2; ++ai)
#pragma unroll
      for (int mm = 0; mm < 4; ++mm) {
        const int m = u.pm * 256 + ai * 128 + wr * 64 + mm * 16 + fr;
#pragma unroll
        for (int bj = 0; bj < 2; ++bj) {
          const int n8 = u.pn * 256 + bj * 128 + wc * 32 + 8 * fq;
          const f32x4 a0 = acc[ai][bj][mm][0], a1 = acc[ai][bj][mm][1];
          const float4 b0 = *(const float4*)(P.s5_b_glu + l * 512 + n8), b1 = *(const float4*)(P.s5_b_glu + l * 512 + n8 + 4);
          const u32x4 gg = *(const u32x4*)(P.proj + (size_t)m * PW + CUS + n8);
          const u32x4 zz = *(const u32x4*)(P.proj + (size_t)m * PW + CZS + n8);
          f32x4 y0, y1;
          y0[0] = bflo(gg.x) * sigmoidf_(a0[0] + b0.x) * bflo(zz.x); y0[1] = bfhi(gg.x) * sigmoidf_(a0[1] + b0.y) * bfhi(zz.x);
          y0[2] = bflo(gg.y) * sigmoidf_(a0[2] + b0.z) * bflo(zz.y); y0[3] = bfhi(gg.y) * sigmoidf_(a0[3] + b0.w) * bfhi(zz.y);
          y1[0] = bflo(gg.z) * sigmoidf_(a1[0] + b1.x) * bflo(zz.z); y1[1] = bfhi(gg.z) * sigmoidf_(a1[1] + b1.y) * bfhi(zz.z);
          y1[2] = bflo(gg.w) * sigmoidf_(a1[2] + b1.z) * bflo(zz.w); y1[3] = bfhi(gg.w) * sigmoidf_(a1[3] + b1.w) * bfhi(zz.w);
          *(u32x4*)(P.proj + (size_t)m * PW + CZS + n8) = pack8(y0, y1);
        }
      }
  }
};
struct EpiOut {
  const Params* Pp; int l;
  DEV void operator()(const f32x4 (&acc)[2][2][4][2], const pg8::Unit& u, int wr, int wc, int fr, int fq) const {
    const Params& P = *Pp;
#pragma unroll
    for (int ai = 0; ai < 2; ++ai)
#pragma unroll
      for (int mm = 0; mm < 4; ++mm) {
        const int m = u.pm * 256 + ai * 128 + wr * 64 + mm * 16 + fr;
        const float* src;
        float* dst;
        if (m < NLAT) { src = (l == 0 ? P.x : P.out) + (size_t)m * 1024; dst = P.out + (size_t)m * 1024; }
        else { src = (l == 0 ? P.ctx : P.ctxres) + (size_t)(m - NLAT) * 1024; dst = P.ctxres + (size_t)(m - NLAT) * 1024; }
        const float* gt = P.mods + (size_t)(l * 9 + mod_row(m)) * 3072 + 2048;
#pragma unroll
        for (int bj = 0; bj < 2; ++bj) {
          const int n8 = u.pn * 256 + bj * 128 + wc * 32 + 8 * fq;
#pragma unroll
          for (int nn = 0; nn < 2; ++nn) {
            const f32x4 a = acc[ai][bj][mm][nn];
            const int n = n8 + 4 * nn;
            float4 xo = *(const float4*)(src + n);
            float4 gg = *(const float4*)(gt + n);
            float4 r;
            r.x = xo.x + gg.x * a[0];
            r.y = xo.y + gg.y * a[1];
            r.z = xo.z + gg.z * a[2];
            r.w = xo.w + gg.w * a[3];
            *(float4*)(dst + n) = r;
          }
        }
      }
  }
};
struct EpiYB {
  const Params* Pp; int l;
  DEV void operator()(const f32x4 (&acc)[2][2][4][2], const pg8::Unit& u, int wr, int wc, int fr, int fq) const {
    const Params& P = *Pp;
#pragma unroll
    for (int ai = 0; ai < 2; ++ai)
#pragma unroll
      for (int mm = 0; mm < 4; ++mm) {
        const int m = u.pm * 256 + ai * 128 + wr * 64 + mm * 16 + fr;
#pragma unroll
        for (int bj = 0; bj < 2; ++bj) {
          const int n8 = u.pn * 256 + bj * 128 + wc * 32 + 8 * fq;
          *(u32x4*)(P.proj + (size_t)m * PW + CZA + n8) = pack8(acc[ai][bj][mm][0], acc[ai][bj][mm][1]);
        }
      }
  }
};
struct EpiGate {
  const Params* Pp; int nb;
  DEV void operator()(const f32x4 (&acc)[2][2][4][2], const pg8::Unit& u, int wr, int wc, int fr, int fq) const {
    const Params& P = *Pp;
#pragma unroll
    for (int ai = 0; ai < 2; ++ai)
#pragma unroll
      for (int mm = 0; mm < 4; ++mm) {
        const int m = u.pm * 256 + ai * 128 + wr * 64 + mm * 16 + fr;
#pragma unroll
        for (int bj = 0; bj < 2; ++bj) {
          const int n8 = u.pn * 256 + bj * 128 + wc * 32 + 8 * fq;
          const f32x4 a0 = acc[ai][bj][mm][0], a1 = acc[ai][bj][mm][1];
          const u32x4 yb = *(const u32x4*)(P.proj + (size_t)m * PW + CZA + n8);
          f32x4 v0, v1;
          v0[0] = sigmoidf_(a0[0]) * bflo(yb.x); v0[1] = sigmoidf_(a0[1]) * bfhi(yb.x);
          v0[2] = sigmoidf_(a0[2]) * bflo(yb.y); v0[3] = sigmoidf_(a0[3]) * bfhi(yb.y);
          v1[0] = sigmoidf_(a1[0]) * bflo(yb.z); v1[1] = sigmoidf_(a1[1]) * bfhi(yb.z);
          v1[2] = sigmoidf_(a1[2]) * bflo(yb.w); v1[3] = sigmoidf_(a1[3]) * bfhi(yb.w);
          if (nb > 0) {
            const u32x4 pv = *(const u32x4*)(P.proj + (size_t)m * PW + CM + n8);
            v0[0] += bflo(pv.x); v0[1] += bfhi(pv.x); v0[2] += bflo(pv.y); v0[3] += bfhi(pv.y);
            v1[0] += bflo(pv.z); v1[1] += bfhi(pv.z); v1[2] += bflo(pv.w); v1[3] += bfhi(pv.w);
          }
          *(u32x4*)(P.proj + (size_t)m * PW + CM + n8) = pack8(v0, v1);
        }
      }
  }
};
template <class Epi>
DEV void engine_gemm_e(const Epi& E, char* smem, const bf16_t* A, int lda, const bf16_t* Bt, int M, int N, int K) {
  pg8::Gemm g{A, Bt, M, N, K, lda};
  pg8::StaticOrder S;
  S.init(M, N, (int)gridDim.x, (int)blockIdx.x);
  pg8::gemm_phase<Epi>((PG8_LAS unsigned char*)smem, g, S, E);
}
template <class Epi>
DEV void engine_gemm(const Params& P, int l, char* smem, const bf16_t* A, int lda, const bf16_t* Bt, int M, int N, int K) {
  Epi E{&P, l};
  engine_gemm_e<Epi>(E, smem, A, lda, Bt, M, N, K);
}
DEV void engine_merge(const Params& P, int l, char* smem, int M) {
#pragma unroll 1
  for (int nb = 0; nb < 3; ++nb) {
    const int cofs = nb == 0 ? CQ : (nb == 1 ? CZR : CZS);
    EpiYB ey{&P, l};
    engine_gemm_e<EpiYB>(ey, smem, P.proj + cofs, PW, P.WbT + (size_t)(l * 3 + nb) * 1024 * 512, M, 1024, 512);
    EpiGate eg{&P, nb};
    engine_gemm_e<EpiGate>(eg, smem, P.hbuf, 1024, P.WinT + ((size_t)l * 7168 + 4096 + nb * 1024) * 1024, M, 1024, 1024);
  }
}

#define XB_TMO      128
#define XB_XCNT(j)  (256  + 64 * (j))
#define XB_XSUB(j)  (1280 + 64 * (j))
#define XB_XGEN(j)  (2304 + 64 * (j))
#define XB_TOP      3328
#define XB_TOPGEN   3392
#define XCD_BAR_WORDS 3456
#define XB_SPIN_CAP (1u << 18)
#define LAS __attribute__((address_space(3)))

__device__ __forceinline__ unsigned xb_ld(unsigned* p)              { return __hip_atomic_load(p, __ATOMIC_RELAXED, __HIP_MEMORY_SCOPE_AGENT); }
__device__ __forceinline__ unsigned xb_add(unsigned* p, unsigned v) { return __hip_atomic_fetch_add(p, v, __ATOMIC_RELAXED, __HIP_MEMORY_SCOPE_AGENT); }
__device__ __forceinline__ unsigned xb_xcc_id() { return (unsigned)__builtin_amdgcn_s_getreg((3 << 11) | 20) & 0xFu; }
#define XB_SPIN(cond, bar) do { unsigned _sp = 0; while (cond) { __builtin_amdgcn_s_sleep(1); \
    if ((++_sp & 255u) == 0u) { if (xb_ld(&(bar)[XB_TMO])) break; if (_sp > XB_SPIN_CAP) { atomicAdd(&(bar)[XB_TMO], 1u); break; } } } } while (0)

struct XcdBarrier {
    unsigned* bar; unsigned x;
    volatile LAS unsigned* st;
};

__device__ __forceinline__ XcdBarrier xcd_barrier_post(unsigned* bar, volatile LAS unsigned* st) {
    XcdBarrier b; b.bar = bar; b.x = xb_xcc_id(); b.st = st;
    if (threadIdx.x == 0) (void)xb_add(&bar[XB_XCNT(b.x)], 1u);
    return b;
}
__device__ __forceinline__ void xcd_barrier_complete(unsigned* bar, unsigned x, unsigned& nloc, unsigned& nx) {
    const unsigned G = gridDim.x * gridDim.y * gridDim.z;
    unsigned sum, cnt, mine, sp = 0u;
    for (;;) {
        sum = 0u; cnt = 0u; mine = 0u;
#pragma unroll
        for (unsigned j = 0; j < 16; ++j) { const unsigned c = xb_ld(&bar[XB_XCNT(j)]); sum += c; cnt += (c > 0u) ? 1u : 0u; mine = (j == x) ? c : mine; }
        if (sum == G) break;
        __builtin_amdgcn_s_sleep(1);
        if ((++sp & 255u) == 0u) { if (xb_ld(&bar[XB_TMO])) break; if (sp > XB_SPIN_CAP) { atomicAdd(&bar[XB_TMO], 1u); break; } }
    }
    nloc = mine > 0u ? mine : 1u; nx = cnt > 0u ? cnt : 1u;
}

__device__ __forceinline__ void xcd_barrier(const XcdBarrier& b) {
    asm volatile("s_waitcnt vmcnt(0)" ::: "memory");
    __syncthreads();
    if (threadIdx.x == 0) {
        unsigned* bar = b.bar;
        __builtin_amdgcn_s_waitcnt(0);
        unsigned nloc = b.st[0], nx = b.st[1];
        if (nloc == 0u) { xcd_barrier_complete(bar, b.x, nloc, nx); b.st[0] = nloc; b.st[1] = nx; }
        const unsigned old = xb_add(&bar[XB_XSUB(b.x)], 1u);
        const unsigned gen = old / nloc;
        if (old + 1u == (gen + 1u) * nloc) {
            __builtin_amdgcn_fence(__ATOMIC_RELEASE, "agent");
            asm volatile("s_waitcnt vmcnt(0)" ::: "memory");
            const unsigned og = xb_add(&bar[XB_TOP], 1u);
            const unsigned tg = og / nx;
            if (og + 1u == (tg + 1u) * nx) xb_add(&bar[XB_TOPGEN], 1u);
            else XB_SPIN(xb_ld(&bar[XB_TOPGEN]) == tg, bar);
            __builtin_amdgcn_fence(__ATOMIC_ACQUIRE, "agent");
            xb_add(&bar[XB_XGEN(b.x)], 1u);
            asm volatile("s_waitcnt vmcnt(0)" ::: "memory");
        } else {
            XB_SPIN(xb_ld(&bar[XB_XGEN(b.x)]) == gen, bar);
            __builtin_amdgcn_fence(__ATOMIC_ACQUIRE, "agent");
            asm volatile("s_waitcnt vmcnt(0)" ::: "memory");
        }
    }
    __syncthreads();
}


#ifndef PROBE_PH
#define PROBE_PH -1
#endif
#define REPEAT(id, body) { int nrep_ = (PROBE_PH == (id)) ? 2 : 1; asm volatile("" : "+s"(nrep_)); _Pragma("unroll 1") for (int rep_ = 0; rep_ < nrep_; ++rep_) { body } }
__global__ void __launch_bounds__(512, 2) mega_kernel(Params P) {
  __shared__ __attribute__((aligned(16))) char smem_all[SMEM_BYTES];
  cg::grid_group grid = cg::this_grid();
  char* smem = smem_all + vhalf() * SMEM_HALF;
  __shared__ __attribute__((aligned(16))) unsigned xb_st[4];
  if (threadIdx.x < 4) xb_st[threadIdx.x] = 0u;
  __syncthreads();
  const XcdBarrier xb = xcd_barrier_post(P.bar, (volatile LAS unsigned*)xb_st);
  REPEAT(0, phase0(P, smem); grid.sync();)
#pragma unroll 1
  for (int l = 0; l < 4; ++l) {
    REPEAT(5, phase_norm(P, l); xcd_barrier(xb);)
    engine_gemm<EpiProj>(P, l, smem_all, P.hbuf, 1024, P.WinT + (size_t)l * 7168 * 1024, NR, 4096, 1024);
    if (l < 3 && gridDim.x == 256 && blockIdx.x >= 128) prep_layer_weights(P, l + 1, ((int)blockIdx.x - 128) * 2 + vhalf(), 256, smem);
    if (l < 3 && gridDim.x != 256) prep_layer_weights(P, l + 1, vb(), vg(), smem);
    xcd_barrier(xb);
#if PROBE_PH == 1
    engine_gemm<EpiProj>(P, l, smem_all, P.hbuf, 1024, P.WinT + (size_t)l * 7168 * 1024, NR, 4096, 1024);
    xcd_barrier(xb);
#endif
    REPEAT(2, phase_scan(P, l, false, smem); xcd_barrier(xb);)
    phase_attn8(P, l, smem_all);
    xcd_barrier(xb);
    phase_scan(P, l, true, smem);
    xcd_barrier(xb);
    engine_gemm<EpiGlu>(P, l, smem_all, P.proj + CUS, PW, P.WgT + (size_t)l * 512 * 512, NLAT, 512, 512);
    if (l < 3) phase_glu(P, l, smem);
    xcd_barrier(xb);
    engine_merge(P, l, smem_all, NLAT);
    if (l < 3) phase_merge(P, l, smem);
    xcd_barrier(xb);
#if PROBE_PH == 4
    engine_merge(P, l, smem_all, Mrows);
    xcd_barrier(xb);
#endif
    engine_gemm<EpiOut>(P, l, smem_all, P.proj + CM, PW, P.WoT + (size_t)l * 1024 * 1024, NLAT, 1024, 1024);
    if (l < 3) phase_out(P, l, smem);
    xcd_barrier(xb);
  }
  phase_final(P);
}

extern "C" void kernel_launch(void* const* d_in, const int* in_sizes, int n_in, void* d_out, int out_size, void* d_ws,
                              size_t ws_size, hipStream_t stream) {
  Params p{};
  const float** fp = (const float**)&p;
  for (int i = 0; i < 30; ++i) fp[i] = (const float*)d_in[i];
  p.out = (float*)d_out;
  char* ws = (char*)d_ws;
  size_t off = 0;
  auto take = [&](size_t bytes) { char* r = ws + off; off += (bytes + 255) & ~(size_t)255; return r; };
  p.proj = (bf16_t*)take((size_t)NR * PW * 2);
  p.hbuf = (bf16_t*)take((size_t)NR * 1024 * 2);
  p.WinT = (bf16_t*)take((size_t)4 * 7168 * 1024 * 2);
  p.WbT = (bf16_t*)take((size_t)12 * 1024 * 512 * 2);
  p.WoT = (bf16_t*)take((size_t)4 * 1024 * 1024 * 2);
  p.WgT = (bf16_t*)take((size_t)4 * 512 * 512 * 2);
  p.WlT = (bf16_t*)take((size_t)128 * 4096 * 2);
  p.Vt = (bf16_t*)take((size_t)32 * 128 * 4352 * 2);
  p.ctxres = (float*)take((size_t)2048 * 1024 * 4);
  p.mods = (float*)take((size_t)4 * 9 * 3072 * 4);
  p.lamv = (float*)take(256);
  p.lruP = (float*)take((size_t)2 * NCH * 512 * 4);
  p.lruS = (float*)take((size_t)2 * NCH * 512 * 4);
  p.rope = (float2*)take((size_t)4096 * 32 * 8);
  p.s5A = (float2*)take((size_t)256 * 64 * 8);
  p.s5A64 = (float2*)take((size_t)256 * 64 * 8);
  p.s5E = (float2*)take((size_t)2 * NCH * 32 * 64 * 8);
  p.s5drvB = (u32x4*)take((size_t)256 * 8 * 64 * 16);
  p.s5C = (u32x4*)take((size_t)128 * 4 * 64 * 16);
  p.bar = (unsigned*)take((size_t)XCD_BAR_WORDS * 4);
  if (off > ws_size) { fprintf(stderr, "workspace too small: need %zu have %zu\n", off, ws_size); return; }

  static int grid_blocks = 0;
  if (!grid_blocks) {
    int dev = 0, cus = 0, per_cu = 0;
    (void)hipGetDevice(&dev);
    (void)hipDeviceGetAttribute(&cus, hipDeviceAttributeMultiprocessorCount, dev);
    (void)hipOccupancyMaxActiveBlocksPerMultiprocessor(&per_cu, mega_kernel, 512, 0);
    if (per_cu < 1) per_cu = 1;
    if (per_cu > 1) per_cu = 1;
    grid_blocks = cus * per_cu;
  }
  (void)hipMemsetAsync(p.bar, 0, (size_t)XCD_BAR_WORDS * 4, stream);
  void* args[] = {&p};
  hipError_t e = hipLaunchCooperativeKernel((void*)mega_kernel, dim3(grid_blocks), dim3(512), args, 0, stream);
  if (e != hipSuccess) fprintf(stderr, "cooperative launch failed: %s (grid %d)\n", hipGetErrorString(e), grid_blocks);
}
```
